# Optimizing an MI355X kernel written in HIP

```python
import jax
import jax.numpy as jnp
from jax import lax
import numpy as np

D_MODEL = 2048
BATCH = 1
SEQ = 16384
DEPTH = 2

GRID_W = 64
CTX_LEN = 256
NORM_EPS = 1e-6

RWKV_WIDTH = D_MODEL // 2
RWKV_HEAD = 64
RWKV_HEADS = RWKV_WIDTH // RWKV_HEAD
DECAY_LORA = 64
ICLR_LORA = 64
GATE_LORA = 160
LNX_EPS = 64e-5
RWKV_COLS = (RWKV_WIDTH, RWKV_WIDTH, RWKV_WIDTH, DECAY_LORA, DECAY_LORA, ICLR_LORA, ICLR_LORA, GATE_LORA)
RWKV_IN = 3 * RWKV_WIDTH + 2 * DECAY_LORA + 2 * ICLR_LORA + GATE_LORA

RET_WIDTH = D_MODEL - RWKV_WIDTH
RET_HEAD = 128
RET_HEADS = RET_WIDTH // RET_HEAD
RET_CHUNK = 128
ROPE_BASE = 10000.0
RET_IN = 4 * RET_WIDTH
P_IN = RWKV_IN + RET_IN

N_EXPERTS = 32
N_GROUPS = 4
EXPERTS_PER_GROUP = N_EXPERTS // N_GROUPS
TOP_K = 2
D_EXPERT = 1024
MOE_BLOCK = 128

kernel_name = "hybrid_rwkv7_retention_moe_diffusion"


def rms_norm(x, g):
    xf = x.astype(jnp.float32)
    y = xf * lax.rsqrt(jnp.mean(xf * xf, axis=-1, keepdims=True) + NORM_EPS)
    return (y * g.astype(jnp.float32)).astype(x.dtype)


def split_cols(t, sizes):
    return jnp.split(t, [int(s) for s in np.cumsum(sizes)[:-1]], axis=-1)


def shift_seq(p, mu_prev, mu_next):
    prev = jnp.pad(p[:, :-1], ((0, 0), (1, 0), (0, 0)))
    nxt = jnp.pad(p[:, 1:], ((0, 0), (0, 1), (0, 0)))
    return p + mu_prev * (prev - p) + mu_next * (nxt - p)


def shift_grid(p, mu, rows):
    b, n, ch = p.shape
    g = p.reshape(b, rows, GRID_W, ch)
    left = jnp.pad(g[:, :, :-1], ((0, 0), (0, 0), (1, 0), (0, 0)))
    right = jnp.pad(g[:, :, 1:], ((0, 0), (0, 0), (0, 1), (0, 0)))
    up = jnp.pad(g[:, :-1], ((0, 0), (1, 0), (0, 0), (0, 0)))
    down = jnp.pad(g[:, 1:], ((0, 0), (0, 1), (0, 0), (0, 0)))
    out = g + mu[0] * (left - g) + mu[1] * (right - g) + mu[2] * (up - g) + mu[3] * (down - g)
    return out.reshape(b, n, ch)


def rwkv7_inputs(u, w0, w2, a0, a2, g2, k_k, k_a):
    b, n, _ = u.shape
    r, k, v, wd_f, wd_b, ad_f, ad_b, gd = split_cols(u.astype(jnp.float32), RWKV_COLS)

    def heads(t):
        return t.reshape(b, n, RWKV_HEADS, RWKV_HEAD)

    kk = heads(k * k_k)
    kk = kk / jnp.maximum(jnp.linalg.norm(kk, axis=-1, keepdims=True), 1e-12)
    per_dir = []
    for d, (wd, ad) in enumerate(((wd_f, ad_f), (wd_b, ad_b))):
        w_log = -jax.nn.softplus(-(w0[d] + jnp.tanh(wd) @ w2[d])) - 0.5
        a = jax.nn.sigmoid(a0[d] + ad @ a2[d])
        decay = jnp.exp(-jnp.exp(w_log))
        per_dir.append((heads(decay), heads(k * (1.0 + (a - 1.0) * k_a)), heads(a)))
    g = jax.nn.sigmoid(gd) @ g2
    return heads(r), heads(v), kk, g, per_dir


def rwkv7_scan(r, w, k, v, kk, a, s0, reverse):
    def step(s, inp):
        r_t, w_t, k_t, v_t, kk_t, a_t = inp
        sa = jnp.einsum('bhvk,bhk->bhv', s, kk_t)
        s = (s * w_t[:, :, None, :] - sa[..., None] * (kk_t * a_t)[:, :, None, :]
             + v_t[..., None] * k_t[:, :, None, :])
        return s, jnp.einsum('bhvk,bhk->bhv', s, r_t)

    xs = tuple(jnp.swapaxes(t, 0, 1) for t in (r, w, k, v, kk, a))
    s_fin, ys = lax.scan(step, s0, xs, reverse=reverse)
    return jnp.swapaxes(ys, 0, 1), s_fin


def rwkv7_output(y, r, v, g, per_dir, r_k, lnx_w, lnx_b):
    b, n = y.shape[:2]
    mu = jnp.mean(y, axis=-1, keepdims=True)
    var = jnp.mean(jnp.square(y - mu), axis=-1, keepdims=True)
    yn = (y - mu) * lax.rsqrt(var + LNX_EPS)
    k_f, k_b = per_dir[0][1], per_dir[1][1]
    bonus = (jnp.sum(r * k_f * r_k, axis=-1, keepdims=True)
             + jnp.sum(r * k_b * r_k, axis=-1, keepdims=True)) * v
    return (yn.reshape(b, n, RWKV_WIDTH) * lnx_w + lnx_b + bonus.reshape(b, n, RWKV_WIDTH)) * g


def rwkv7_mixer(u_c, u_x, w0, w2, a0, a2, g2, k_k, k_a, r_k, lnx_w, lnx_b, with_ctx):
    r_c, v_c, kk_c, g_c, dirs_c = rwkv7_inputs(u_c, w0, w2, a0, a2, g2, k_k, k_a)
    r_x, v_x, kk_x, g_x, dirs_x = rwkv7_inputs(u_x, w0, w2, a0, a2, g2, k_k, k_a)
    s0 = jnp.zeros((u_x.shape[0], RWKV_HEADS, RWKV_HEAD, RWKV_HEAD), jnp.float32)
    ys_c, ys_x = [], []
    for d in range(2):
        rev = d == 1
        dec_c, kd_c, a_c = dirs_c[d]
        y_c, s_c = rwkv7_scan(r_c, dec_c, kd_c, v_c, kk_c, a_c, s0, rev)
        dec_x, kd_x, a_x = dirs_x[d]
        y_x, _ = rwkv7_scan(r_x, dec_x, kd_x, v_x, kk_x, a_x, s_c, rev)
        ys_c.append(y_c)
        ys_x.append(y_x)
    out_x = rwkv7_output(ys_x[0] + ys_x[1], r_x, v_x, g_x, dirs_x, r_k, lnx_w, lnx_b)
    out_c = rwkv7_output(ys_c[0] + ys_c[1], r_c, v_c, g_c, dirs_c, r_k, lnx_w, lnx_b) if with_ctx else None
    return out_c, out_x


def rotary_2d(t):
    n = t.shape[1]
    pos = jnp.arange(n)
    half = RET_HEAD // 2
    inv = ROPE_BASE ** (-jnp.arange(0, half, 2, dtype=jnp.float32) / half)

    def rot(xp, p):
        ang = p.astype(jnp.float32)[:, None] * inv
        cos = jnp.cos(ang)[None, :, None, :]
        sin = jnp.sin(ang)[None, :, None, :]
        x1, x2 = xp[..., :half // 2], xp[..., half // 2:]
        return jnp.concatenate([x1 * cos - x2 * sin, x1 * sin + x2 * cos], axis=-1)

    return jnp.concatenate([rot(t[..., :half], pos // GRID_W), rot(t[..., half:], pos % GRID_W)], axis=-1)


def retention_scan(q, k, v, log_gamma, s0, include_diag):
    b, n, h, _ = q.shape
    nc = n // RET_CHUNK

    def chunks(t):
        return t.reshape(b, nc, RET_CHUNK, h, t.shape[-1]).transpose(1, 0, 3, 2, 4)

    idx = jnp.arange(RET_CHUNK, dtype=jnp.float32)
    diff = idx[:, None] - idx[None, :]
    keep = diff >= 0 if include_diag else diff > 0
    dmat = jnp.where(keep[None], jnp.exp(jnp.maximum(diff, 0.0)[None] * log_gamma[:, None, None]), 0.0)
    xi = jnp.exp((idx + 1.0)[None, :] * log_gamma[:, None])[..., None]
    zeta = jnp.exp((RET_CHUNK - 1.0 - idx)[None, :] * log_gamma[:, None])[..., None]
    g_chunk = jnp.exp(RET_CHUNK * log_gamma)[:, None, None]

    def step(s, inp):
        qc, kc, vc = inp
        scores = jnp.einsum('bhnd,bhmd->bhnm', qc, kc) * dmat
        y = jnp.einsum('bhnm,bhmv->bhnv', scores, vc) + jnp.einsum('bhnd,bhdv->bhnv', qc * xi, s)
        s = s * g_chunk + jnp.einsum('bhmd,bhmv->bhdv', kc * zeta, vc)
        return s, y

    s_fin, ys = lax.scan(step, s0, (chunks(q), chunks(k), chunks(v)))
    return ys.transpose(1, 0, 3, 2, 4).reshape(b, n, h, v.shape[-1]), s_fin


def retention_inputs(p, rotate):
    b, n, _ = p.shape
    q, k, v, g = jnp.split(p.astype(jnp.float32), 4, axis=-1)

    def heads(t):
        return t.reshape(b, n, RET_HEADS, RET_HEAD)

    q, k, v = heads(q), heads(k) * (RET_HEAD ** -0.5), heads(v)
    if rotate:
        q, k = rotary_2d(q), rotary_2d(k)
    return q, k, v, g


def retention_output(y, g, gn_w):
    b, n = y.shape[:2]
    yn = y * lax.rsqrt(jnp.mean(y * y, axis=-1, keepdims=True) + NORM_EPS)
    return yn.reshape(b, n, RET_WIDTH) * gn_w * jax.nn.silu(g)


def retention_mixer(p_c, p_x, log2_decay, gn_w, with_ctx):
    qc, kc, vc, gc = retention_inputs(p_c, False)
    qx, kx, vx, gx = retention_inputs(p_x, True)
    log_gamma = jnp.log1p(-jnp.exp2(-log2_decay.astype(jnp.float32)))
    s0 = jnp.zeros((p_x.shape[0], RET_HEADS, RET_HEAD, RET_HEAD), jnp.float32)

    def flip(t):
        return jnp.flip(t, axis=1)

    yc_f, sc_f = retention_scan(qc, kc, vc, log_gamma[0], s0, True)
    yx_f, _ = retention_scan(qx, kx, vx, log_gamma[0], sc_f, True)
    yc_b, sc_b = retention_scan(flip(qc), flip(kc), flip(vc), log_gamma[1], s0, False)
    yx_b, _ = retention_scan(flip(qx), flip(kx), flip(vx), log_gamma[1], sc_b, False)
    out_x = retention_output(yx_f + flip(yx_b), gx, gn_w)
    out_c = retention_output(yc_f + flip(yc_b), gc, gn_w) if with_ctx else None
    return out_c, out_x


def route(h, router_w, router_b):
    t = h.shape[0]
    scores = jax.nn.sigmoid((h @ router_w).astype(jnp.float32))
    biased = scores + router_b.astype(jnp.float32)
    grp = biased.reshape(t, N_GROUPS, EXPERTS_PER_GROUP)
    grp_score = jnp.sum(lax.top_k(grp, 2)[0], axis=-1)
    g_sel = jnp.argmax(grp_score, axis=-1)
    sel_idx = jnp.broadcast_to(g_sel[:, None, None], (t, 1, EXPERTS_PER_GROUP))
    in_grp = jnp.take_along_axis(grp, sel_idx, axis=1)[:, 0]
    _, local = lax.top_k(in_grp, TOP_K)
    expert = g_sel[:, None] * EXPERTS_PER_GROUP + local
    w = jnp.take_along_axis(scores, expert, axis=1)
    return expert, w / jnp.sum(w, axis=-1, keepdims=True)


def moe(h, router_w, router_b, w1, w2, layer):
    t, d = h.shape
    expert, gate = route(h, router_w, router_b)
    m = t * TOP_K
    e_flat = expert.reshape(-1)
    tok = jnp.repeat(jnp.arange(t, dtype=jnp.int32), TOP_K)
    order = jnp.argsort(e_flat)
    e_s = e_flat[order]
    counts = jnp.bincount(e_flat, length=N_EXPERTS)
    padded = (counts + MOE_BLOCK - 1) // MOE_BLOCK * MOE_BLOCK
    start = jnp.cumsum(counts) - counts
    pend = jnp.cumsum(padded)
    pstart = pend - padded
    dest = pstart[e_s] + jnp.arange(m, dtype=jnp.int32) - start[e_s]
    m_pad = -(-m // MOE_BLOCK) * MOE_BLOCK + N_EXPERTS * MOE_BLOCK
    n_blocks = m_pad // MOE_BLOCK
    row_tok = jnp.zeros((m_pad,), jnp.int32).at[dest].set(tok[order])
    row_w = jnp.zeros((m_pad,), h.dtype).at[dest].set(gate.reshape(-1)[order].astype(h.dtype))
    block_start = jnp.arange(n_blocks, dtype=jnp.int32) * MOE_BLOCK
    block_expert = jnp.minimum(jnp.searchsorted(pend, block_start, side='right'), N_EXPERTS - 1)
    xb = h[row_tok].reshape(n_blocks, MOE_BLOCK, d)

    def expert_block(args):
        xblk, e = args
        gu = xblk @ w1[layer, e]
        g_, u_ = jnp.split(gu, 2, axis=-1)
        return (jax.nn.silu(g_) * u_) @ w2[layer, e]

    yb = lax.map(expert_block, (xb, block_expert)).reshape(m_pad, d)
    return jnp.zeros_like(h).at[row_tok].add(yb * row_w[:, None])


def setup_inputs(seed: int = 0) -> dict:
    key = jax.random.key(seed)
    ks = jax.random.split(key, 28)
    f32 = jnp.float32

    def nrm(k, shape, s):
        return s * jax.random.normal(k, shape, f32)

    D = D_MODEL
    return {
        "x": nrm(ks[0], (BATCH, SEQ, D), 1.0),
        "c": nrm(ks[1], (BATCH, D), 1.0),
        "ctx": nrm(ks[2], (BATCH, CTX_LEN, D), 1.0),
        "c_ctx": nrm(ks[3], (D,), 1.0),
        "ada_w": nrm(ks[4], (DEPTH, D, 6 * D), 0.3 * D ** -0.5),
        "ada_b": nrm(ks[5], (DEPTH, 6 * D), 0.02),
        "norm1_g": 1.0 + nrm(ks[6], (DEPTH, D), 0.05),
        "norm2_g": 1.0 + nrm(ks[7], (DEPTH, D), 0.05),
        "w_in": nrm(ks[8], (DEPTH, D, P_IN), D ** -0.5),
        "shift_mu": jax.random.uniform(ks[9], (DEPTH, 4, RWKV_IN), f32, 0.0, 0.5),
        "rwkv_w0": jax.random.uniform(ks[10], (DEPTH, 2, RWKV_WIDTH), f32, -6.0, -1.0),
        "rwkv_w2": nrm(ks[11], (DEPTH, 2, DECAY_LORA, RWKV_WIDTH), 0.5 * DECAY_LORA ** -0.5),
        "rwkv_a0": nrm(ks[12], (DEPTH, 2, RWKV_WIDTH), 0.5),
        "rwkv_a2": nrm(ks[13], (DEPTH, 2, ICLR_LORA, RWKV_WIDTH), 0.5 * ICLR_LORA ** -0.5),
        "rwkv_g2": nrm(ks[14], (DEPTH, GATE_LORA, RWKV_WIDTH), GATE_LORA ** -0.5),
        "rwkv_k_k": 0.85 + nrm(ks[15], (DEPTH, RWKV_WIDTH), 0.05),
        "rwkv_k_a": 1.0 + nrm(ks[16], (DEPTH, RWKV_WIDTH), 0.05),
        "rwkv_r_k": nrm(ks[17], (DEPTH, RWKV_HEADS, RWKV_HEAD), 0.1),
        "rwkv_lnx_w": 1.0 + nrm(ks[18], (DEPTH, RWKV_WIDTH), 0.05),
        "rwkv_lnx_b": nrm(ks[19], (DEPTH, RWKV_WIDTH), 0.02),
        "ret_log2_decay": ((5.0 + jnp.arange(RET_HEADS, dtype=f32))[None, None, :]
                           + jnp.array([0.0, 0.5], f32)[None, :, None]
                           + nrm(ks[20], (DEPTH, 2, RET_HEADS), 0.1)),
        "ret_gn_w": 1.0 + nrm(ks[21], (DEPTH, RET_WIDTH), 0.05),
        "w_out": nrm(ks[22], (DEPTH, D, D), D ** -0.5),
        "router_w": nrm(ks[23], (D, N_EXPERTS), D ** -0.5),
        "router_b": nrm(ks[24], (N_EXPERTS,), 0.01),
        "moe_w1": nrm(ks[25], (DEPTH, N_EXPERTS, D, 2 * D_EXPERT), D ** -0.5),
        "moe_w2": nrm(ks[26], (DEPTH, N_EXPERTS, D_EXPERT, D), D_EXPERT ** -0.5),
        "final_g": 1.0 + nrm(ks[27], (D,), 0.05),
    }


def reference(x, c, ctx, c_ctx, ada_w, ada_b, norm1_g, norm2_g, w_in, shift_mu,
              rwkv_w0, rwkv_w2, rwkv_a0, rwkv_a2, rwkv_g2, rwkv_k_k, rwkv_k_a, rwkv_r_k,
              rwkv_lnx_w, rwkv_lnx_b, ret_log2_decay, ret_gn_w, w_out, router_w, router_b,
              moe_w1, moe_w2, final_g):
    b, n, d = x.shape
    rows = n // GRID_W
    n_ctx = ctx.shape[1]
    cx = ctx
    for l in range(DEPTH):
        last = l == DEPTH - 1
        mod_x = jax.nn.silu(c) @ ada_w[l] + ada_b[l]
        mod_c = jax.nn.silu(c_ctx) @ ada_w[l] + ada_b[l]
        sh1, sc1, gt1, sh2, sc2, gt2 = jnp.split(mod_x[:, None, :], 6, axis=-1)
        csh1, csc1, cgt1, csh2, csc2, cgt2 = jnp.split(mod_c, 6, axis=-1)

        h_x = rms_norm(x, norm1_g[l]) * (1.0 + sc1) + sh1
        h_c = rms_norm(cx, norm1_g[l]) * (1.0 + csc1) + csh1
        p = jnp.concatenate([h_c, h_x], axis=1) @ w_in[l]
        p_c, p_x = p[:, :n_ctx], p[:, n_ctx:]
        u_c = shift_seq(p_c[..., :RWKV_IN], shift_mu[l, 0], shift_mu[l, 1])
        u_x = shift_grid(p_x[..., :RWKV_IN], shift_mu[l], rows)
        ya_c, ya_x = rwkv7_mixer(u_c, u_x, rwkv_w0[l], rwkv_w2[l], rwkv_a0[l], rwkv_a2[l], rwkv_g2[l],
                                 rwkv_k_k[l], rwkv_k_a[l], rwkv_r_k[l], rwkv_lnx_w[l], rwkv_lnx_b[l],
                                 not last)
        yb_c, yb_x = retention_mixer(p_c[..., RWKV_IN:], p_x[..., RWKV_IN:], ret_log2_decay[l],
                                     ret_gn_w[l], not last)

        if last:
            y = jnp.concatenate([ya_x, yb_x], axis=-1).astype(x.dtype) @ w_out[l]
            x = x + gt1 * y
            h2 = rms_norm(x, norm2_g[l]) * (1.0 + sc2) + sh2
            f = moe(h2.reshape(-1, d), router_w, router_b, moe_w1, moe_w2, l).reshape(b, n, d)
            x = x + gt2 * f
        else:
            y_all = jnp.concatenate([jnp.concatenate([ya_c, yb_c], axis=-1),
                                     jnp.concatenate([ya_x, yb_x], axis=-1)], axis=1)
            y = y_all.astype(x.dtype) @ w_out[l]
            cx = cx + cgt1 * y[:, :n_ctx]
            x = x + gt1 * y[:, n_ctx:]
            h2 = jnp.concatenate([rms_norm(cx, norm2_g[l]) * (1.0 + csc2) + csh2,
                                  rms_norm(x, norm2_g[l]) * (1.0 + sc2) + sh2], axis=1)
            f = moe(h2.reshape(-1, d), router_w, router_b, moe_w1, moe_w2, l).reshape(b, n_ctx + n, d)
            cx = cx + cgt2 * f[:, :n_ctx]
            x = x + gt2 * f[:, n_ctx:]
    return rms_norm(x, final_g)
```

```cpp
#include <hip/hip_runtime.h>
#include <cstdio>
#include <cstdint>
#define REP_PHASE 63
#define GEMM_SP2 false
namespace pg8 {
#define PG8_LAS __attribute__((address_space(3)))
typedef unsigned short bf16_t;
typedef short bf16x8 __attribute__((ext_vector_type(8)));
typedef float f32x4 __attribute__((ext_vector_type(4)));
typedef unsigned u32x4 __attribute__((ext_vector_type(4)));
constexpr int BM = 256, BK = 64, HALF = 128, HTB = HALF * BK * 2  , STAGE_BYTES = 8 * HTB, NXCD = 8, WGM = 8;

__host__ __device__ __forceinline__ int lds_byte(int r, int c) { const int st = (r >> 4) * 2 + (c >> 5), rr = r & 15, cc = c & 31, ob = rr * 64 + cc * 2; return st * 1024 + (ob ^ (((ob >> 9) & 1) << 5)); }
__host__ __device__ __forceinline__ void stage_rc(int b, int& R, int& C) { const int st = b / 1024, sb = b % 1024, swz = sb ^ (((sb >> 9) & 1) << 5); R = (st >> 1) * 16 + swz / 64; C = (st & 1) * 32 + (swz % 64) / 2; }
__host__ __device__ __forceinline__ int perm32(int rho) { const int n = rho >> 4, i = rho & 15; return 8 * (i >> 2) + 4 * n + (i & 3); }

struct Unit { int pm, pn; };
struct Gemm { const bf16_t* A; const bf16_t* Bt; int M, N, K; };

struct StaticOrder {
    int nM, nN, nwg, G, c;
    __host__ __device__ void init(int M, int N, int G_, int c_) { nM = M / BM; nN = N / BM; nwg = nM * nN; G = G_; c = c_; }
    __host__ __device__ bool next(int i, Unit& u) const {
        const long L = (long)i * G + c; if (L >= nwg) return false;
        int wgid = (int)L; { const int q = nwg / NXCD, r = nwg % NXCD, xcd = wgid % NXCD, off = wgid / NXCD; wgid = (xcd < r ? xcd * (q + 1) : r * (q + 1) + (xcd - r) * q) + off; }
        const int nig = WGM * nN, gid = wgid / nig, fm = gid * WGM, gsz = (nM - fm) < WGM ? (nM - fm) : WGM;
        u.pm = fm + ((wgid % nig) % gsz); u.pn = (wgid % nig) / gsz; return true;
    }
    __device__ __forceinline__ void a_ready(const Unit&) const {}
    __device__ __forceinline__ void done(const Unit&) const {}
};

typedef float f32x2c __attribute__((ext_vector_type(2))); typedef __bf16 bf16x2c __attribute__((ext_vector_type(2)));
__device__ __forceinline__ unsigned cvt_pk_bf16(float lo, float hi) { const f32x2c v = {lo, hi}; return __builtin_bit_cast(unsigned, __builtin_convertvector(v, bf16x2c)); }
typedef float f32x2 __attribute__((ext_vector_type(2)));


struct EpiStoreBf16 {
    static constexpr bool PERM = true, AFTER_DRAIN = false;
    bf16_t* O; int ldc; int pn_mask;
    __device__ __forceinline__ void operator()(const f32x4 (&acc)[2][2][4][2], const Unit& u, int wr, int wc, int fr, int fq) const {
        const int row0 = u.pm * BM + wr * 64 + fr; const int col0 = (u.pn & pn_mask) * BM + wc * 32 + 8 * fq;
#pragma unroll
        for (int ai = 0; ai < 2; ++ai)
#pragma unroll
            for (int m = 0; m < 4; ++m) { bf16_t* rowp = O + (size_t)(row0 + ai * HALF + m * 16) * ldc + col0;
#pragma unroll
                for (int bj = 0; bj < 2; ++bj) { const f32x4 v0 = acc[ai][bj][m][0], v1 = acc[ai][bj][m][1];
                    u32x4 w; w.x = cvt_pk_bf16(v0[0], v0[1]); w.y = cvt_pk_bf16(v0[2], v0[3]); w.z = cvt_pk_bf16(v1[0], v1[1]); w.w = cvt_pk_bf16(v1[2], v1[3]);
                    *(u32x4*)(rowp + bj * HALF) = w; } }
    }
};
struct EpiSwiGLU {
    static constexpr bool PERM = true, AFTER_DRAIN = false;
    bf16_t* O; int ldc;
    __device__ __forceinline__ void operator()(const f32x4 (&acc)[2][2][4][2], const Unit& u, int wr, int wc, int fr, int fq) const {
        const int row0 = u.pm * BM + wr * 64 + fr; const int col0 = (u.pn & 7) * HALF + wc * 32 + 8 * fq;
#pragma unroll
        for (int ai = 0; ai < 2; ++ai)
#pragma unroll
            for (int m = 0; m < 4; ++m) { bf16_t* rowp = O + (size_t)(row0 + ai * HALF + m * 16) * ldc + col0;
                float r[8];
#pragma unroll
                for (int n = 0; n < 2; ++n)
#pragma unroll
                    for (int j = 0; j < 4; ++j) { const float g = acc[ai][0][m][n][j], up = acc[ai][1][m][n][j]; r[n * 4 + j] = g * up / (1.0f + __expf(-g)); }
                u32x4 w; w.x = cvt_pk_bf16(r[0], r[1]); w.y = cvt_pk_bf16(r[2], r[3]); w.z = cvt_pk_bf16(r[4], r[5]); w.w = cvt_pk_bf16(r[6], r[7]);
                *(u32x4*)rowp = w; }
    }
};
template <bool BASE_BF16> struct EpiResid {
    static constexpr bool PERM = false, AFTER_DRAIN = false;
    const void* base_c; const void* base_x; const float* gate_c; const float* gate_x; bf16_t* X; int ldc; int pm_off;
    __device__ __forceinline__ void operator()(const f32x4 (&acc)[2][2][4][2], const Unit& u, int wr, int wc, int fr, int fq) const {
        const int pmr = u.pm + pm_off; const int row0 = pmr * BM + wr * 64 + fr, col0 = u.pn * BM + wc * 32 + 4 * fq;
        const bool isc = (pmr == 0);
        const float* gate = isc ? gate_c : gate_x;
        const size_t boff = isc ? 0 : (size_t)BM * ldc;
        const void* base = isc ? base_c : base_x;
        f32x4 gv[2][2];
#pragma unroll
        for (int bj = 0; bj < 2; ++bj)
#pragma unroll
            for (int n = 0; n < 2; ++n) gv[bj][n] = *(const f32x4*)(gate + col0 + bj * HALF + n * 16);
#pragma unroll
        for (int ai = 0; ai < 2; ++ai)
#pragma unroll
            for (int m = 0; m < 4; ++m) { const size_t off = (size_t)(row0 + ai * HALF + m * 16) * ldc + col0;
#pragma unroll
                for (int bj = 0; bj < 2; ++bj)
#pragma unroll
                    for (int n = 0; n < 2; ++n) { f32x4 bs;
                        if (BASE_BF16) { const unsigned long long w = *(const unsigned long long*)((const bf16_t*)base + (off - boff) + bj * HALF + n * 16); const unsigned lo = (unsigned)w, hi = (unsigned)(w >> 32);
                            bs = (f32x4){__uint_as_float(lo << 16), __uint_as_float(lo & 0xffff0000u), __uint_as_float(hi << 16), __uint_as_float(hi & 0xffff0000u)}; }
                        else bs = *(const f32x4*)((const float*)base + (off - boff) + bj * HALF + n * 16);
                        const f32x4 o = bs + gv[bj][n] * acc[ai][bj][m][n];
                        *(unsigned long long*)(X + off + bj * HALF + n * 16) = (unsigned long long)cvt_pk_bf16(o[0], o[1]) | ((unsigned long long)cvt_pk_bf16(o[2], o[3]) << 32); } }
    }
};
struct MoeOrder {
    int n8, G, c; const int* tile_e;
    __device__ __forceinline__ bool next(int i, Unit& u) const {
        const long L = (long)i * G + c; if (L >= n8) return false;
        u.pm = (int)(L >> 3); u.pn = tile_e[u.pm] * 8 + (int)(L & 7); return true;
    }
    __device__ __forceinline__ void a_ready(const Unit&) const {}
    __device__ __forceinline__ void done(const Unit&) const {}
};
template <class Epi, class Sched, bool ALIGN_EPI = false, bool SP2 = false>
__device__ __forceinline__ void gemm_phase(PG8_LAS unsigned char* lds, const Gemm g, const Sched& S, const Epi& E) {
    int tid_ = threadIdx.x; asm volatile("" : "+v"(tid_));
    const int tid = tid_, wid = __builtin_amdgcn_readfirstlane(tid >> 6), lane = tid & 63, wr = wid >> 2, wc = wid & 3, fr = lane & 15, fq = lane >> 4;
    const int K = g.K, nt = K / BK;
    unsigned voffA[2], voffB[2];
#pragma unroll
    for (int i = 0; i < 2; ++i) { int R, C; stage_rc(tid * 16 + i * 8192, R, C); const int Rb = Epi::PERM ? ((R & ~31) + perm32(R & 31)) : R;
        voffA[i] = (unsigned)(R * K + C) * 2u; voffB[i] = (unsigned)(Rb * K + C) * 2u; }
    const size_t kstep = (size_t)(BK * 2);
    const size_t hstep = (size_t)HALF * K * 2;
    const size_t tstep = 2 * hstep;
    const unsigned ldsw = (unsigned)wid * 1024u;
    const int aoff = lds_byte(wr * 64 + fr, fq * 8), boff = lds_byte(wc * 32 + fr, fq * 8);
#define PG8_SA(b, h) (((b) * 2 + (h)) * HTB)
#define PG8_SB(b, h) ((4 + (b) * 2 + (h)) * HTB)
#define PG8_STAGE(bufoff, gbase, voff) do { _Pragma("unroll") for (int _i = 0; _i < 2; ++_i) \
        __builtin_amdgcn_global_load_lds((const unsigned*)((const char*)(gbase) + (voff)[_i]), (PG8_LAS unsigned*)(lds + (bufoff) + ldsw + _i * 8192), 16, 0, 0); } while (0)
#define PG8_LDA(dst, b, h) do { _Pragma("unroll") for (int m = 0; m < 4; ++m) _Pragma("unroll") for (int k = 0; k < 2; ++k) dst[m][k] = *(const PG8_LAS bf16x8*)(lds + PG8_SA(b, h) + aoff + m * 2048 + k * 1024); } while (0)
#define PG8_LDB(dst, b, h) do { _Pragma("unroll") for (int n = 0; n < 2; ++n) _Pragma("unroll") for (int k = 0; k < 2; ++k) dst[n][k] = *(const PG8_LAS bf16x8*)(lds + PG8_SB(b, h) + boff + n * 2048 + k * 1024); } while (0)
#define PG8_MMA(ai, bj, At, Bt) do { __builtin_amdgcn_s_setprio(1); _Pragma("unroll") for (int m = 0; m < 4; ++m) _Pragma("unroll") for (int n = 0; n < 2; ++n) _Pragma("unroll") for (int k = 0; k < 2; ++k) \
        acc[ai][bj][m][n] = __builtin_amdgcn_mfma_f32_16x16x32_bf16(Bt[n][k], At[m][k], acc[ai][bj][m][n], 0, 0, 0); __builtin_amdgcn_s_setprio(0); } while (0)
#define PG8_WAIT_V(n) asm volatile("s_waitcnt vmcnt(" #n ")" ::: "memory")
#define PG8_WAIT_L(n) asm volatile("s_waitcnt lgkmcnt(" #n ")" ::: "memory")
#define PG8_BAR __builtin_amdgcn_s_barrier()
#define PG8_SCHED __builtin_amdgcn_sched_barrier(0)
    Unit cur, nxt; int ui = 0;
    if (!S.next(0, cur)) return;
    f32x4 acc[2][2][4][2];
#pragma unroll
    for (int a = 0; a < 2; ++a)
#pragma unroll
        for (int b = 0; b < 2; ++b)
#pragma unroll
            for (int m = 0; m < 4; ++m)
#pragma unroll
                for (int n = 0; n < 2; ++n) acc[a][b][m][n] = (f32x4){0.f, 0.f, 0.f, 0.f};
    bf16x8 At[4][2], B0[2][2], B1[2][2];
    const char* cA = (const char*)g.A + (size_t)cur.pm * tstep; const char* cB = (const char*)g.Bt + (size_t)cur.pn * tstep;
    S.a_ready(cur);
    if constexpr (SP2) {
        PG8_STAGE(PG8_SB(0, 0), cB, voffB); PG8_STAGE(PG8_SB(0, 1), cB + hstep, voffB); PG8_STAGE(PG8_SA(0, 0), cA, voffA); PG8_STAGE(PG8_SA(0, 1), cA + hstep, voffA);
        if (wr == 1) PG8_BAR;
        PG8_WAIT_V(2); PG8_BAR;
        PG8_STAGE(PG8_SB(1, 0), cB + kstep, voffB); PG8_STAGE(PG8_SA(1, 0), cA + kstep, voffA); PG8_STAGE(PG8_SB(1, 1), cB + hstep + kstep, voffB);
        PG8_WAIT_V(6); PG8_BAR;
    } else {
        PG8_STAGE(PG8_SB(0, 0), cB, voffB); PG8_STAGE(PG8_SA(0, 0), cA, voffA); PG8_STAGE(PG8_SB(0, 1), cB + hstep, voffB); PG8_STAGE(PG8_SA(0, 1), cA + hstep, voffA);
        if (wr == 1) PG8_BAR;
        PG8_WAIT_V(4); PG8_BAR;
        PG8_STAGE(PG8_SB(1, 0), cB + kstep, voffB); PG8_STAGE(PG8_SA(1, 0), cA + kstep, voffA); PG8_STAGE(PG8_SB(1, 1), cB + hstep + kstep, voffB);
        PG8_WAIT_V(6); PG8_BAR;
    }
    for (;;) {
        const bool has_next = S.next(ui + 1, nxt);
        const char* nA = has_next ? (const char*)g.A + (size_t)nxt.pm * tstep : cA; const char* nB = has_next ? (const char*)g.Bt + (size_t)nxt.pn * tstep : cB;
        for (int t = 0; t < nt; t += 2) {
            const bool last = (t == nt - 2);
            const char* a1 = cA + (size_t)(t + 1) * kstep;
            const char* a2 = last ? nA : cA + (size_t)(t + 2) * kstep; const char* b2 = last ? nB : cB + (size_t)(t + 2) * kstep;
            const char* a3 = a2 + kstep; const char* b3 = b2 + kstep;
            if (last && has_next) S.a_ready(nxt);
            if constexpr (SP2) {
            PG8_LDB(B0, 0, 0); PG8_LDB(B1, 0, 1); PG8_SCHED; PG8_LDA(At, 0, 0); PG8_STAGE(PG8_SA(1, 1), a1 + hstep, voffA);
            PG8_WAIT_V(8); PG8_WAIT_L(0); PG8_BAR; PG8_MMA(0, 0, At, B0); PG8_MMA(0, 1, At, B1); PG8_BAR; PG8_SCHED;
            PG8_LDA(At, 0, 1); PG8_STAGE(PG8_SB(0, 0), b2, voffB); PG8_STAGE(PG8_SB(0, 1), b2 + hstep, voffB); PG8_STAGE(PG8_SA(0, 0), a2, voffA);
            PG8_WAIT_V(8); PG8_WAIT_L(0); PG8_BAR; PG8_MMA(1, 0, At, B0); PG8_MMA(1, 1, At, B1); PG8_BAR; PG8_SCHED;
            PG8_LDB(B0, 1, 0); PG8_LDB(B1, 1, 1); PG8_SCHED; PG8_LDA(At, 1, 0); PG8_STAGE(PG8_SA(0, 1), a2 + hstep, voffA);
            PG8_WAIT_V(8); PG8_WAIT_L(0); PG8_BAR; PG8_MMA(0, 0, At, B0); PG8_MMA(0, 1, At, B1); PG8_BAR; PG8_SCHED;
            PG8_LDA(At, 1, 1); PG8_STAGE(PG8_SB(1, 0), b3, voffB); PG8_STAGE(PG8_SB(1, 1), b3 + hstep, voffB); PG8_STAGE(PG8_SA(1, 0), a3, voffA);
            PG8_WAIT_V(8); PG8_WAIT_L(0); PG8_BAR; PG8_MMA(1, 0, At, B0); PG8_MMA(1, 1, At, B1); PG8_BAR; PG8_SCHED;
            } else {
            PG8_LDB(B0, 0, 0); PG8_SCHED; PG8_LDA(At, 0, 0); PG8_STAGE(PG8_SA(1, 1), a1 + hstep, voffA);
            PG8_WAIT_L(8); PG8_BAR; PG8_WAIT_L(0); PG8_MMA(0, 0, At, B0); PG8_BAR; PG8_SCHED;
            PG8_LDB(B1, 0, 1); PG8_STAGE(PG8_SB(0, 0), b2, voffB);
            PG8_BAR; PG8_WAIT_L(0); PG8_MMA(0, 1, At, B1); PG8_BAR;
            PG8_LDA(At, 0, 1); PG8_STAGE(PG8_SA(0, 0), a2, voffA);
            PG8_BAR; PG8_WAIT_L(0); PG8_MMA(1, 0, At, B0); PG8_BAR; PG8_SCHED;
            PG8_STAGE(PG8_SB(0, 1), b2 + hstep, voffB);
            PG8_WAIT_V(6); PG8_BAR; PG8_MMA(1, 1, At, B1); PG8_BAR;
            PG8_LDB(B0, 1, 0); PG8_SCHED; PG8_LDA(At, 1, 0); PG8_STAGE(PG8_SA(0, 1), a2 + hstep, voffA);
            PG8_WAIT_L(8); PG8_BAR; PG8_WAIT_L(0); PG8_MMA(0, 0, At, B0); PG8_BAR; PG8_SCHED;
            PG8_LDB(B1, 1, 1); PG8_STAGE(PG8_SB(1, 0), b3, voffB);
            PG8_BAR; PG8_WAIT_L(0); PG8_MMA(0, 1, At, B1); PG8_BAR;
            PG8_LDA(At, 1, 1); PG8_STAGE(PG8_SA(1, 0), a3, voffA);
            PG8_BAR; PG8_WAIT_L(0); PG8_MMA(1, 0, At, B0); PG8_BAR; PG8_SCHED;
            PG8_STAGE(PG8_SB(1, 1), b3 + hstep, voffB);
            PG8_WAIT_V(6); PG8_BAR; PG8_MMA(1, 1, At, B1); PG8_BAR;
            }
        }
        if constexpr (ALIGN_EPI) { if (wr == 0) PG8_BAR; }
        if constexpr (!Epi::AFTER_DRAIN) { E(acc, cur, wr, wc, fr, fq); S.done(cur); }
        if (!has_next) break;
#pragma unroll
        for (int a = 0; a < 2; ++a)
#pragma unroll
            for (int b = 0; b < 2; ++b)
#pragma unroll
                for (int m = 0; m < 4; ++m)
#pragma unroll
                    for (int n = 0; n < 2; ++n) acc[a][b][m][n] = (f32x4){0.f, 0.f, 0.f, 0.f};
        cur = nxt; cA = nA; cB = nB; ++ui;
        if constexpr (ALIGN_EPI) { if (wr == 1) PG8_BAR; }
    }
    PG8_WAIT_V(0);
    if constexpr (!ALIGN_EPI) { if (wr == 0) PG8_BAR; }
    PG8_BAR;
    if constexpr (Epi::AFTER_DRAIN) { E.fused(acc, cur, wr, wc, fr, fq, lds, wid, lane); S.done(cur); }
#undef PG8_SA
#undef PG8_SB
#undef PG8_STAGE
#undef PG8_LDA
#undef PG8_LDB
#undef PG8_MMA
#undef PG8_WAIT_V
#undef PG8_WAIT_L
#undef PG8_BAR
#undef PG8_SCHED
}
}


#ifndef MK_N_LAUNCHES
#define MK_N_LAUNCHES 1
#endif

#define GAS __attribute__((address_space(1)))
#define LAS __attribute__((address_space(3)))
#define CAS __attribute__((address_space(4)))
typedef unsigned short bf16;
typedef unsigned v4u __attribute__((ext_vector_type(4)));
typedef unsigned v2u __attribute__((ext_vector_type(2)));
typedef float f32x4 __attribute__((ext_vector_type(4)));
typedef short bf16x8 __attribute__((ext_vector_type(8)));

constexpr int D = 2048, TC = 256, TL = 16384, T = TC + TL;
constexpr int NL = 2;
constexpr int PIN = 7584, PW = 7680, RWIN = 3488, RET_OFF = 3584;
constexpr int LK = 512, LNN = 5120;
constexpr int NCH = 130;
constexpr int NE = 32, MPAD = 41472, MAXTILES = MPAD / 256;
constexpr int NWAVES = 8, NTHR = 512;
constexpr int KP = 16;

constexpr size_t al256(size_t x) { return (x + 255) & ~(size_t)255; }
constexpr size_t WS_CTL = 0, CTL_BYTES = 1u << 20;
constexpr size_t WS_MODP = CTL_BYTES;
constexpr size_t WS_MOD  = WS_MODP + al256((size_t)NL * KP * 2 * 12288 * 4);
constexpr size_t WS_WIN  = WS_MOD + al256((size_t)NL * 2 * 12288 * 4);
constexpr size_t WS_WOUT = WS_WIN + al256((size_t)NL * PW * D * 2);
constexpr size_t WS_LB   = WS_WOUT + al256((size_t)NL * D * D * 2);
constexpr size_t WS_W1   = WS_LB + al256((size_t)NL * LNN * LK * 2);
constexpr size_t WS_W2   = WS_W1 + al256((size_t)NL * NE * 2048 * 2048 * 2);
constexpr size_t WS_X    = WS_W2 + al256((size_t)NL * NE * 2048 * 1024 * 2);
constexpr size_t WS_XN   = WS_X + al256((size_t)T * D * 4);
constexpr size_t WS_H    = WS_XN + al256((size_t)T * D * 4);
constexpr size_t WS_P    = WS_H + al256((size_t)T * D * 2);
constexpr size_t WS_LA   = WS_P + al256((size_t)T * PW * 2);
constexpr size_t WS_LORA = WS_LA + al256((size_t)T * LK * 2);
constexpr size_t SZ_S    = al256((size_t)T * 1024 * 4);
constexpr size_t SZ_CK   = al256((size_t)32 * 520 * 2048 * 2);
constexpr size_t SZ_CM   = al256((size_t)32 * 520 * 1024 * 2);
constexpr size_t WS_AGP  = WS_LORA + al256((size_t)T * LNN * 2);
constexpr size_t WS_RGP  = WS_AGP + SZ_CK, WS_BGI = WS_RGP + SZ_CK, WS_KGI = WS_BGI + SZ_CK, WS_KGT = WS_KGI + SZ_CK, WS_BGT = WS_KGT + SZ_CK, WS_VTP = WS_BGT + SZ_CK;
constexpr size_t WS_TP   = WS_VTP + SZ_CK, WS_AAK = WS_TP + SZ_CM, WS_ARK = WS_AAK + SZ_CM, WS_ARB = WS_ARK + SZ_CM;
constexpr size_t WS_GC   = WS_ARB + SZ_CM;
constexpr size_t WS_VTOK = WS_GC + al256((size_t)32 * 520 * 256 * 4);
constexpr size_t WS_SY   = WS_VTOK + al256((size_t)2 * T * 1024 * 2);
constexpr size_t WS_BON  = WS_SY + 2 * SZ_S;
constexpr size_t WS_KNRM = WS_BON + al256((size_t)2 * T * 16 * 4 * 4);
constexpr size_t SZ_RT   = al256((size_t)T * 1024 * 2);
constexpr size_t WS_SCT  = WS_KNRM + al256((size_t)T * 16 * 4);
constexpr size_t WS_RT   = WS_SCT + al256((size_t)320 * 32 * 2 * 4);
constexpr size_t WS_QR   = WS_RT + al256((size_t)2 * 32 * 2048 * 2);
constexpr size_t WS_KR   = WS_QR + SZ_RT, WS_VT = WS_KR + SZ_RT, WS_KTF = WS_VT + SZ_RT, WS_KTB = WS_KTF + SZ_RT;
constexpr size_t WS_KVT  = WS_KTB + SZ_RT;
constexpr size_t WS_ST   = WS_KVT + al256((size_t)2 * 8 * NCH * 16384 * 4);
constexpr size_t WS_YALL = WS_ST + al256((size_t)2 * 8 * NCH * 16384 * 2);
constexpr size_t WS_RE   = WS_YALL + al256((size_t)T * D * 2);
constexpr size_t WS_RWT  = WS_RE + al256((size_t)T * 2 * 4);
constexpr size_t WS_RI   = WS_RWT + al256((size_t)T * 2 * 4);
constexpr size_t WS_DEST = WS_RI + al256((size_t)T * 2 * 4);
constexpr size_t WS_TILE = WS_DEST + al256((size_t)T * 2 * 4);
constexpr size_t WS_XB   = WS_TILE + 1024;
constexpr size_t WS_ACT  = WS_XB + al256((size_t)MPAD * D * 2);
constexpr size_t WS_YB   = WS_ACT + al256((size_t)MPAD * 1024 * 2);
constexpr size_t WS_END  = WS_YB + al256((size_t)MPAD * D * 2);
constexpr int CW_BAR = 4096;
constexpr int CW_CNT = 8192;

constexpr int RING_BYTES = 131072, EXTRA_OFF = RING_BYTES, EXTRA_BYTES = 24576, MISC_OFF = EXTRA_OFF + EXTRA_BYTES, LDS_BYTES = MISC_OFF + 256;

__device__ __forceinline__ float bf_lo(unsigned w) { return __uint_as_float(w << 16); }
__device__ __forceinline__ float bf_hi(unsigned w) { return __uint_as_float(w & 0xffff0000u); }
__device__ __forceinline__ unsigned pk2(float lo, float hi) { return pg8::cvt_pk_bf16(lo, hi); }
__device__ __forceinline__ unsigned short f2bf1(float f) { return (unsigned short)(pg8::cvt_pk_bf16(f, 0.f) & 0xffffu); }
__device__ __forceinline__ float wave_sum(float v) {
#pragma unroll
    for (int o = 1; o < 64; o <<= 1) v += __shfl_xor(v, o);
    return v;
}
template <int CTRL> __device__ __forceinline__ float dppf(float v) { return __builtin_bit_cast(float, __builtin_amdgcn_update_dpp(0, __builtin_bit_cast(int, v), CTRL, 0xf, 0xf, true)); }
__device__ __forceinline__ float quadsum(float v) { v += dppf<0xB1>(v); v += dppf<0x4E>(v); return v; }
__device__ __forceinline__ float rowsum16(float v) { v += dppf<0xB1>(v); v += dppf<0x4E>(v); v += dppf<0x141>(v); v += dppf<0x140>(v); return v; }
__device__ __forceinline__ float sigmoidf_(float x) { return 1.0f / (1.0f + __expf(-x)); }
#define LDS_WAIT() asm volatile("s_waitcnt lgkmcnt(0)" ::: "memory")

#define XB_TMO      128
#define XB_XCNT(j)  (256  + 64 * (j))
#define XB_XSUB(j)  (1280 + 64 * (j))
#define XB_XGEN(j)  (2304 + 64 * (j))
#define XB_TOP      3328
#define XB_TOPGEN   3392
#define XCD_BAR_WORDS 3456
#define XB_SPIN_CAP (1u << 20)
__device__ __forceinline__ unsigned xb_ld(unsigned* p)              { return __hip_atomic_load(p, __ATOMIC_RELAXED, __HIP_MEMORY_SCOPE_AGENT); }
__device__ __forceinline__ unsigned xb_add(unsigned* p, unsigned v) { return __hip_atomic_fetch_add(p, v, __ATOMIC_RELAXED, __HIP_MEMORY_SCOPE_AGENT); }
__device__ __forceinline__ unsigned xb_xcc_id() { return (unsigned)__builtin_amdgcn_s_getreg((3 << 11) | 20) & 0xFu; }
#define XB_SPIN(cond, bar) do { unsigned _sp = 0; while (cond) { __builtin_amdgcn_s_sleep(1); \
    if ((++_sp & 255u) == 0u) { if (xb_ld(&(bar)[XB_TMO])) break; if (_sp > XB_SPIN_CAP) { atomicAdd(&(bar)[XB_TMO], 1u); break; } } } } while (0)
struct XcdBarrier { unsigned* bar; unsigned x; volatile LAS unsigned* st; };
__device__ __forceinline__ XcdBarrier xcd_barrier_post(unsigned* bar, volatile LAS unsigned* st) {
    XcdBarrier b; b.bar = bar; b.x = xb_xcc_id(); b.st = st;
    if (threadIdx.x == 0) (void)xb_add(&bar[XB_XCNT(b.x)], 1u);
    return b;
}
__device__ __forceinline__ void xcd_barrier_complete(unsigned* bar, unsigned x, unsigned& nloc, unsigned& nx) {
    const unsigned G = gridDim.x * gridDim.y * gridDim.z;
    unsigned sum, cnt, mine, sp = 0u;
    for (;;) {
        sum = 0u; cnt = 0u; mine = 0u;
#pragma unroll
        for (unsigned j = 0; j < 16; ++j) { const unsigned c = xb_ld(&bar[XB_XCNT(j)]); sum += c; cnt += (c > 0u) ? 1u : 0u; mine = (j == x) ? c : mine; }
        if (sum == G) break;
        __builtin_amdgcn_s_sleep(1);
        if ((++sp & 255u) == 0u) { if (xb_ld(&bar[XB_TMO])) break; if (sp > XB_SPIN_CAP) { atomicAdd(&bar[XB_TMO], 1u); break; } }
    }
    nloc = mine > 0u ? mine : 1u; nx = cnt > 0u ? cnt : 1u;
}
__device__ __forceinline__ void xcd_barrier(const XcdBarrier& b) {
    asm volatile("s_waitcnt vmcnt(0)" ::: "memory");
    __syncthreads();
    if (threadIdx.x == 0) {
        unsigned* bar = b.bar; asm volatile("" : "+s"(bar));
        __builtin_amdgcn_s_waitcnt(0);
        unsigned nloc = b.st[0], nx = b.st[1];
        if (nloc == 0u) { xcd_barrier_complete(bar, b.x, nloc, nx); b.st[0] = nloc; b.st[1] = nx; }
        const unsigned old = xb_add(&bar[XB_XSUB(b.x)], 1u);
        const unsigned gen = old / nloc;
        if (old + 1u == (gen + 1u) * nloc) {
            __builtin_amdgcn_fence(__ATOMIC_RELEASE, "agent");
            asm volatile("s_waitcnt vmcnt(0)" ::: "memory");
            const unsigned og = xb_add(&bar[XB_TOP], 1u);
            const unsigned tg = og / nx;
            if (og + 1u == (tg + 1u) * nx) xb_add(&bar[XB_TOPGEN], 1u);
            else XB_SPIN(xb_ld(&bar[XB_TOPGEN]) == tg, bar);
            __builtin_amdgcn_fence(__ATOMIC_ACQUIRE, "agent");
            xb_add(&bar[XB_XGEN(b.x)], 1u);
            asm volatile("s_waitcnt vmcnt(0)" ::: "memory");
        } else {
            XB_SPIN(xb_ld(&bar[XB_XGEN(b.x)]) == gen, bar);
            __builtin_amdgcn_fence(__ATOMIC_ACQUIRE, "agent");
            asm volatile("s_waitcnt vmcnt(0)" ::: "memory");
        }
    }
    __syncthreads();
}

struct Args { const float* in[28]; float* out; unsigned char* ws; int ph_lo, ph_hi; };
enum { I_X = 0, I_C, I_CTX, I_CCTX, I_ADAW, I_ADAB, I_N1G, I_N2G, I_WIN, I_MU, I_W0, I_W2, I_A0, I_A2, I_G2, I_KK, I_KA, I_RK, I_LNW, I_LNB, I_L2D, I_GNW, I_WOUT, I_RTW, I_RTB, I_MW1, I_MW2, I_FG };

struct Ctx {
    LAS unsigned char* lds;
    int tid, lane, wave, G, bx, gw, NGW;
};

__device__ __forceinline__ void tr_item(const float* W, int K, int N, bf16* WT, int k0, int n0, int orow0, LAS float* scr, int lane) {
#pragma unroll 8
    for (int i = 0; i < 32; ++i) { const int kk = 2 * i + (lane >> 5); scr[kk * 33 + (lane & 31)] = W[(size_t)(k0 + kk) * N + n0 + (lane & 31)]; }
    LDS_WAIT();
    const int c = lane & 7;
#pragma unroll
    for (int j = 0; j < 4; ++j) { const int n = (lane >> 3) + 8 * j; const LAS float* s = scr + (8 * c) * 33 + n;
        v4u o; o.x = pk2(s[0 * 33], s[1 * 33]); o.y = pk2(s[2 * 33], s[3 * 33]); o.z = pk2(s[4 * 33], s[5 * 33]); o.w = pk2(s[6 * 33], s[7 * 33]);
        *(v4u*)(WT + (size_t)(orow0 + n) * K + k0 + 8 * c) = o; }
    LDS_WAIT();
}
__device__ __forceinline__ void ph_prologue(const Args& a, const Ctx& C) {
    unsigned char* ws = a.ws;
    LAS float* scr = (LAS float*)(C.lds + C.wave * 16384);
    constexpr int IW_IN = 32 * 237, IW_OUT = 32 * 64, PER = IW_IN + IW_OUT;
    for (int it = C.gw; it < NL * PER; it += C.NGW) {
        const int l = it / PER; int r = it % PER;
        if (r < IW_IN) { const int kb = r / 237, nb = r % 237, n0 = 32 * nb;
            tr_item(a.in[I_WIN] + (size_t)l * D * PIN, D, PIN, (bf16*)(ws + WS_WIN) + (size_t)l * PW * D, 64 * kb, n0, n0 < RWIN ? n0 : n0 + (RET_OFF - RWIN), scr, C.lane); continue; }
        r -= IW_IN;
        { const int kb = r / 64, nb = r % 64;
            tr_item(a.in[I_WOUT] + (size_t)l * D * D, D, D, (bf16*)(ws + WS_WOUT) + (size_t)l * D * D, 64 * kb, 32 * nb, 32 * nb, scr, C.lane); }
    }
    const int gtid = C.gw * 64 + C.lane, NGT = C.NGW * 64;
    for (int i = gtid; i < NL * 96 * (D / 8); i += NGT) { const int l = i / (96 * 256), r = (i / 256) % 96, c8 = i % 256;
        *(v4u*)((bf16*)(ws + WS_WIN) + ((size_t)l * PW + RWIN + r) * D + 8 * c8) = (v4u){0u, 0u, 0u, 0u}; }
    for (int i = gtid; i < NL * LNN * (LK / 8); i += NGT) {
        const int l = i / (LNN * 64), n = (i / 64) % LNN, k0 = 8 * (i % 64);
        const int blk = n >> 10, nn = n & 1023;
        float v[8];
#pragma unroll
        for (int j = 0; j < 8; ++j) { const int k = k0 + j; float x = 0.f;
            if (blk < 2) { if ((k >> 6) == blk) x = a.in[I_W2][((size_t)(l * 2 + blk) * 64 + (k & 63)) * 1024 + nn]; }
            else if (blk < 4) { if ((k >> 6) == blk) x = a.in[I_A2][((size_t)(l * 2 + (blk - 2)) * 64 + (k & 63)) * 1024 + nn]; }
            else { if (k >= 256 && k < 416) x = a.in[I_G2][((size_t)l * 160 + (k - 256)) * 1024 + nn]; }
            v[j] = x; }
        *(v4u*)((bf16*)(ws + WS_LB) + ((size_t)l * LNN + n) * LK + k0) = (v4u){pk2(v[0], v[1]), pk2(v[2], v[3]), pk2(v[4], v[5]), pk2(v[6], v[7])};
    }
    for (int i = gtid; i < 32 * 2048; i += NGT) { const int e = i >> 11, k = i & 2047; const float w = a.in[I_RTW][(size_t)k * 32 + e];
        const unsigned short hi = f2bf1(w); const float hf = __uint_as_float((unsigned)hi << 16);
        bf16* rt = (bf16*)(ws + WS_RT); rt[i] = hi; rt[32 * 2048 + i] = f2bf1(w - hf); }
    for (int i = gtid; i < 320 * 32; i += NGT) { const int pv = i >> 5, fi = i & 31; const float ang = (float)(pv < 256 ? pv : pv - 256) * exp2f(-(float)(2 * fi) * (13.287712379549449f / 64.0f));
        float* sct = (float*)(ws + WS_SCT); sct[2 * i] = cosf(ang); sct[2 * i + 1] = sinf(ang); }
    for (int it = C.gw; it < NL * KP * 48; it += C.NGW) {
        const int l = it / (KP * 48), kp = (it / 48) % KP, jb = it % 48;
        const int kb = 128 * kp;
        { const float c0 = a.in[I_C][kb + C.lane], c1 = a.in[I_C][kb + 64 + C.lane], x0 = a.in[I_CCTX][kb + C.lane], x1 = a.in[I_CCTX][kb + 64 + C.lane];
          scr[C.lane] = c0 * sigmoidf_(c0); scr[64 + C.lane] = c1 * sigmoidf_(c1); scr[128 + C.lane] = x0 * sigmoidf_(x0); scr[192 + C.lane] = x1 * sigmoidf_(x1); }
        LDS_WAIT();
        f32x4 ax = {0.f, 0.f, 0.f, 0.f}, ac = {0.f, 0.f, 0.f, 0.f};
        const float* wp = a.in[I_ADAW] + ((size_t)l * D + kb) * 12288 + 256 * jb + 4 * C.lane;
#pragma unroll 8
        for (int k = 0; k < 128; ++k) { const f32x4 w = *(const f32x4*)(wp + (size_t)k * 12288); const float sx = scr[k], sc = scr[128 + k]; ax += w * sx; ac += w * sc; }
        float* mp = (float*)(ws + WS_MODP) + ((size_t)(l * KP + kp) * 2) * 12288 + 256 * jb + 4 * C.lane;
        *(f32x4*)mp = ax; *(f32x4*)(mp + 12288) = ac;
        LDS_WAIT();
    }
}

__device__ __forceinline__ void ph_convert_moe(const Args& a, const Ctx& C, int l, int wid, int nw, LAS float* scr) {
    unsigned char* ws = a.ws;
    constexpr int IW_1 = 32 * 32 * 64, IW_2 = 32 * 16 * 64;
    for (int it = wid; it < IW_1 + IW_2; it += nw) {
        int r = it;
        if (r < IW_1) { const int e = r / 2048, rr = r % 2048, kb = rr / 64, nb = rr % 64, n0 = 32 * nb;
            const int orow = n0 < 1024 ? 256 * (n0 >> 7) + (n0 & 127) : 256 * ((n0 - 1024) >> 7) + 128 + ((n0 - 1024) & 127);
            tr_item(a.in[I_MW1] + (size_t)(l * NE + e) * 2048 * 2048, 2048, 2048, (bf16*)(ws + WS_W1) + (size_t)(l * NE + e) * 2048 * 2048, 64 * kb, n0, orow, scr, C.lane); continue; }
        r -= IW_1;
        { const int e = r / 1024, rr = r % 1024, kb = rr / 64, nb = rr % 64;
            tr_item(a.in[I_MW2] + (size_t)(l * NE + e) * 1024 * 2048, 1024, 2048, (bf16*)(ws + WS_W2) + (size_t)(l * NE + e) * 2048 * 1024, 64 * kb, 32 * nb, 32 * nb, scr, C.lane); }
    }
}
__device__ __forceinline__ float mod_from_partials(const Args& a, int l, int which, int j) {
    float s = a.in[I_ADAB][l * 12288 + j];
    const float* mp = (const float*)(a.ws + WS_MODP) + ((size_t)(l * KP) * 2 + which) * 12288 + j;
#pragma unroll
    for (int kp = 0; kp < KP; ++kp) s += mp[(size_t)kp * 2 * 12288];
    return s;
}

__device__ __forceinline__ const float* xrow_ptr(const Args& a, int l, int r) {
    if (l == 0) return r < TC ? a.in[I_CTX] + (size_t)r * D : a.in[I_X] + (size_t)(r - TC) * D;
    return (const float*)(a.ws + WS_XN) + (size_t)r * D;
}
__device__ __forceinline__ void ph_norm1(const Args& a, const Ctx& C, int l) {
    LAS float* GV = (LAS float*)C.lds;
    if (l == 0) {
        float* modf = (float*)(a.ws + WS_MOD);
        for (int i = C.bx * NTHR + C.tid; i < NL * 2 * 12288; i += C.G * NTHR) { const int ll = i / (2 * 12288), wh = (i / 12288) & 1, j = i % 12288; modf[i] = mod_from_partials(a, ll, wh, j); }
    }
    for (int i = C.tid; i < 2 * D; i += NTHR) { const int wh = i / D, k = i % D;
        const float sh = mod_from_partials(a, l, wh, k), sc = mod_from_partials(a, l, wh, D + k);
        GV[wh * D + k] = a.in[I_N1G][l * D + k] * (1.0f + sc); GV[2 * D + wh * D + k] = sh; }
    __syncthreads();
    bf16* H = (bf16*)(a.ws + WS_H);
    for (int r = C.gw; r < T; r += C.NGW) {
        const float* xr = xrow_ptr(a, l, r); const int wh = r < TC ? 1 : 0;
        f32x4 v[8]; float ss = 0.f;
#pragma unroll
        for (int j = 0; j < 8; ++j) { v[j] = *(const f32x4*)(xr + 4 * C.lane + 256 * j); ss += v[j].x * v[j].x + v[j].y * v[j].y + v[j].z * v[j].z + v[j].w * v[j].w; }
        const float rstd = rsqrtf(wave_sum(ss) * (1.0f / D) + 1e-6f);
#pragma unroll
        for (int j = 0; j < 8; ++j) { const int k = 4 * C.lane + 256 * j;
            const f32x4 g = *(const LAS f32x4*)(GV + wh * D + k), s = *(const LAS f32x4*)(GV + 2 * D + wh * D + k);
            const f32x4 h = v[j] * rstd * g + s;
            *(v2u*)(H + (size_t)r * D + k) = (v2u){pk2(h.x, h.y), pk2(h.z, h.w)}; }
    }
    __syncthreads();
}

__device__ __forceinline__ void shift_rows(int t, int (&nb)[4], int& nn) {
    const bool isc = t < TC; const int p = t - TC, gc = p & 63, gr = p >> 6;
    nn = isc ? 2 : 4;
    nb[0] = isc ? (t > 0 ? t - 1 : -1) : (gc > 0 ? t - 1 : -1);
    nb[1] = isc ? (t < TC - 1 ? t + 1 : -1) : (gc < 63 ? t + 1 : -1);
    nb[2] = isc ? -1 : (gr > 0 ? t - 64 : -1);
    nb[3] = isc ? -1 : (gr < 255 ? t + 64 : -1);
}
__device__ __forceinline__ void shift8(const bf16* P, const float* mu  , int t, int col0, const int (&nb)[4], int nn, float (&u)[8]) {
    const v4u pc = *(const v4u*)(P + (size_t)t * PW + col0);
    v4u q[4];
#pragma unroll
    for (int j = 0; j < 4; ++j) q[j] = *(const v4u*)(P + (size_t)(nb[j] >= 0 ? nb[j] : t) * PW + col0);
    float p[8] = {bf_lo(pc.x), bf_hi(pc.x), bf_lo(pc.y), bf_hi(pc.y), bf_lo(pc.z), bf_hi(pc.z), bf_lo(pc.w), bf_hi(pc.w)};
#pragma unroll
    for (int i = 0; i < 8; ++i) u[i] = p[i];
#pragma unroll
    for (int j = 0; j < 4; ++j) {
        const float on = (j < nn) ? 1.0f : 0.0f, has = (nb[j] >= 0) ? 1.0f : 0.0f;
        const float n8[8] = {bf_lo(q[j].x), bf_hi(q[j].x), bf_lo(q[j].y), bf_hi(q[j].y), bf_lo(q[j].z), bf_hi(q[j].z), bf_lo(q[j].w), bf_hi(q[j].w)};
        const f32x4 m0 = *(const f32x4*)(mu + (size_t)j * RWIN + col0), m1 = *(const f32x4*)(mu + (size_t)j * RWIN + col0 + 4);
        const float m8[8] = {m0.x, m0.y, m0.z, m0.w, m1.x, m1.y, m1.z, m1.w};
#pragma unroll
        for (int i = 0; i < 8; ++i) u[i] += on * m8[i] * (has * n8[i] - p[i]);
    }
}

__device__ __forceinline__ void ph_prep(const Args& a, const Ctx& C, int l) {
    const bf16* P = (const bf16*)(a.ws + WS_P);
    const float* mu = a.in[I_MU] + (size_t)l * 4 * RWIN;
    bf16* LA = (bf16*)(a.ws + WS_LA);
    for (int t = C.gw; t < T; t += C.NGW) {
        v4u o = {0u, 0u, 0u, 0u};
        if (C.lane < 52) {
            int nb[4], nn; shift_rows(t, nb, nn);
            float u[8]; shift8(P, mu, t, 3072 + 8 * C.lane, nb, nn, u);
            const int cc = 8 * C.lane;
#pragma unroll
            for (int i = 0; i < 8; ++i) { if (cc < 128) u[i] = tanhf(u[i]); else if (cc >= 256) u[i] = sigmoidf_(u[i]); }
            o = (v4u){pk2(u[0], u[1]), pk2(u[2], u[3]), pk2(u[4], u[5]), pk2(u[6], u[7])};
        }
        *(v4u*)(LA + (size_t)t * LK + 8 * C.lane) = o;
    }
    { float* KNRM = (float*)(a.ws + WS_KNRM);
      for (int t = C.gw; t < T; t += C.NGW) {
          int nb[4], nn; shift_rows(t, nb, nn);
          float u[8], ss = 0.f;
#pragma unroll
          for (int hh = 0; hh < 2; ++hh) { shift8(P, mu, t, 1024 + 16 * C.lane + 8 * hh, nb, nn, u);
#pragma unroll
              for (int i = 0; i < 8; ++i) { const float x = u[i] * a.in[I_KK][l * 1024 + 16 * C.lane + 8 * hh + i]; ss += x * x; } }
          ss = quadsum(ss);
          if ((C.lane & 3) == 0) KNRM[(size_t)t * 16 + (C.lane >> 2)] = ss; } }
    bf16* QR = (bf16*)(a.ws + WS_QR); bf16* KR = (bf16*)(a.ws + WS_KR);
    bf16* VT = (bf16*)(a.ws + WS_VT); bf16* KTF = (bf16*)(a.ws + WS_KTF); bf16* KTB = (bf16*)(a.ws + WS_KTB);
    LAS unsigned short* TL0 = (LAS unsigned short*)C.lds;
    constexpr int TP = 136, TSZ = 128 * TP;
    for (int un = C.bx; un < NCH * 8; un += C.G) {
        const int c = un >> 3, h = un & 7, t0 = 128 * c;
        const float l2f = a.in[I_L2D][(l * 2 + 0) * 8 + h], l2b = a.in[I_L2D][(l * 2 + 1) * 8 + h];
        const float lgf = log1pf(-exp2f(-l2f)), lgb = log1pf(-exp2f(-l2b));
        const int m = C.tid >> 2, p = C.tid & 3, t = t0 + m;
        const bool lat = c >= 2; const int pos = t - TC;
        const int half = p >> 1, ib = 16 * (p & 1);
        const int pvi = lat ? (half ? 256 + (pos & 63) : (pos >> 6)) : 0; const float* sct = (const float*)(a.ws + WS_SCT);
        const int d1 = 64 * half + ib;
        const bf16* prow = P + (size_t)t * PW + RET_OFF + 128 * h;
        float q1[16], q2[16], k1[16], k2[16];
        { const v4u a0 = *(const v4u*)(prow + d1), a1 = *(const v4u*)(prow + d1 + 8), b0 = *(const v4u*)(prow + d1 + 32), b1 = *(const v4u*)(prow + d1 + 40);
          const unsigned wa[8] = {a0.x, a0.y, a0.z, a0.w, a1.x, a1.y, a1.z, a1.w}, wb[8] = {b0.x, b0.y, b0.z, b0.w, b1.x, b1.y, b1.z, b1.w};
#pragma unroll
          for (int i = 0; i < 8; ++i) { q1[2 * i] = bf_lo(wa[i]); q1[2 * i + 1] = bf_hi(wa[i]); q2[2 * i] = bf_lo(wb[i]); q2[2 * i + 1] = bf_hi(wb[i]); } }
        { const bf16* kp = prow + 1024;
          const v4u a0 = *(const v4u*)(kp + d1), a1 = *(const v4u*)(kp + d1 + 8), b0 = *(const v4u*)(kp + d1 + 32), b1 = *(const v4u*)(kp + d1 + 40);
          const unsigned wa[8] = {a0.x, a0.y, a0.z, a0.w, a1.x, a1.y, a1.z, a1.w}, wb[8] = {b0.x, b0.y, b0.z, b0.w, b1.x, b1.y, b1.z, b1.w};
#pragma unroll
          for (int i = 0; i < 8; ++i) { k1[2 * i] = bf_lo(wa[i]); k1[2 * i + 1] = bf_hi(wa[i]); k2[2 * i] = bf_lo(wb[i]); k2[2 * i + 1] = bf_hi(wb[i]); } }
        const float ksc = 0.08838834764831845f;
#pragma unroll
        for (int i = 0; i < 16; ++i) {
            float cs = 1.f, sn = 0.f;
            if (lat) { const float* e2 = sct + ((size_t)pvi * 32 + ib + i) * 2; cs = e2[0]; sn = e2[1]; }
            const float qa = q1[i] * cs - q2[i] * sn, qb = q1[i] * sn + q2[i] * cs;
            const float ka = (k1[i] * cs - k2[i] * sn) * ksc, kb = (k1[i] * sn + k2[i] * cs) * ksc;
            q1[i] = qa; q2[i] = qb; k1[i] = ka; k2[i] = kb;
        }
        { bf16* qo = QR + (size_t)t * 1024 + 128 * h; bf16* ko = KR + (size_t)t * 1024 + 128 * h;
          *(v4u*)(qo + d1) = (v4u){pk2(q1[0], q1[1]), pk2(q1[2], q1[3]), pk2(q1[4], q1[5]), pk2(q1[6], q1[7])};
          *(v4u*)(qo + d1 + 8) = (v4u){pk2(q1[8], q1[9]), pk2(q1[10], q1[11]), pk2(q1[12], q1[13]), pk2(q1[14], q1[15])};
          *(v4u*)(qo + d1 + 32) = (v4u){pk2(q2[0], q2[1]), pk2(q2[2], q2[3]), pk2(q2[4], q2[5]), pk2(q2[6], q2[7])};
          *(v4u*)(qo + d1 + 40) = (v4u){pk2(q2[8], q2[9]), pk2(q2[10], q2[11]), pk2(q2[12], q2[13]), pk2(q2[14], q2[15])};
          *(v4u*)(ko + d1) = (v4u){pk2(k1[0], k1[1]), pk2(k1[2], k1[3]), pk2(k1[4], k1[5]), pk2(k1[6], k1[7])};
          *(v4u*)(ko + d1 + 8) = (v4u){pk2(k1[8], k1[9]), pk2(k1[10], k1[11]), pk2(k1[12], k1[13]), pk2(k1[14], k1[15])};
          *(v4u*)(ko + d1 + 32) = (v4u){pk2(k2[0], k2[1]), pk2(k2[2], k2[3]), pk2(k2[4], k2[5]), pk2(k2[6], k2[7])};
          *(v4u*)(ko + d1 + 40) = (v4u){pk2(k2[8], k2[9]), pk2(k2[10], k2[11]), pk2(k2[12], k2[13]), pk2(k2[14], k2[15])}; }
        const float zf = __expf(lgf * (float)(127 - m)), zb = __expf(lgb * (float)m);
#pragma unroll
        for (int i = 0; i < 16; ++i) {
            TL0[TSZ + (d1 + i) * TP + m] = f2bf1(k1[i] * zf);      TL0[TSZ + (d1 + 32 + i) * TP + m] = f2bf1(k2[i] * zf);
            TL0[2 * TSZ + (d1 + i) * TP + m] = f2bf1(k1[i] * zb);  TL0[2 * TSZ + (d1 + 32 + i) * TP + m] = f2bf1(k2[i] * zb);
        }
        { const bf16* vp = prow + 2048 + 32 * p;
#pragma unroll
          for (int j = 0; j < 4; ++j) { const v4u w = *(const v4u*)(vp + 8 * j); const unsigned ww[4] = {w.x, w.y, w.z, w.w};
#pragma unroll
              for (int i = 0; i < 4; ++i) { TL0[(32 * p + 8 * j + 2 * i) * TP + m] = (unsigned short)(ww[i] & 0xffffu); TL0[(32 * p + 8 * j + 2 * i + 1) * TP + m] = (unsigned short)(ww[i] >> 16); } } }
        __syncthreads();
        { const int d = C.tid >> 2, part = C.tid & 3; const size_t go = ((size_t)(h * NCH + c) * 128 + d) * 128 + 32 * part;
#pragma unroll
          for (int j = 0; j < 4; ++j) *(v4u*)(VT + go + 8 * j)  = *(const LAS v4u*)(TL0 + d * TP + 32 * part + 8 * j); }
        { const int fr = C.lane & 15, fq = C.lane >> 4; float* KVT = (float*)(a.ws + WS_KVT);
          bf16x8 A[4];
#pragma unroll
          for (int s = 0; s < 4; ++s) A[s] = *(const LAS bf16x8*)(TL0 + (16 * C.wave + fr) * TP + 32 * s + 8 * fq);
#pragma unroll
          for (int dir = 0; dir < 2; ++dir) { float* outp = KVT + ((size_t)dir * 8 * NCH + (size_t)(h * NCH + c)) * 16384;
#pragma unroll
              for (int n = 0; n < 8; ++n) { f32x4 acc = {0.f, 0.f, 0.f, 0.f};
#pragma unroll
                  for (int s = 0; s < 4; ++s) { const bf16x8 B = *(const LAS bf16x8*)(TL0 + (1 + dir) * TSZ + (16 * n + fr) * TP + 32 * s + 8 * fq); acc = __builtin_amdgcn_mfma_f32_16x16x32_bf16(B, A[s], acc, 0, 0, 0); }
                  *(f32x4*)(outp + (size_t)(16 * C.wave + fr) * 128 + 16 * n + 4 * fq) = acc; } } }
        __syncthreads();
    }
}

__device__ __forceinline__ void ph_ret_kv(const Args& a, const Ctx& C) {
    const bf16* VT = (const bf16*)(a.ws + WS_VT); float* KVT = (float*)(a.ws + WS_KVT);
    const int fr = C.lane & 15, fq = C.lane >> 4;
    for (int un = C.bx; un < 2 * 8 * NCH; un += C.G) {
        const int dir = un / (8 * NCH), hc = un % (8 * NCH);
        const bf16* KT = (const bf16*)(a.ws + (dir ? WS_KTB : WS_KTF)) + (size_t)hc * 16384;
        const bf16* vt = VT + (size_t)hc * 16384 + (size_t)(16 * C.wave + fr) * 128 + 8 * fq;
        bf16x8 A[4];
#pragma unroll
        for (int s = 0; s < 4; ++s) A[s] = *(const bf16x8*)(vt + 32 * s);
        float* outp = KVT + ((size_t)dir * 8 * NCH + hc) * 16384;
#pragma unroll
        for (int n = 0; n < 8; ++n) {
            f32x4 acc = {0.f, 0.f, 0.f, 0.f};
            const bf16* kt = KT + (size_t)(16 * n + fr) * 128 + 8 * fq;
#pragma unroll
            for (int s = 0; s < 4; ++s) { const bf16x8 B = *(const bf16x8*)(kt + 32 * s); acc = __builtin_amdgcn_mfma_f32_16x16x32_bf16(B, A[s], acc, 0, 0, 0); }
            *(f32x4*)(outp + (size_t)(16 * C.wave + fr) * 128 + 16 * n + 4 * fq) = acc;
        }
    }
}
__device__ __forceinline__ void ph_ret_prefix(const Args& a, const Ctx& C, int l) {
    const float* KVT = (const float*)(a.ws + WS_KVT); bf16* ST = (bf16*)(a.ws + WS_ST);
    for (int i = C.bx * NTHR + C.tid; i < 16 * 16384; i += C.G * NTHR) {
        const int dh = i >> 14, el = i & 16383, dir = dh >> 3, h = dh & 7;
        const float l2 = a.in[I_L2D][(l * 2 + dir) * 8 + h]; const float gC = __expf(128.0f * log1pf(-exp2f(-l2)));
        const float* kv = KVT + (size_t)dh * NCH * 16384 + el; bf16* st = ST + (size_t)dh * NCH * 16384 + el;
        float s = 0.f;
        for (int b0 = 0; b0 < NCH; b0 += 10) {
            float kvv[10]; int cc[10];
#pragma unroll
            for (int j = 0; j < 10; ++j) { const int o = b0 + j; cc[j] = dir == 0 ? o : (o < 2 ? 1 - o : (NCH + 1) - o); kvv[j] = kv[(size_t)cc[j] * 16384]; }
#pragma unroll
            for (int j = 0; j < 10; ++j) { st[(size_t)cc[j] * 16384] = f2bf1(s); s = s * gC + kvv[j]; }
        }
    }
}
__device__ __forceinline__ void ph_ret_out(const Args& a, const Ctx& C, int l, int ub, int nblk) {
    const bf16* QR = (const bf16*)(a.ws + WS_QR); const bf16* KR = (const bf16*)(a.ws + WS_KR); const bf16* VT = (const bf16*)(a.ws + WS_VT);
    const bf16* ST = (const bf16*)(a.ws + WS_ST); const bf16* P = (const bf16*)(a.ws + WS_P); bf16* YALL = (bf16*)(a.ws + WS_YALL);
    const int fr = C.lane & 15, fq = C.lane >> 4;
    constexpr int PP = 136, TSZ = 128 * PP;
    LAS unsigned short* T0 = (LAS unsigned short*)C.lds; LAS unsigned short* T1 = T0 + TSZ; LAS unsigned short* T2 = T1 + TSZ;
    LAS unsigned short* Pw = T0 + 3 * TSZ + C.wave * 16 * PP;
    for (int un = ub; un < NCH * 8; un += nblk) {
        const int c = un >> 3, h = un & 7, t0 = 128 * c, hc = h * NCH + c, rs = C.wave;
        const float l2f = a.in[I_L2D][(l * 2 + 0) * 8 + h], l2b = a.in[I_L2D][(l * 2 + 1) * 8 + h];
        const float lgf2 = log1pf(-exp2f(-l2f)) * 1.4426950408889634f, lgb2 = log1pf(-exp2f(-l2b)) * 1.4426950408889634f;
#pragma unroll
        for (int j = 0; j < 4; ++j) { const int pc = C.tid + NTHR * j, r = pc >> 4, c16 = pc & 15;
            *(LAS v4u*)(T0 + r * PP + 8 * c16) = *(const v4u*)(KR + (size_t)(t0 + r) * 1024 + 128 * h + 8 * c16); }
        bf16x8 QA[4];
        { const bf16* qp = QR + (size_t)(t0 + 16 * rs + fr) * 1024 + 128 * h + 8 * fq;
#pragma unroll
          for (int s = 0; s < 4; ++s) QA[s] = *(const bf16x8*)(qp + 32 * s); }
        __syncthreads();
#pragma unroll
        for (int j = 0; j < 8; ++j) {
            f32x4 acc = {0.f, 0.f, 0.f, 0.f};
#pragma unroll
            for (int s = 0; s < 4; ++s) { const bf16x8 B = *(const LAS bf16x8*)(T0 + (16 * j + fr) * PP + 32 * s + 8 * fq); acc = __builtin_amdgcn_mfma_f32_16x16x32_bf16(QA[s], B, acc, 0, 0, 0); }
#pragma unroll
            for (int r = 0; r < 4; ++r) { const int n = 16 * rs + 4 * fq + r, m = 16 * j + fr, df = n - m;
                const float f = df >= 0 ? exp2f(lgf2 * (float)df) : exp2f(lgb2 * (float)(-df));
                Pw[(4 * fq + r) * PP + m] = f2bf1(acc[r] * f); }
        }
        __syncthreads();
#pragma unroll
        for (int j = 0; j < 4; ++j) { const int pc = C.tid + NTHR * j, r = pc >> 4, c16 = pc & 15; const size_t go = (size_t)hc * 16384 + (size_t)r * 128 + 8 * c16;
            *(LAS v4u*)(T0 + r * PP + 8 * c16) = *(const v4u*)(VT + go);
            *(LAS v4u*)(T1 + r * PP + 8 * c16) = *(const v4u*)(ST + (size_t)(0 * 8) * NCH * 16384 + go);
            *(LAS v4u*)(T2 + r * PP + 8 * c16) = *(const v4u*)(ST + (size_t)(1 * 8) * NCH * 16384 + go); }
        __syncthreads();
        f32x4 aY[8];
        bf16x8 PA[4];
#pragma unroll
        for (int s = 0; s < 4; ++s) PA[s] = *(const LAS bf16x8*)(Pw + fr * PP + 32 * s + 8 * fq);
        const int n = 16 * rs + fr;
        const float xf = exp2f(lgf2 * (float)(n + 1)), xb = exp2f(lgb2 * (float)(128 - n));
        float ss = 0.f;
#pragma unroll
        for (int j = 0; j < 8; ++j) {
            const int dvr = 32 * (j >> 1) + 8 * (fr >> 2) + 4 * (j & 1) + (fr & 3);
            f32x4 y = {0.f, 0.f, 0.f, 0.f}, zf = y, zb = y;
#pragma unroll
            for (int s = 0; s < 4; ++s) {
                const bf16x8 Av = *(const LAS bf16x8*)(T0 + dvr * PP + 32 * s + 8 * fq), Af = *(const LAS bf16x8*)(T1 + dvr * PP + 32 * s + 8 * fq), Ab = *(const LAS bf16x8*)(T2 + dvr * PP + 32 * s + 8 * fq);
                y = __builtin_amdgcn_mfma_f32_16x16x32_bf16(Av, PA[s], y, 0, 0, 0);
                zf = __builtin_amdgcn_mfma_f32_16x16x32_bf16(Af, QA[s], zf, 0, 0, 0);
                zb = __builtin_amdgcn_mfma_f32_16x16x32_bf16(Ab, QA[s], zb, 0, 0, 0);
            }
#pragma unroll
            for (int r = 0; r < 4; ++r) { const float v = y[r] + xf * zf[r] + xb * zb[r]; y[r] = v; ss += v * v; }
            aY[j] = y;
            asm volatile("" : "+v"(aY[j]));
        }
        ss += __shfl_xor(ss, 16); ss += __shfl_xor(ss, 32);
        const float rstd = rsqrtf(ss * (1.0f / 128.0f) + 1e-6f);
        const int t = t0 + n;
#pragma unroll
        for (int m = 0; m < 4; ++m) { const int dv0 = 32 * m + 8 * fq;
            const f32x4 w0 = *(const f32x4*)(a.in[I_GNW] + l * 1024 + 128 * h + dv0), w1 = *(const f32x4*)(a.in[I_GNW] + l * 1024 + 128 * h + dv0 + 4);
            const v4u gq = *(const v4u*)(P + (size_t)t * PW + RET_OFF + 3072 + 128 * h + dv0);
            const float g8[8] = {bf_lo(gq.x), bf_hi(gq.x), bf_lo(gq.y), bf_hi(gq.y), bf_lo(gq.z), bf_hi(gq.z), bf_lo(gq.w), bf_hi(gq.w)};
            const float w8[8] = {w0.x, w0.y, w0.z, w0.w, w1.x, w1.y, w1.z, w1.w};
            float o[8];
#pragma unroll
            for (int i = 0; i < 8; ++i) { const float yv = (i < 4) ? aY[2 * m][i] : aY[2 * m + 1][i - 4]; o[i] = yv * rstd * w8[i] * g8[i] * sigmoidf_(g8[i]); }
            *(v4u*)(YALL + (size_t)t * D + 1024 + 128 * h + dv0) = (v4u){pk2(o[0], o[1]), pk2(o[2], o[3]), pk2(o[4], o[5]), pk2(o[6], o[7])}; }
        __syncthreads();
    }
}

constexpr int NCK = T / 32;
__device__ __forceinline__ int scan_row(int s, int dir) { return dir ? (s < TC ? TC - 1 - s : (T + TC - 1) - s) : s; }
__device__ __forceinline__ int pos_c(int c) { return 32 * (c >> 5) + 8 * ((c >> 2) & 3) + 4 * ((c >> 4) & 1) + (c & 3); }
__device__ __forceinline__ int pos_i(int i) { return 8 * ((i >> 2) & 3) + 4 * (i >> 4) + (i & 3); }
__device__ __forceinline__ float wave_sum_all(float v) {
    v = rowsum16(v);
    const float a = __builtin_bit_cast(float, __builtin_amdgcn_readlane(__builtin_bit_cast(int, v), 0)), b = __builtin_bit_cast(float, __builtin_amdgcn_readlane(__builtin_bit_cast(int, v), 16));
    const float c = __builtin_bit_cast(float, __builtin_amdgcn_readlane(__builtin_bit_cast(int, v), 32)), d = __builtin_bit_cast(float, __builtin_amdgcn_readlane(__builtin_bit_cast(int, v), 48));
    return (a + b) + (c + d);
}
__device__ __forceinline__ float ldbf(const bf16* p) { return __uint_as_float((unsigned)(*p) << 16); }

__device__ __forceinline__ void rwkv_mats_unit(const Args& a, const Ctx& C, int cs, LAS float* LA, const LAS unsigned char* bk);
__device__ __forceinline__ void ld8(const bf16* p, float (&o)[8]) { const v4u w = *(const v4u*)p; o[0] = bf_lo(w.x); o[1] = bf_hi(w.x); o[2] = bf_lo(w.y); o[3] = bf_hi(w.y); o[4] = bf_lo(w.z); o[5] = bf_hi(w.z); o[6] = bf_lo(w.w); o[7] = bf_hi(w.w); }
__device__ __forceinline__ float seg_scan32(float x) {
    x += dppf<0x111>(x); x += dppf<0x112>(x); x += dppf<0x114>(x); x += dppf<0x118>(x);
    x += __builtin_bit_cast(float, __builtin_amdgcn_update_dpp(0, __builtin_bit_cast(int, x), 0x142, 0xa, 0xf, false));
    return x;
}
template <int ST> __device__ __forceinline__ void ph_rwkv_prep(const Args& a, const Ctx& C, int l) {
    const bf16* P = (const bf16*)(a.ws + WS_P); const bf16* LO = (const bf16*)(a.ws + WS_LORA); const float* KNRM = (const float*)(a.ws + WS_KNRM);
    bf16* AGP = (bf16*)(a.ws + WS_AGP); bf16* RGP = (bf16*)(a.ws + WS_RGP);
    bf16* KGT = (bf16*)(a.ws + WS_KGT); bf16* BGT = (bf16*)(a.ws + WS_BGT); bf16* VTP = (bf16*)(a.ws + WS_VTP); float* GC = (float*)(a.ws + WS_GC);
    float* BONP = (float*)(a.ws + WS_BON);
    const int gsel = C.lane >> 5, tok = C.lane & 31;
    LAS unsigned short* tl = (LAS unsigned short*)(C.lds + 65536 + C.wave * 9216);
    LAS unsigned char* bkw = C.lds + (((C.wave >> 2) & 1) * 2 + gsel) * 2 * 8192;
    const int nwv = C.NGW & ~63, hq = C.gw & 63, q = hq & 3, h = hq >> 2;
    for (int un = C.gw; (un & ~7) < (NCK / 2) * 64 && C.gw < nwv; un += nwv) {
        const int pp = un >> 6;
        const int g = 2 * pp + gsel, t = 32 * g + tok;
        const int s = q >> 1, fqb = 2 * (q & 1), lcA = 32 * s + 4 * fqb, lcB = lcA + 16;
        const int chA = 64 * h + lcA, chB = 64 * h + lcB;
        int nb[4], nn; shift_rows(t, nb, nn);
        float onf[4], hasf[4]; int nrow[4];
#pragma unroll
        for (int j = 0; j < 4; ++j) { onf[j] = (j < nn) ? 1.0f : 0.0f; hasf[j] = (nb[j] >= 0) ? 1.0f : 0.0f; nrow[j] = nb[j] >= 0 ? nb[j] : t; }
        float r[16], k[16], v[16];
#pragma unroll
        for (int arr = 0; arr < 3; ++arr) {
#pragma unroll
            for (int run = 0; run < 2; ++run) {
                const int cc = 1024 * arr + (run ? chB : chA);
                float pc[8], u[8]; ld8(P + (size_t)t * PW + cc, pc);
#pragma unroll
                for (int i = 0; i < 8; ++i) u[i] = pc[i];
#pragma unroll
                for (int j = 0; j < 4; ++j) { float n8[8]; ld8(P + (size_t)nrow[j] * PW + cc, n8);
                    const CAS float* mu = (const CAS float*)a.in[I_MU] + ((size_t)l * 4 + j) * RWIN + cc;
#pragma unroll
                    for (int i = 0; i < 8; ++i) u[i] += onf[j] * mu[i] * (hasf[j] * n8[i] - pc[i]); }
#pragma unroll
                for (int i = 0; i < 8; ++i) { if (arr == 0) r[8 * run + i] = u[i]; else if (arr == 1) k[8 * run + i] = u[i]; else v[8 * run + i] = u[i]; }
            }
        }
        const float rn = __builtin_amdgcn_rcpf(fmaxf(__builtin_amdgcn_sqrtf(KNRM[(size_t)t * 16 + h]), 1e-12f));
        float kk[16];
#pragma unroll
        for (int i = 0; i < 16; ++i) kk[i] = k[i] * ((const CAS float*)a.in[I_KK])[l * 1024 + (i < 8 ? chA + i : chB + i - 8)] * rn;
#pragma unroll
        for (int d = 0; d < 2; ++d) {
            const int c = d == 0 ? g : (g < 8 ? 7 - g : (NCK + 7) - g);
            const int cs = (d * 16 + h) * NCK + c, ii = d ? 31 - tok : tok, pi = pos_i(ii);
            const bf16* lo = LO + (size_t)t * LNN + d * 1024;
            float bon = 0.f, gcv = 0.f;
            const size_t po = (size_t)cs * 2048 + ((ii >> 4) * 2 + s) * 512 + (ii & 15) * 8;
#pragma unroll
            for (int f = 0; f < 2; ++f) {
                float ag[8], rg[8], bg[8], kg[8], lwv[8], lav[8];
                { const v2u wa = *(const v2u*)(lo + chA + 4 * f), wb = *(const v2u*)(lo + chB + 4 * f), xa = *(const v2u*)(lo + 2048 + chA + 4 * f), xb = *(const v2u*)(lo + 2048 + chB + 4 * f);
                  lwv[0] = bf_lo(wa.x); lwv[1] = bf_hi(wa.x); lwv[2] = bf_lo(wa.y); lwv[3] = bf_hi(wa.y); lwv[4] = bf_lo(wb.x); lwv[5] = bf_hi(wb.x); lwv[6] = bf_lo(wb.y); lwv[7] = bf_hi(wb.y);
                  lav[0] = bf_lo(xa.x); lav[1] = bf_hi(xa.x); lav[2] = bf_lo(xa.y); lav[3] = bf_hi(xa.y); lav[4] = bf_lo(xb.x); lav[5] = bf_hi(xb.x); lav[6] = bf_lo(xb.y); lav[7] = bf_hi(xb.y); }
#pragma unroll
                for (int e = 0; e < 8; ++e) {
                    const int i = (e < 4) ? 4 * f + e : 8 + 4 * f + (e - 4);
                    const int ch = (i < 8 ? chA + i : chB + i - 8), lc = (i < 8 ? lcA + i : lcB + i - 8);
                    const float x = ((const CAS float*)a.in[I_W0])[(size_t)(l * 2 + d) * 1024 + ch] + lwv[e], z = -x;
                    const float sp = fmaxf(z, 0.f) + __logf(1.0f + __expf(-fabsf(z)));
                    const float lw = -__expf(-sp - 0.5f);
                    const float av = __builtin_amdgcn_rcpf(1.0f + __expf(-(((const CAS float*)a.in[I_A0])[(size_t)(l * 2 + d) * 1024 + ch] + lav[e])));
                    const float kd = k[i] * (1.0f + (av - 1.0f) * ((const CAS float*)a.in[I_KA])[l * 1024 + ch]), b = kk[i] * av;
                    float inc = seg_scan32(lw);
                    const float t31 = __builtin_bit_cast(float, __builtin_amdgcn_readlane(__builtin_bit_cast(int, inc), 31)), t63 = __builtin_bit_cast(float, __builtin_amdgcn_readlane(__builtin_bit_cast(int, inc), 63));
                    const float tot = gsel ? t63 : t31;
                    if (d) inc = tot - inc + lw;
                    gcv = (tok == i) ? tot : gcv;
                    const float gp = __expf(inc - lw), gt = __expf(inc), gi = __expf(-inc);
                    ag[e] = kk[i] * gp; rg[e] = r[i] * gt; bg[e] = b * gi; kg[e] = kd * gi;
                    bon += r[i] * kd * ((const CAS float*)a.in[I_RK])[l * 1024 + ch];
                    if (ST & 2) { const int to = i * 64 + 32 * gsel + pi; tl[to] = f2bf1(kg[e]); tl[1024 + to] = f2bf1(-bg[e]); tl[2048 + to] = f2bf1(v[i]); } else asm volatile("" :: "v"(kg[e]), "v"(bg[e]));
                }
                const size_t o = po + (size_t)(fqb + f) * 128;
                if (ST & 1) {
                *(v4u*)(AGP + o) = (v4u){pk2(ag[0], ag[1]), pk2(ag[2], ag[3]), pk2(ag[4], ag[5]), pk2(ag[6], ag[7])};
                *(v4u*)(RGP + o) = (v4u){pk2(rg[0], rg[1]), pk2(rg[2], rg[3]), pk2(rg[4], rg[5]), pk2(rg[6], rg[7])};
                { const int pfe = (int)(o - (size_t)cs * 2048);
                  *(LAS v4u*)(bkw + d * 8192 + pfe * 2) = (v4u){pk2(bg[0], bg[1]), pk2(bg[2], bg[3]), pk2(bg[4], bg[5]), pk2(bg[6], bg[7])};
                  *(LAS v4u*)(bkw + d * 8192 + 4096 + pfe * 2) = (v4u){pk2(kg[0], kg[1]), pk2(kg[2], kg[3]), pk2(kg[4], kg[5]), pk2(kg[6], kg[7])}; }
                } else asm volatile("" :: "v"(ag[0] + ag[1] + ag[2] + ag[3] + ag[4] + ag[5] + ag[6] + ag[7]), "v"(rg[0] + rg[1] + rg[2] + rg[3] + rg[4] + rg[5] + rg[6] + rg[7]));
            }
            if (ST & 2) {
                LDS_WAIT();
                const int kl = C.lane & 15, gs = (C.lane >> 4) & 1, op = C.lane >> 5, lcl = kl < 8 ? lcA + kl : lcB + kl - 8;
                const int gg = 2 * pp + gs, cg = d == 0 ? gg : (gg < 8 ? 7 - gg : (NCK + 7) - gg);
                const size_t ob = (size_t)((d * 16 + h) * NCK + cg) * 2048 + ((lcl >> 4) * 64 + (lcl & 15)) * 8;
#pragma unroll
                for (int oo = 0; oo < 2; ++oo) { const int o = 2 * op + oo; const int la = kl * 64 + 32 * gs + 8 * o;
                    *(v4u*)(KGT + ob + o * 128) = *(const LAS v4u*)(tl + la); *(v4u*)(BGT + ob + o * 128) = *(const LAS v4u*)(tl + 1024 + la); *(v4u*)(VTP + ob + o * 128) = *(const LAS v4u*)(tl + 2048 + la); }
                LDS_WAIT();
            }
            if (ST & 4) BONP[((size_t)(d * 16 + h) * 4 + q) * T + t] = bon; else asm volatile("" :: "v"(bon));
            if ((ST & 4) && tok < 16) GC[(size_t)cs * 64 + (tok < 8 ? lcA + tok : lcB + tok - 8)] = __expf(gcv);
        }
        asm volatile("s_waitcnt vmcnt(0)" ::: "memory");
        __syncthreads();
        { const int hh = (C.wave >> 2) & 1, gs2 = (C.wave >> 1) & 1, d2 = C.wave & 1;
          const int h2 = ((C.gw & ~7) & 63) / 4 + hh, g2 = 2 * pp + gs2, c2 = d2 == 0 ? g2 : (g2 < 8 ? 7 - g2 : (NCK + 7) - g2);
          rwkv_mats_unit(a, C, (d2 * 16 + h2) * NCK + c2, (LAS float*)(C.lds + 65536 + C.wave * 9216), C.lds + ((hh * 2 + gs2) * 2 + d2) * 8192); }
        __syncthreads();
    }
}

__device__ __forceinline__ void rwkv_mats_unit(const Args& a, const Ctx& C, int cs, LAS float* LA, const LAS unsigned char* bk) {
    const bf16* AGP = (const bf16*)(a.ws + WS_AGP); const bf16* RGP = (const bf16*)(a.ws + WS_RGP);
    bf16* TPm = (bf16*)(a.ws + WS_TP); bf16* AAK = (bf16*)(a.ws + WS_AAK); bf16* ARK = (bf16*)(a.ws + WS_ARK); bf16* ARB = (bf16*)(a.ws + WS_ARB);
    LAS float* LT = LA + 32 * 36;
    {
        int ln = C.lane; asm volatile("" : "+v"(ln));
        const int fr = ln & 15, fq = ln >> 4;
        const size_t o = (size_t)cs * 2048 + ln * 8;
        bf16x8 AG[2][2], RG[2][2], BG[2][2], KG[2][2];
#pragma unroll
        for (int tt = 0; tt < 2; ++tt)
#pragma unroll
            for (int s = 0; s < 2; ++s) { const size_t off = o + (tt * 2 + s) * 512;
                AG[tt][s] = *(const bf16x8*)(AGP + off); RG[tt][s] = *(const bf16x8*)(RGP + off);
                BG[tt][s] = *(const LAS bf16x8*)(bk + ((tt * 2 + s) * 512 + ln * 8) * 2); KG[tt][s] = *(const LAS bf16x8*)(bk + 4096 + ((tt * 2 + s) * 512 + ln * 8) * 2); }
#pragma unroll
        for (int tt = 0; tt < 2; ++tt) {
            f32x4 ab[2], ak[2], rk[2], rb[2];
#pragma unroll
            for (int it = 0; it < 2; ++it) {
                ab[it] = (f32x4){0.f, 0.f, 0.f, 0.f}; ak[it] = ab[it]; rk[it] = ab[it]; rb[it] = ab[it];
                if (it <= tt) {
#pragma unroll
                    for (int s = 0; s < 2; ++s) {
                        ab[it] = __builtin_amdgcn_mfma_f32_16x16x32_bf16(BG[it][s], AG[tt][s], ab[it], 0, 0, 0);
                        ak[it] = __builtin_amdgcn_mfma_f32_16x16x32_bf16(KG[it][s], AG[tt][s], ak[it], 0, 0, 0);
                        rk[it] = __builtin_amdgcn_mfma_f32_16x16x32_bf16(KG[it][s], RG[tt][s], rk[it], 0, 0, 0);
                        rb[it] = __builtin_amdgcn_mfma_f32_16x16x32_bf16(BG[it][s], RG[tt][s], rb[it], 0, 0, 0);
                    }
                    const int t = 16 * tt + fr;
#pragma unroll
                    for (int r = 0; r < 4; ++r) { const int i = 16 * it + 4 * fq + r;
                        if (i >= t) { ab[it][r] = 0.f; ak[it][r] = 0.f; }
                        if (i > t) { rk[it][r] = 0.f; rb[it][r] = 0.f; } }
                }
                *(LAS f32x4*)(LA + (16 * tt + fr) * 36 + 16 * it + 4 * fq) = ab[it];
            }
            if (tt == 0) { const size_t so = (size_t)cs * 1024 + ln * 4;
                *(v2u*)(AAK + so) = (v2u){pk2(ak[0][0], ak[0][1]), pk2(ak[0][2], ak[0][3])};
                *(v2u*)(ARK + so) = (v2u){pk2(rk[0][0], rk[0][1]), pk2(rk[0][2], rk[0][3])};
                *(v2u*)(ARB + so) = (v2u){pk2(-rb[0][0], -rb[0][1]), pk2(-rb[0][2], -rb[0][3])}; }
            else { const size_t so = (size_t)cs * 1024 + 256 + ln * 8;
                *(v4u*)(AAK + so) = (v4u){pk2(ak[0][0], ak[0][1]), pk2(ak[0][2], ak[0][3]), pk2(ak[1][0], ak[1][1]), pk2(ak[1][2], ak[1][3])};
                *(v4u*)(ARK + so) = (v4u){pk2(rk[0][0], rk[0][1]), pk2(rk[0][2], rk[0][3]), pk2(rk[1][0], rk[1][1]), pk2(rk[1][2], rk[1][3])};
                *(v4u*)(ARB + so) = (v4u){pk2(-rb[0][0], -rb[0][1]), pk2(-rb[0][2], -rb[0][3]), pk2(-rb[1][0], -rb[1][1]), pk2(-rb[1][2], -rb[1][3])}; }
        }
        LDS_WAIT();
        const int n = ln & 31;
        float x[32];
#pragma unroll
        for (int t = 0; t < 32; ++t) {
            float s = (t == n) ? 1.0f : 0.0f;
#pragma unroll
            for (int m = 0; m < (t + 3) / 4; ++m) { const f32x4 av = *(const LAS f32x4*)(LA + t * 36 + 4 * m);
                if (4 * m + 0 < t) s -= av.x * x[4 * m + 0];
                if (4 * m + 1 < t) s -= av.y * x[4 * m + 1];
                if (4 * m + 2 < t) s -= av.z * x[4 * m + 2];
                if (4 * m + 3 < t) s -= av.w * x[4 * m + 3]; }
            x[t] = s; LT[t * 36 + n] = s;
        }
        LDS_WAIT();
#pragma unroll
        for (int tt = 0; tt < 2; ++tt) { const LAS float* row = LT + (16 * tt + fr) * 36;
            const f32x4 lo = *(const LAS f32x4*)(row + 4 * fq), hi = *(const LAS f32x4*)(row + 16 + 4 * fq);
            if (tt == 0) *(v2u*)(TPm + (size_t)cs * 1024 + ln * 4) = (v2u){pk2(lo.x, lo.y), pk2(lo.z, lo.w)};
            else *(v4u*)(TPm + (size_t)cs * 1024 + 256 + ln * 8) = (v4u){pk2(lo.x, lo.y), pk2(lo.z, lo.w), pk2(hi.x, hi.y), pk2(hi.z, hi.w)}; }
        LDS_WAIT();
    }
}

__device__ __forceinline__ bf16x8 pack_acc2(const f32x4& lo, const f32x4& hi) {
    v4u w = {pk2(lo[0], lo[1]), pk2(lo[2], lo[3]), pk2(hi[0], hi[1]), pk2(hi[2], hi[3])};
    return __builtin_bit_cast(bf16x8, w);
}
struct SeqOpsA { bf16x8 AG[2][2], TPf[2], AK[2], KT[4], BT[4], VB; f32x4 GCv[4]; };
struct SeqOpsB { bf16x8 RG[2][2], RK[2], RB[2]; };
__device__ __forceinline__ void ph_rwkv_seq(const Args& a, const Ctx& C, int hd, int vs) {
    const int fq = C.lane >> 4;
    const bf16* AGP = (const bf16*)(a.ws + WS_AGP); const bf16* KGT = (const bf16*)(a.ws + WS_KGT); const bf16* BGT = (const bf16*)(a.ws + WS_BGT);
    const bf16* VTP = (const bf16*)(a.ws + WS_VTP); const float* GC = (const float*)(a.ws + WS_GC);
    const bf16* TPm = (const bf16*)(a.ws + WS_TP); const bf16* AAK = (const bf16*)(a.ws + WS_AAK);
    const size_t ol = (size_t)C.lane * 8;
#define SEQ_LD64(dst, base, cs_, tt, s) dst = *(const bf16x8*)((base) + (size_t)(cs_) * 2048 + ((tt) * 2 + (s)) * 512 + ol)
#define SEQ_LD32(dst, base, cs_, tt) do { if ((tt) == 0) { const v2u w_ = *(const v2u*)((base) + (size_t)(cs_) * 1024 + C.lane * 4); dst = __builtin_bit_cast(bf16x8, (v4u){w_.x, w_.y, 0u, 0u}); } \
        else dst = *(const bf16x8*)((base) + (size_t)(cs_) * 1024 + 256 + ol); } while (0)
#define SEQ_LDT(dst, base, cs_, mt) dst = *(const bf16x8*)((base) + (size_t)(cs_) * 2048 + (mt) * 512 + ol)
#define SEQA_LOAD1(O, cs_) do { _Pragma("unroll") for (int tt = 0; tt < 2; ++tt) { _Pragma("unroll") for (int s = 0; s < 2; ++s) SEQ_LD64(O.AG[tt][s], AGP, cs_, tt, s); SEQ_LD32(O.AK[tt], AAK, cs_, tt); } } while (0)
#define SEQA_LOAD2(O, cs_) do { _Pragma("unroll") for (int tt = 0; tt < 2; ++tt) SEQ_LD32(O.TPf[tt], TPm, cs_, tt); } while (0)
#define SEQA_LOAD3(O, cs_) do { _Pragma("unroll") for (int mt = 0; mt < 4; ++mt) { SEQ_LDT(O.KT[mt], KGT, cs_, mt); SEQ_LDT(O.BT[mt], BGT, cs_, mt); O.GCv[mt] = *(const f32x4*)(GC + (size_t)(cs_) * 64 + 16 * mt + 4 * fq); } SEQ_LDT(O.VB, VTP, cs_, vs); } while (0)
    const int cs0 = hd * NCK;
    SeqOpsA P0, P1;
    SEQA_LOAD1(P0, cs0); SEQA_LOAD2(P0, cs0); SEQA_LOAD3(P0, cs0);
    SEQA_LOAD1(P1, cs0 + 1); SEQA_LOAD2(P1, cs0 + 1); SEQA_LOAD3(P1, cs0 + 1);
    f32x4 Hc[4];
#pragma unroll
    for (int mt = 0; mt < 4; ++mt) Hc[mt] = (f32x4){0.f, 0.f, 0.f, 0.f};
    bf16x8 Hb[2]; Hb[0] = pack_acc2(Hc[0], Hc[1]); Hb[1] = pack_acc2(Hc[2], Hc[3]);
    volatile LAS int* prog = (volatile LAS int*)(C.lds + MISC_OFF + 64);
    volatile LAS int* fa = (volatile LAS int*)(C.lds + MISC_OFF + 68);
    volatile LAS int* fb = (volatile LAS int*)(C.lds + MISC_OFF + 72);
    LAS unsigned char* ring = C.lds;
#define SEQA_BODY(O, c) do { \
        if (C.lane == 0) *prog = (c); \
        const int cn = cs0 + ((c) + 2 < NCK ? (c) + 2 : NCK - 1); \
        LAS unsigned char* slot = ring + ((c) & 7) * 4096 + C.lane * 16; \
        if ((c) >= 8) { unsigned sp = 0; while (*fb < (c) - 7 && ++sp < (1u << 24)) __builtin_amdgcn_s_sleep(1); } \
        *(LAS bf16x8*)slot = Hb[0]; *(LAS bf16x8*)(slot + 1024) = Hb[1]; *(LAS bf16x8*)(slot + 3072) = O.VB; \
        f32x4 RH[2], U[2]; \
        _Pragma("unroll") for (int tt = 0; tt < 2; ++tt) { RH[tt] = (f32x4){0.f, 0.f, 0.f, 0.f}; \
            _Pragma("unroll") for (int s = 0; s < 2; ++s) RH[tt] = __builtin_amdgcn_mfma_f32_16x16x32_bf16(O.AG[tt][s], Hb[s], RH[tt], 0, 0, 0); \
            RH[tt] = __builtin_amdgcn_mfma_f32_16x16x32_bf16(O.AK[tt], O.VB, RH[tt], 0, 0, 0); } \
        SEQA_LOAD1(O, cn); \
        const bf16x8 RHb = pack_acc2(RH[0], RH[1]); \
        _Pragma("unroll") for (int tt = 0; tt < 2; ++tt) U[tt] = __builtin_amdgcn_mfma_f32_16x16x32_bf16(O.TPf[tt], RHb, (f32x4){0.f, 0.f, 0.f, 0.f}, 0, 0, 0); \
        SEQA_LOAD2(O, cn); \
        const bf16x8 Ub = pack_acc2(U[0], U[1]); \
        *(LAS bf16x8*)(slot + 2048) = Ub; \
        asm volatile("s_waitcnt lgkmcnt(0)" ::: "memory"); \
        if (C.lane == 0) *fa = (c) + 1; \
        _Pragma("unroll") for (int mt = 0; mt < 4; ++mt) { \
            Hc[mt] = __builtin_amdgcn_mfma_f32_16x16x32_bf16(O.KT[mt], O.VB, Hc[mt], 0, 0, 0); \
            Hc[mt] = __builtin_amdgcn_mfma_f32_16x16x32_bf16(O.BT[mt], Ub, Hc[mt], 0, 0, 0); \
            Hc[mt] = Hc[mt] * O.GCv[mt]; } \
        SEQA_LOAD3(O, cn); \
        Hb[0] = pack_acc2(Hc[0], Hc[1]); Hb[1] = pack_acc2(Hc[2], Hc[3]); } while (0)
    for (int c = 0; c < NCK; c += 2) { SEQA_BODY(P0, c); SEQA_BODY(P1, c + 1); }
    if (C.lane == 0) *prog = NCK + 64;
#undef SEQA_BODY
#undef SEQA_LOAD1
#undef SEQA_LOAD2
#undef SEQA_LOAD3
}
__device__ __forceinline__ void ph_rwkv_seq_y(const Args& a, const Ctx& C, int hd, int vs) {
    const int d = hd >> 4, h = hd & 15, fr = C.lane & 15, fq = C.lane >> 4;
    const bf16* RGP = (const bf16*)(a.ws + WS_RGP); const bf16* VTP = (const bf16*)(a.ws + WS_VTP); const bf16* ARK = (const bf16*)(a.ws + WS_ARK); const bf16* ARB = (const bf16*)(a.ws + WS_ARB);
    bf16* YF = (bf16*)(a.ws + WS_SY) + (size_t)d * T * 1024 + 64 * h + 16 * vs + 4 * fq;
    const size_t ol = (size_t)C.lane * 8;
    const int cs0 = hd * NCK;
#define SEQB_LOAD(O, cs_) do { _Pragma("unroll") for (int tt = 0; tt < 2; ++tt) { _Pragma("unroll") for (int s = 0; s < 2; ++s) SEQ_LD64(O.RG[tt][s], RGP, cs_, tt, s); SEQ_LD32(O.RK[tt], ARK, cs_, tt); SEQ_LD32(O.RB[tt], ARB, cs_, tt); } } while (0)
    SeqOpsB P0, P1;
    SEQB_LOAD(P0, cs0); SEQB_LOAD(P1, cs0 + 1);
    volatile LAS int* fa = (volatile LAS int*)(C.lds + MISC_OFF + 68);
    volatile LAS int* fb = (volatile LAS int*)(C.lds + MISC_OFF + 72);
    LAS unsigned char* ring = C.lds;
#define SEQB_BODY(O, c) do { \
        const int cn = cs0 + ((c) + 2 < NCK ? (c) + 2 : NCK - 1); \
        const int ystep = d ? -1 : 1, yrow0 = d ? ((c) < 8 ? TC - 1 : T + TC - 1) : 0; \
        { unsigned sp = 0; while (*fa <= (c) && ++sp < (1u << 24)) __builtin_amdgcn_s_sleep(1); } \
        asm volatile("" ::: "memory"); \
        const LAS unsigned char* slot = ring + ((c) & 7) * 4096 + C.lane * 16; \
        const bf16x8 H0 = *(const LAS bf16x8*)slot, H1 = *(const LAS bf16x8*)(slot + 1024), Ub = *(const LAS bf16x8*)(slot + 2048), VBs = *(const LAS bf16x8*)(slot + 3072); \
        asm volatile("s_waitcnt lgkmcnt(0)" ::: "memory"); \
        if (C.lane == 0) *fb = (c) + 1; \
        f32x4 Y[2];     \
        _Pragma("unroll") for (int tt = 0; tt < 2; ++tt) { Y[tt] = (f32x4){0.f, 0.f, 0.f, 0.f}; \
            Y[tt] = __builtin_amdgcn_mfma_f32_16x16x32_bf16(H0, O.RG[tt][0], Y[tt], 0, 0, 0); \
            Y[tt] = __builtin_amdgcn_mfma_f32_16x16x32_bf16(H1, O.RG[tt][1], Y[tt], 0, 0, 0); \
            Y[tt] = __builtin_amdgcn_mfma_f32_16x16x32_bf16(VBs, O.RK[tt], Y[tt], 0, 0, 0); \
            Y[tt] = __builtin_amdgcn_mfma_f32_16x16x32_bf16(Ub, O.RB[tt], Y[tt], 0, 0, 0); } \
        SEQB_LOAD(O, cn); \
        _Pragma("unroll") for (int tt = 0; tt < 2; ++tt) *(v2u*)(YF + (size_t)(unsigned)((yrow0 + ystep * (32 * (c) + 16 * tt + fr)) * 1024)) = (v2u){pk2(Y[tt][0], Y[tt][1]), pk2(Y[tt][2], Y[tt][3])}; } while (0)
    for (int c = 0; c < NCK; c += 2) { SEQB_BODY(P0, c); SEQB_BODY(P1, c + 1); }
#undef SEQB_BODY
#undef SEQB_LOAD
#undef SEQ_LD64
#undef SEQ_LD32
#undef SEQ_LDT
}
__device__ __forceinline__ void ph_rwkv_pref(const Args& a, const Ctx& C, int hd, int vs) {
    const unsigned char* ws = a.ws;
    volatile LAS int* prog = (volatile LAS int*)(C.lds + MISC_OFF + 64);
    const int cs0 = hd * NCK;
    constexpr int DEPTH = 12, INFL = 6;
    unsigned x[INFL][4];
#pragma unroll
    for (int i = 0; i < INFL; ++i)
#pragma unroll
        for (int k = 0; k < 4; ++k) x[i][k] = 0u;
#define PREF_ADDR(cs_, k) ({ const int L_ = 64 * (k) + C.lane; const size_t c2_ = (size_t)(cs_) * 4096, c1_ = (size_t)(cs_) * 2048; \
        (L_ < 32 ? ws + WS_AGP + c2_ + 128 * L_ : L_ < 64 ? ws + WS_GC + (size_t)(cs_) * 256   : L_ < 96 ? ws + WS_KGT + c2_ + 128 * (L_ - 64) : L_ < 128 ? ws + WS_BGT + c2_ + 128 * (L_ - 96) : \
         L_ < 160 ? ws + WS_VTP + c2_ + 128 * (L_ - 128) : L_ < 172 ? ws + WS_TP + c1_ + 128 * (L_ - 160) : L_ < 184 ? ws + WS_AAK + c1_ + 128 * (L_ - 172) : L_ < 208 ? ws + WS_GC + (size_t)(cs_) * 256 : \
         L_ >= 210 ? ws + WS_GC + (size_t)(cs_) * 256   : ws + WS_GC + (size_t)(cs_) * 256 + 128 * ((L_ - 224) & 1)); })
    for (int c0 = 2; c0 < NCK; c0 += INFL) {
#pragma unroll
        for (int i = 0; i < INFL; ++i) {
            const int c = c0 + i < NCK ? c0 + i : NCK - 1;
            unsigned spins = 0;
            while (c > *prog + DEPTH && ++spins < (1u << 22)) __builtin_amdgcn_s_sleep(8);
#pragma unroll
            for (int k = 0; k < 4; ++k) { asm volatile("" :: "v"(x[i][k])); x[i][k] = *(const unsigned*)PREF_ADDR(cs0 + c, k); }
        }
    }
#pragma unroll
    for (int i = 0; i < INFL; ++i)
#pragma unroll
        for (int k = 0; k < 4; ++k) asm volatile("" :: "v"(x[i][k]));
#undef PREF_ADDR
}

__device__ __forceinline__ void ph_rwkv_out(const Args& a, const Ctx& C, int l) {
    const bf16* SY = (const bf16*)(a.ws + WS_SY); const bf16* P = (const bf16*)(a.ws + WS_P); const float* mu = a.in[I_MU] + (size_t)l * 4 * RWIN; const float* BON = (const float*)(a.ws + WS_BON);
    const bf16* LO = (const bf16*)(a.ws + WS_LORA); bf16* YALL = (bf16*)(a.ws + WS_YALL);
    const int c0 = 16 * C.lane;
    for (int t = C.gw; t < T; t += C.NGW) {
        const size_t o = (size_t)t * 1024 + c0;
        float y[16], v[16]; float s = 0.f;
        { const v4u f0 = *(const v4u*)(SY + o), f1 = *(const v4u*)(SY + o + 8), b0 = *(const v4u*)(SY + (size_t)T * 1024 + o), b1 = *(const v4u*)(SY + (size_t)T * 1024 + o + 8);
          const unsigned ff[8] = {f0.x, f0.y, f0.z, f0.w, f1.x, f1.y, f1.z, f1.w}, bb[8] = {b0.x, b0.y, b0.z, b0.w, b1.x, b1.y, b1.z, b1.w};
#pragma unroll
          for (int i = 0; i < 8; ++i) { y[2 * i] = bf_lo(ff[i]) + bf_lo(bb[i]); y[2 * i + 1] = bf_hi(ff[i]) + bf_hi(bb[i]); } }
        { int nb[4], nn; shift_rows(t, nb, nn); float u[8];
          shift8(P, mu, t, 2048 + c0, nb, nn, u);
#pragma unroll
          for (int i = 0; i < 8; ++i) v[i] = u[i];
          shift8(P, mu, t, 2048 + c0 + 8, nb, nn, u);
#pragma unroll
          for (int i = 0; i < 8; ++i) v[8 + i] = u[i]; }
#pragma unroll
        for (int i = 0; i < 16; ++i) s += y[i];
        const float mean = quadsum(s) * (1.0f / 64.0f); float q = 0.f;
#pragma unroll
        for (int i = 0; i < 16; ++i) { y[i] -= mean; q += y[i] * y[i]; }
        const float rstd = rsqrtf(quadsum(q) * (1.0f / 64.0f) + 64e-5f);
        float bon = 0.f;
#pragma unroll
        for (int j = 0; j < 8; ++j) bon += BON[((size_t)((j >> 2) * 16 + (C.lane >> 2)) * 4 + (j & 3)) * T + t];
        const bf16* gp = LO + (size_t)t * LNN + 4096 + c0; const v4u g0 = *(const v4u*)gp, g1 = *(const v4u*)(gp + 8);
        const unsigned gg[8] = {g0.x, g0.y, g0.z, g0.w, g1.x, g1.y, g1.z, g1.w};
        float out[16];
#pragma unroll
        for (int i = 0; i < 16; ++i) { const float g = (i & 1) ? bf_hi(gg[i >> 1]) : bf_lo(gg[i >> 1]);
            out[i] = (y[i] * rstd * a.in[I_LNW][l * 1024 + c0 + i] + a.in[I_LNB][l * 1024 + c0 + i] + bon * v[i]) * g; }
        bf16* yo = YALL + (size_t)t * D + c0;
        *(v4u*)yo = (v4u){pk2(out[0], out[1]), pk2(out[2], out[3]), pk2(out[4], out[5]), pk2(out[6], out[7])};
        *(v4u*)(yo + 8) = (v4u){pk2(out[8], out[9]), pk2(out[10], out[11]), pk2(out[12], out[13]), pk2(out[14], out[15])};
    }
}

__device__ __forceinline__ void ph_norm2_route(const Args& a, const Ctx& C, int l, int cslot) {
    const bf16* X = (const bf16*)(a.ws + WS_X); bf16* H = (bf16*)(a.ws + WS_H);
    const float* modf = (const float*)(a.ws + WS_MOD);
    constexpr int TPH = 2056;
    LAS unsigned short* TH = (LAS unsigned short*)C.lds; LAS unsigned short* TLo = TH + 16 * TPH;
    LAS float* PART = (LAS float*)(C.lds + 2 * 16 * TPH * 2);
    LAS float* SC = PART + 8 * 16 * 32;
    int* RE = (int*)(a.ws + WS_RE); float* RWT = (float*)(a.ws + WS_RWT); int* RI = (int*)(a.ws + WS_RI);
    unsigned* cnt = (unsigned*)(a.ws + WS_CTL) + CW_CNT + 64 * cslot;
    const bf16* RT = (const bf16*)(a.ws + WS_RT);
    const int fr = C.lane & 15, fq = C.lane >> 4;
    for (int tl = C.bx; tl < T / 16; tl += C.G) {
#pragma unroll
        for (int rr = 0; rr < 2; ++rr) {
            const int r = 16 * tl + 2 * C.wave + rr; const int wh = r < TC ? 1 : 0;
            const bf16* xr = X + (size_t)r * D; const float* md = modf + (size_t)(l * 2 + wh) * 12288;
            f32x4 v[8]; float ss = 0.f;
#pragma unroll
            for (int j = 0; j < 8; ++j) { const v2u xw = *(const v2u*)(xr + 4 * C.lane + 256 * j); v[j] = (f32x4){bf_lo(xw.x), bf_hi(xw.x), bf_lo(xw.y), bf_hi(xw.y)}; ss += v[j].x * v[j].x + v[j].y * v[j].y + v[j].z * v[j].z + v[j].w * v[j].w; }
            const float rstd = rsqrtf(wave_sum(ss) * (1.0f / D) + 1e-6f);
#pragma unroll
            for (int j = 0; j < 8; ++j) { const int k = 4 * C.lane + 256 * j;
                const f32x4 g = *(const f32x4*)(a.in[I_N2G] + l * D + k), sc = *(const f32x4*)(md + 4 * D + k), sh = *(const f32x4*)(md + 3 * D + k);
                const f32x4 h = v[j] * rstd * (g * (1.0f + sc)) + sh;
                const unsigned p0 = pk2(h.x, h.y), p1 = pk2(h.z, h.w);
                const float l0 = h.x - bf_lo(p0), l1 = h.y - bf_hi(p0), l2 = h.z - bf_lo(p1), l3 = h.w - bf_hi(p1);
                *(LAS v2u*)(TH + (2 * C.wave + rr) * TPH + k) = (v2u){p0, p1};
                *(LAS v2u*)(TLo + (2 * C.wave + rr) * TPH + k) = (v2u){pk2(l0, l1), pk2(l2, l3)};
                *(v2u*)(H + (size_t)r * D + k) = (v2u){p0, p1}; }
        }
        __syncthreads();
        { f32x4 acc[2] = {{0.f, 0.f, 0.f, 0.f}, {0.f, 0.f, 0.f, 0.f}};
#pragma unroll
          for (int s = 0; s < 8; ++s) { const int k = 256 * C.wave + 32 * s + 8 * fq;
              const bf16x8 ah = *(const LAS bf16x8*)(TH + fr * TPH + k), al = *(const LAS bf16x8*)(TLo + fr * TPH + k);
#pragma unroll
              for (int hf = 0; hf < 2; ++hf) { const bf16* rp = RT + (size_t)(16 * hf + fr) * 2048 + k;
                  const bf16x8 bh = *(const bf16x8*)rp, bl = *(const bf16x8*)(rp + 32 * 2048);
                  acc[hf] = __builtin_amdgcn_mfma_f32_16x16x32_bf16(ah, bh, acc[hf], 0, 0, 0);
                  acc[hf] = __builtin_amdgcn_mfma_f32_16x16x32_bf16(ah, bl, acc[hf], 0, 0, 0);
                  acc[hf] = __builtin_amdgcn_mfma_f32_16x16x32_bf16(al, bh, acc[hf], 0, 0, 0); } }
#pragma unroll
          for (int hf = 0; hf < 2; ++hf)
#pragma unroll
              for (int r = 0; r < 4; ++r) PART[(C.wave * 16 + 4 * fq + r) * 32 + 16 * hf + fr] = acc[hf][r]; }
        __syncthreads();
        { const int row = C.tid >> 5, e = C.tid & 31; float lg = 0.f;
#pragma unroll
          for (int w = 0; w < 8; ++w) lg += PART[(w * 16 + row) * 32 + e];
          const float sc = 1.0f / (1.0f + expf(-lg)); SC[row * 32 + e] = sc; SC[512 + row * 32 + e] = sc + a.in[I_RTB][e]; }
        __syncthreads();
        if (C.tid < 16) { const int row = C.tid, t = 16 * tl + row; const LAS float* bi = SC + 512 + row * 32; const LAS float* sc = SC + row * 32;
            int bg = 0; float bgs = -1e30f;
            for (int g = 0; g < 4; ++g) { float m1 = -1e30f, m2 = -1e30f;
                for (int j = 0; j < 8; ++j) { const float x = bi[8 * g + j]; if (x > m1) { m2 = m1; m1 = x; } else if (x > m2) m2 = x; }
                const float gs = m1 + m2; if (gs > bgs) { bgs = gs; bg = g; } }
            int i1 = 0; float v1 = -1e30f;
            for (int j = 0; j < 8; ++j) { const float x = bi[8 * bg + j]; if (x > v1) { v1 = x; i1 = j; } }
            int i2 = 0; float v2 = -1e30f;
            for (int j = 0; j < 8; ++j) { if (j == i1) continue; const float x = bi[8 * bg + j]; if (x > v2) { v2 = x; i2 = j; } }
            const int e1 = 8 * bg + i1, e2 = 8 * bg + i2; const float w1 = sc[e1], w2 = sc[e2], ws = w1 + w2;
            RE[2 * t] = e1; RE[2 * t + 1] = e2; RWT[2 * t] = w1 / ws; RWT[2 * t + 1] = w2 / ws;
            RI[2 * t] = (int)atomicAdd(cnt + e1, 1u); RI[2 * t + 1] = (int)atomicAdd(cnt + e2, 1u); }
        __syncthreads();
    }
}

__device__ __forceinline__ void ph_scatter(const Args& a, const Ctx& C, int l) {
    LAS int* pst = (LAS int*)(C.lds + EXTRA_OFF);
    unsigned* cnt = (unsigned*)(a.ws + WS_CTL) + CW_CNT + 64 * l;
    if (C.tid < 64) {
        const int c = C.lane < NE ? (int)__hip_atomic_load(cnt + C.lane, __ATOMIC_RELAXED, __HIP_MEMORY_SCOPE_AGENT) : 0;
        const int pad = ((c + 255) >> 8) << 8; int inc = pad;
#pragma unroll
        for (int o = 1; o < 32; o <<= 1) { const int t = __shfl_up(inc, o); if (C.lane >= o) inc += t; }
        const int st = inc - pad;
        if (C.lane < NE) { pst[C.lane] = st; pst[64 + C.lane] = c; if (C.lane == NE - 1) pst[NE] = inc; }
        if (C.bx == 0 && C.lane < NE) { int* tile = (int*)(a.ws + WS_TILE);
            for (int i = 0; i < (pad >> 8); ++i) tile[(st >> 8) + i] = C.lane;
            if (C.lane == NE - 1) tile[192] = inc >> 8; }
    }
    __syncthreads();
    const bf16* H = (const bf16*)(a.ws + WS_H); bf16* XB = (bf16*)(a.ws + WS_XB);
    const int* RE = (const int*)(a.ws + WS_RE); const int* RI = (const int*)(a.ws + WS_RI); int* DEST = (int*)(a.ws + WS_DEST);
    for (int sl = C.gw; sl < 2 * T; sl += C.NGW) {
        const int t = sl >> 1; const int e = RE[sl], idx = RI[sl]; const int dest = pst[e] + idx;
        const v4u* src = (const v4u*)(H + (size_t)t * D); v4u* dst = (v4u*)(XB + (size_t)dest * D);
#pragma unroll
        for (int j = 0; j < 4; ++j) dst[C.lane + 64 * j] = src[C.lane + 64 * j];
        if (C.lane == 0) DEST[sl] = dest;
    }
    for (int idx = C.gw; idx < NE * 256; idx += C.NGW) {
        const int e = idx >> 8, r = idx & 255, c = pst[64 + e], npad = pst[e + 1] - pst[e] - c;
        if (r < npad) { v4u* dst = (v4u*)(XB + (size_t)(pst[e] + c + r) * D);
#pragma unroll
            for (int j = 0; j < 4; ++j) dst[C.lane + 64 * j] = (v4u){0u, 0u, 0u, 0u}; }
    }
    __syncthreads();
}

__device__ __forceinline__ void ph_combine(const Args& a, const Ctx& C, int l) {
    const bf16* X = (const bf16*)(a.ws + WS_X); bf16* XN = (bf16*)(a.ws + WS_XN); const bf16* YB = (const bf16*)(a.ws + WS_YB);
    const int* DEST = (const int*)(a.ws + WS_DEST); const float* RWT = (const float*)(a.ws + WS_RWT);
    const float* modf = (const float*)(a.ws + WS_MOD);
    for (int r = C.gw; r < T; r += C.NGW) {
        const int wh = r < TC ? 1 : 0; const float* gt = modf + (size_t)(l * 2 + wh) * 12288 + 5 * D;
        const int d0 = DEST[2 * r], d1 = DEST[2 * r + 1]; const float w0 = RWT[2 * r], w1 = RWT[2 * r + 1];
        const bf16* xr = X + (size_t)r * D; bf16* xo = XN + (size_t)r * D; const bf16* y0 = YB + (size_t)d0 * D; const bf16* y1 = YB + (size_t)d1 * D;
        f32x4 v[8]; float ss = 0.f;
#pragma unroll
        for (int j = 0; j < 8; ++j) { const int k = 4 * C.lane + 256 * j;
            const v2u xw = *(const v2u*)(xr + k); const f32x4 x = {bf_lo(xw.x), bf_hi(xw.x), bf_lo(xw.y), bf_hi(xw.y)}, g = *(const f32x4*)(gt + k); const v2u p0 = *(const v2u*)(y0 + k), p1 = *(const v2u*)(y1 + k);
            f32x4 f; f.x = w0 * bf_lo(p0.x) + w1 * bf_lo(p1.x); f.y = w0 * bf_hi(p0.x) + w1 * bf_hi(p1.x); f.z = w0 * bf_lo(p0.y) + w1 * bf_lo(p1.y); f.w = w0 * bf_hi(p0.y) + w1 * bf_hi(p1.y);
            v[j] = x + g * f; ss += v[j].x * v[j].x + v[j].y * v[j].y + v[j].z * v[j].z + v[j].w * v[j].w; }
        if (l == NL - 1) {
            if (r >= TC) { const float rstd = rsqrtf(wave_sum(ss) * (1.0f / D) + 1e-6f); float* orow = a.out + (size_t)(r - TC) * D;
#pragma unroll
                for (int j = 0; j < 8; ++j) { const int k = 4 * C.lane + 256 * j; const f32x4 g = *(const f32x4*)(a.in[I_FG] + k); *(f32x4*)(orow + k) = v[j] * rstd * g; } }
        } else {
            const float rstd = rsqrtf(wave_sum(ss) * (1.0f / D) + 1e-6f);
            const float* mdn = modf + (size_t)((l + 1) * 2 + wh) * 12288; bf16* H = (bf16*)(a.ws + WS_H);
#pragma unroll
            for (int j = 0; j < 8; ++j) { const int k = 4 * C.lane + 256 * j;
                *(v2u*)(xo + k) = (v2u){pk2(v[j].x, v[j].y), pk2(v[j].z, v[j].w)};
                const f32x4 g = *(const f32x4*)(a.in[I_N1G] + (l + 1) * D + k), sc = *(const f32x4*)(mdn + D + k), sh = *(const f32x4*)(mdn + k);
                const f32x4 h = v[j] * rstd * (g * (1.0f + sc)) + sh;
                *(v2u*)(H + (size_t)r * D + k) = (v2u){pk2(h.x, h.y), pk2(h.z, h.w)}; }
        }
    }
}

__device__ __forceinline__ Ctx fresh_ctx(const Ctx& C0) {
    Ctx C = C0; int t = C0.tid; asm volatile("" : "+v"(t)); C.tid = t; C.lane = t & 63; C.wave = __builtin_amdgcn_readfirstlane(t >> 6); C.gw = C.bx * NWAVES + C.wave; return C; }
__device__ __forceinline__ int opaque_two() { int n = 2; asm volatile("" : "+s"(n)); return n; }
constexpr int PH_PER_LAYER = 14, N_PHASES = 1 + NL * PH_PER_LAYER;
#ifndef PH_MASK
#define PH_MASK 0xffffffffu
#endif
#define PHM(j) (((PH_MASK) >> (j)) & 1u)
#ifndef GEMM_SP2
#define GEMM_SP2 true
#endif
#ifndef REP_PHASE
#define REP_PHASE (-1)
#endif
#define REPLOOP(j, l) _Pragma("nounroll") for (int rep_ = 0, nrep_ = ((REP_PHASE) == (j) && (l) == 0) ? opaque_two() : 1; rep_ < nrep_; ++rep_)
#define IN(k) (lo <= (k) && (k) < hi)
#define SEAM(k) do { if (IN(k) && IN((k) + 1)) xcd_barrier(bar); } while (0)


template <int l> __device__ __forceinline__ void layer_body(const Args& args, const Ctx& C, const XcdBarrier& bar, const int lo, const int hi, const bool multi) {
    unsigned char* ws = args.ws;
        const int pb = 1 + l * PH_PER_LAYER;
        if (l == 0) {
            if (PHM(0) && IN(pb + 0)) REPLOOP(0, l) ph_norm1(args, fresh_ctx(C), l);
            SEAM(pb + 0);
        }
        if (PHM(1) && IN(pb + 1)) {
            pg8::Gemm g{(const bf16*)(ws + WS_H), (const bf16*)(ws + WS_WIN) + (size_t)l * PW * D, T, PW, D};
            pg8::StaticOrder S; S.init(T, PW, C.G, C.bx);
            pg8::EpiStoreBf16 E{(bf16*)(ws + WS_P), PW, 0x7fffffff};
            pg8::gemm_phase<pg8::EpiStoreBf16, pg8::StaticOrder, true, GEMM_SP2>(C.lds, g, S, E);
        }
        SEAM(pb + 1);
        if (PHM(2) && IN(pb + 2)) REPLOOP(2, l) ph_prep(args, fresh_ctx(C), l);
        SEAM(pb + 2);
        if (PHM(3) && IN(pb + 3)) {
            pg8::Gemm g{(const bf16*)(ws + WS_LA), (const bf16*)(ws + WS_LB) + (size_t)l * LNN * LK, T, LNN, LK};
            pg8::StaticOrder S; S.init(T, LNN, C.G, C.bx);
            pg8::EpiStoreBf16 E{(bf16*)(ws + WS_LORA), LNN, 0x7fffffff};
            pg8::gemm_phase<pg8::EpiStoreBf16, pg8::StaticOrder, true, GEMM_SP2>(C.lds, g, S, E);
        }
        SEAM(pb + 3);
        if (PHM(4) && IN(pb + 4)) { REPLOOP(4, l) ph_rwkv_prep<7>(args, fresh_ctx(C), l); if ((REP_PHASE) >= 420 && (REP_PHASE) < 428 && l == 0) ph_rwkv_prep<((REP_PHASE) >= 420 && (REP_PHASE) < 428) ? (REP_PHASE) - 420 : 0>(args, fresh_ctx(C), l); REPLOOP(41, l) ph_ret_prefix(args, fresh_ctx(C), l); }
        SEAM(pb + 4);
        if (PHM(6) && IN(pb + 6)) {
            const int nsq = C.G >= 128 ? 128 : 0;
            if (nsq == 0) { for (int b = C.bx; b < 128; b += C.G) { if (C.wave == 0) ph_rwkv_seq(args, fresh_ctx(C), b >> 2, b & 3); else if (C.wave == 2) ph_rwkv_seq_y(args, fresh_ctx(C), b >> 2, b & 3);
                    __syncthreads(); if (C.tid == 0) { volatile LAS int* w = (volatile LAS int*)(C.lds + MISC_OFF + 64); w[0] = 0; w[1] = 0; w[2] = 0; } __syncthreads(); } ph_ret_out(args, fresh_ctx(C), l, C.bx, C.G); ph_convert_moe(args, fresh_ctx(C), l, C.gw, C.NGW, (LAS float*)(C.lds + 79872 + (C.wave & 7) * 8704)); }
            else if (C.bx < nsq && C.wave == 0) { const int xi = C.bx >> 3;
                ph_rwkv_seq(args, fresh_ctx(C), (C.bx & 7) * 4 + (xi >> 2), xi & 3); }
            else if (C.bx < nsq && C.wave == 1) { const int xi = C.bx >> 3; ph_rwkv_pref(args, fresh_ctx(C), (C.bx & 7) * 4 + (xi >> 2), xi & 3); }
            else if (C.bx < nsq && C.wave == 2) { const int xi = C.bx >> 3; ph_rwkv_seq_y(args, fresh_ctx(C), (C.bx & 7) * 4 + (xi >> 2), xi & 3); }
            else if (C.bx >= nsq) { const int wid = (C.bx - nsq) * 8 + C.wave; const int nwk = (C.G - nsq) * 8;     REPLOOP(62, l) ph_ret_out(args, fresh_ctx(C), l, C.bx - nsq, C.G - nsq);
                   REPLOOP(63, l) ph_convert_moe(args, fresh_ctx(C), l, wid, nwk, (LAS float*)(C.lds + 79872 + (C.wave & 7) * 8704)); }
        }
        SEAM(pb + 6);
        if (IN(pb + 6) && C.tid == 0) { volatile LAS int* w = (volatile LAS int*)(C.lds + MISC_OFF + 64); w[0] = 0; w[1] = 0; w[2] = 0; }
        if (PHM(7) && IN(pb + 7)) REPLOOP(7, l) ph_rwkv_out(args, fresh_ctx(C), l);
        SEAM(pb + 7);
        if (PHM(8) && IN(pb + 8)) REPLOOP(8, l) {
            constexpr int roff = (l == NL - 1) ? TC : 0;
            pg8::Gemm g{(const bf16*)(ws + WS_YALL) + (size_t)roff * D, (const bf16*)(ws + WS_WOUT) + (size_t)l * D * D, T - roff, D, D};
            pg8::StaticOrder S; S.init(T - roff, D, C.G, C.bx);
            const float* modf = (const float*)(ws + WS_MOD);
            bf16* X = (bf16*)(ws + WS_X); const bf16* XNp = (const bf16*)(ws + WS_XN);
            if constexpr (l == 0) { pg8::EpiResid<false> E{args.in[I_CTX], args.in[I_X], modf + (size_t)(l * 2 + 1) * 12288 + 2 * D, modf + (size_t)(l * 2 + 0) * 12288 + 2 * D, X, D, roff / 256};
                pg8::gemm_phase<pg8::EpiResid<false>, pg8::StaticOrder, true, GEMM_SP2>(C.lds, g, S, E); }
            else { pg8::EpiResid<true> E{XNp, XNp + (size_t)TC * D, modf + (size_t)(l * 2 + 1) * 12288 + 2 * D, modf + (size_t)(l * 2 + 0) * 12288 + 2 * D, X, D, roff / 256};
                pg8::gemm_phase<pg8::EpiResid<true>, pg8::StaticOrder, true, GEMM_SP2>(C.lds, g, S, E); }
        }
        SEAM(pb + 8);
        if (PHM(9) && IN(pb + 9)) REPLOOP(9, l) ph_norm2_route(args, fresh_ctx(C), l, l + 2 * rep_);
        SEAM(pb + 9);
        if (PHM(10) && IN(pb + 10)) REPLOOP(10, l) ph_scatter(args, fresh_ctx(C), l);
        SEAM(pb + 10);
        if (PHM(11) && IN(pb + 11)) REPLOOP(11, l) {
            const int* tile = (const int*)(ws + WS_TILE);
            pg8::Gemm g{(const bf16*)(ws + WS_XB), (const bf16*)(ws + WS_W1) + (size_t)l * NE * 2048 * 2048, MPAD, NE * 2048, D};
            pg8::MoeOrder S{tile[192] * 8, C.G, C.bx, tile};
            pg8::EpiSwiGLU E{(bf16*)(ws + WS_ACT), 1024};
            pg8::gemm_phase<pg8::EpiSwiGLU, pg8::MoeOrder, true, GEMM_SP2>(C.lds, g, S, E);
        }
        SEAM(pb + 11);
        if (PHM(12) && IN(pb + 12)) REPLOOP(12, l) {
            const int* tile = (const int*)(ws + WS_TILE);
            pg8::Gemm g{(const bf16*)(ws + WS_ACT), (const bf16*)(ws + WS_W2) + (size_t)l * NE * 2048 * 1024, MPAD, NE * 2048, 1024};
            pg8::MoeOrder S{tile[192] * 8, C.G, C.bx, tile};
            pg8::EpiStoreBf16 E{(bf16*)(ws + WS_YB), D, 7};
            pg8::gemm_phase<pg8::EpiStoreBf16, pg8::MoeOrder, true, GEMM_SP2>(C.lds, g, S, E);
        }
        SEAM(pb + 12);
        if (PHM(13) && IN(pb + 13)) REPLOOP(13, l) ph_combine(args, fresh_ctx(C), l);
        SEAM(pb + 13);
        if ((REP_PHASE) == 77 && l == 0 && multi) { _Pragma("nounroll") for (int i_ = 0, n_ = 5 * opaque_two(); i_ < n_; ++i_) xcd_barrier(bar); }
    }
__global__ void __launch_bounds__(NTHR, 2) fwd_kernel(Args args) {
    extern __shared__ __attribute__((aligned(16))) unsigned char lds_raw[];
    Ctx C; C.lds = (LAS unsigned char*)lds_raw;
    C.tid = threadIdx.x; C.lane = C.tid & 63; C.wave = __builtin_amdgcn_readfirstlane(C.tid >> 6);
    C.G = gridDim.x; C.bx = blockIdx.x; C.gw = C.bx * NWAVES + C.wave; C.NGW = C.G * NWAVES;
    volatile LAS unsigned* MISC = (volatile LAS unsigned*)(C.lds + MISC_OFF);
    if (C.tid < 64) MISC[C.tid] = 0u;
    __syncthreads();
    unsigned char* ws = args.ws;
    XcdBarrier bar; bar.bar = (unsigned*)(ws + WS_CTL) + CW_BAR; bar.x = 0; bar.st = nullptr;
    const bool multi = (args.ph_hi - args.ph_lo) > 1;
    if (multi) bar = xcd_barrier_post((unsigned*)(ws + WS_CTL) + CW_BAR, MISC + 8);
    const int lo = args.ph_lo, hi = args.ph_hi;
    if (PHM(15) && IN(0)) { REPLOOP(15, 0) ph_prologue(args, fresh_ctx(C)); }
    SEAM(0);
    layer_body<0>(args, C, bar, lo, hi, multi);
    layer_body<1>(args, C, bar, lo, hi, multi);
#undef IN
#undef SEAM
}

extern "C" void kernel_launch(void* const* d_in, const int* in_sizes, int n_in, void* d_out, int out_size, void* d_ws, size_t ws_size, hipStream_t stream) {
    static int grid = 0;
    if (grid == 0) {
        if (n_in != 28 || out_size != TL * D || ws_size < WS_END) { fprintf(stderr, "kernel_launch: unexpected shapes (n_in %d out %d ws %zu need %zu)\n", n_in, out_size, ws_size, (size_t)WS_END); grid = -1; return; }
        int dev = 0, cus = 0, per_cu = 0;
        if (hipGetDevice(&dev) != hipSuccess || hipDeviceGetAttribute(&cus, hipDeviceAttributeMultiprocessorCount, dev) != hipSuccess) { grid = -1; return; }
        if (hipFuncSetAttribute((const void*)fwd_kernel, hipFuncAttributeMaxDynamicSharedMemorySize, LDS_BYTES) != hipSuccess) { fprintf(stderr, "kernel_launch: hipFuncSetAttribute failed\n"); grid = -1; return; }
        if (hipOccupancyMaxActiveBlocksPerMultiprocessor(&per_cu, (const void*)fwd_kernel, NTHR, LDS_BYTES) != hipSuccess || per_cu < 1) { fprintf(stderr, "kernel_launch: occupancy query says %d\n", per_cu); }
        (void)hipGetLastError();
        grid = cus;
    }
    if (grid < 0) return;
    if (hipMemsetAsync((char*)d_ws + WS_CTL, 0, CTL_BYTES, stream) != hipSuccess) return;
    Args a{};
    for (int i = 0; i < 28; ++i) a.in[i] = (const float*)d_in[i];
    a.out = (float*)d_out; a.ws = (unsigned char*)d_ws;
#if MK_N_LAUNCHES == 1
    a.ph_lo = 0; a.ph_hi = N_PHASES;
    hipLaunchKernelGGL(fwd_kernel, dim3(grid), dim3(NTHR), LDS_BYTES, stream, a);
#else
    for (int p = 0; p < N_PHASES; ++p) { a.ph_lo = p; a.ph_hi = p + 1; hipLaunchKernelGGL(fwd_kernel, dim3(grid), dim3(NTHR), LDS_BYTES, stream, a); }
#endif
}
```

```cpp
#include <hip/hip_runtime.h>
#include <cstdio>
#include <cstdint>
namespace pg8 {
#define PG8_LAS __attribute__((address_space(3)))
typedef unsigned short bf16_t;
typedef short bf16x8 __attribute__((ext_vector_type(8)));
typedef float f32x4 __attribute__((ext_vector_type(4)));
typedef unsigned u32x4 __attribute__((ext_vector_type(4)));
constexpr int BM = 256, BK = 64, HALF = 128, HTB = HALF * BK * 2  , STAGE_BYTES = 8 * HTB, NXCD = 8, WGM = 8;

__host__ __device__ __forceinline__ int lds_byte(int r, int c) { const int st = (r >> 4) * 2 + (c >> 5), rr = r & 15, cc = c & 31, ob = rr * 64 + cc * 2; return st * 1024 + (ob ^ (((ob >> 9) & 1) << 5)); }
__host__ __device__ __forceinline__ void stage_rc(int b, int& R, int& C) { const int st = b / 1024, sb = b % 1024, swz = sb ^ (((sb >> 9) & 1) << 5); R = (st >> 1) * 16 + swz / 64; C = (st & 1) * 32 + (swz % 64) / 2; }
__host__ __device__ __forceinline__ int perm32(int rho) { const int n = rho >> 4, i = rho & 15; return 8 * (i >> 2) + 4 * n + (i & 3); }

struct Unit { int pm, pn; };
struct Gemm { const bf16_t* A; const bf16_t* Bt; int M, N, K; };

struct StaticOrder {
    int nM, nN, nwg, G, c;
    __host__ __device__ void init(int M, int N, int G_, int c_) { nM = M / BM; nN = N / BM; nwg = nM * nN; G = G_; c = c_; }
    __host__ __device__ bool next(int i, Unit& u) const {
        const long L = (long)i * G + c; if (L >= nwg) return false;
        int wgid = (int)L; { const int q = nwg / NXCD, r = nwg % NXCD, xcd = wgid % NXCD, off = wgid / NXCD; wgid = (xcd < r ? xcd * (q + 1) : r * (q + 1) + (xcd - r) * q) + off; }
        const int nig = WGM * nN, gid = wgid / nig, fm = gid * WGM, gsz = (nM - fm) < WGM ? (nM - fm) : WGM;
        u.pm = fm + ((wgid % nig) % gsz); u.pn = (wgid % nig) / gsz; return true;
    }
    __device__ __forceinline__ void a_ready(const Unit&) const {}
    __device__ __forceinline__ void done(const Unit&) const {}
};

typedef float f32x2c __attribute__((ext_vector_type(2))); typedef __bf16 bf16x2c __attribute__((ext_vector_type(2)));
__device__ __forceinline__ unsigned cvt_pk_bf16(float lo, float hi) { const f32x2c v = {lo, hi}; return __builtin_bit_cast(unsigned, __builtin_convertvector(v, bf16x2c)); }
typedef float f32x2 __attribute__((ext_vector_type(2)));


struct EpiStoreBf16 {
    static constexpr bool PERM = true, AFTER_DRAIN = false;
    bf16_t* O; int ldc; int pn_mask;
    __device__ __forceinline__ void operator()(const f32x4 (&acc)[2][2][4][2], const Unit& u, int wr, int wc, int fr, int fq) const {
        const int row0 = u.pm * BM + wr * 64 + fr; const int col0 = (u.pn & pn_mask) * BM + wc * 32 + 8 * fq;
#pragma unroll
        for (int ai = 0; ai < 2; ++ai)
#pragma unroll
            for (int m = 0; m < 4; ++m) { bf16_t* rowp = O + (size_t)(row0 + ai * HALF + m * 16) * ldc + col0;
#pragma unroll
                for (int bj = 0; bj < 2; ++bj) { const f32x4 v0 = acc[ai][bj][m][0], v1 = acc[ai][bj][m][1];
                    u32x4 w; w.x = cvt_pk_bf16(v0[0], v0[1]); w.y = cvt_pk_bf16(v0[2], v0[3]); w.z = cvt_pk_bf16(v1[0], v1[1]); w.w = cvt_pk_bf16(v1[2], v1[3]);
                    *(u32x4*)(rowp + bj * HALF) = w; } }
    }
};
struct EpiSwiGLU {
    static constexpr bool PERM = true, AFTER_DRAIN = false;
    bf16_t* O; int ldc;
    __device__ __forceinline__ void operator()(const f32x4 (&acc)[2][2][4][2], const Unit& u, int wr, int wc, int fr, int fq) const {
        const int row0 = u.pm * BM + wr * 64 + fr; const int col0 = (u.pn & 7) * HALF + wc * 32 + 8 * fq;
#pragma unroll
        for (int ai = 0; ai < 2; ++ai)
#pragma unroll
            for (int m = 0; m < 4; ++m) { bf16_t* rowp = O + (size_t)(row0 + ai * HALF + m * 16) * ldc + col0;
                float r[8];
#pragma unroll
                for (int n = 0; n < 2; ++n)
#pragma unroll
                    for (int j = 0; j < 4; ++j) { const float g = acc[ai][0][m][n][j], up = acc[ai][1][m][n][j]; r[n * 4 + j] = g * up / (1.0f + __expf(-g)); }
                u32x4 w; w.x = cvt_pk_bf16(r[0], r[1]); w.y = cvt_pk_bf16(r[2], r[3]); w.z = cvt_pk_bf16(r[4], r[5]); w.w = cvt_pk_bf16(r[6], r[7]);
                *(u32x4*)rowp = w; }
    }
};
template <bool BASE_BF16> struct EpiResid {
    static constexpr bool PERM = false, AFTER_DRAIN = false;
    const void* base_c; const void* base_x; const float* gate_c; const float* gate_x; bf16_t* X; int ldc; int pm_off;
    __device__ __forceinline__ void operator()(const f32x4 (&acc)[2][2][4][2], const Unit& u, int wr, int wc, int fr, int fq) const {
        const int pmr = u.pm + pm_off; const int row0 = pmr * BM + wr * 64 + fr, col0 = u.pn * BM + wc * 32 + 4 * fq;
        const bool isc = (pmr == 0);
        const float* gate = isc ? gate_c : gate_x;
        const size_t boff = isc ? 0 : (size_t)BM * ldc;
        const void* base = isc ? base_c : base_x;
        f32x4 gv[2][2];
#pragma unroll
        for (int bj = 0; bj < 2; ++bj)
#pragma unroll
            for (int n = 0; n < 2; ++n) gv[bj][n] = *(const f32x4*)(gate + col0 + bj * HALF + n * 16);
#pragma unroll
        for (int ai = 0; ai < 2; ++ai)
#pragma unroll
            for (int m = 0; m < 4; ++m) { const size_t off = (size_t)(row0 + ai * HALF + m * 16) * ldc + col0;
#pragma unroll
                for (int bj = 0; bj < 2; ++bj)
#pragma unroll
                    for (int n = 0; n < 2; ++n) { f32x4 bs;
                        if (BASE_BF16) { const unsigned long long w = *(const unsigned long long*)((const bf16_t*)base + (off - boff) + bj * HALF + n * 16); const unsigned lo = (unsigned)w, hi = (unsigned)(w >> 32);
                            bs = (f32x4){__uint_as_float(lo << 16), __uint_as_float(lo & 0xffff0000u), __uint_as_float(hi << 16), __uint_as_float(hi & 0xffff0000u)}; }
                        else bs = *(const f32x4*)((const float*)base + (off - boff) + bj * HALF + n * 16);
                        const f32x4 o = bs + gv[bj][n] * acc[ai][bj][m][n];
                        *(unsigned long long*)(X + off + bj * HALF + n * 16) = (unsigned long long)cvt_pk_bf16(o[0], o[1]) | ((unsigned long long)cvt_pk_bf16(o[2], o[3]) << 32); } }
    }
};
struct MoeGatherOrder {
    int n8, G, c; const int* tile_e; const int* row_tok;
    __device__ __forceinline__ bool next(int i, Unit& u) const {
        const long L = (long)i * G + c; if (L >= n8) return false;
        u.pm = (int)(L >> 3); u.pn = tile_e[u.pm] * 8 + (int)(L & 7); return true;
    }
    __device__ __forceinline__ int arow(const Unit& u, int r) const { return row_tok[u.pm * BM + r]; }
    __device__ __forceinline__ void a_ready(const Unit&) const {}
    __device__ __forceinline__ void done(const Unit&) const {}
};
struct MoeOrder {
    int n8, G, c; const int* tile_e;
    __device__ __forceinline__ bool next(int i, Unit& u) const {
        const long L = (long)i * G + c; if (L >= n8) return false;
        u.pm = (int)(L >> 3); u.pn = tile_e[u.pm] * 8 + (int)(L & 7); return true;
    }
    __device__ __forceinline__ void a_ready(const Unit&) const {}
    __device__ __forceinline__ void done(const Unit&) const {}
};
template <class Epi, class Sched, bool ALIGN_EPI = false, bool SP2 = false, bool GATHER = false>
__device__ __forceinline__ void gemm_phase(PG8_LAS unsigned char* lds, const Gemm g, const Sched& S, const Epi& E) {
    int tid_ = threadIdx.x; asm volatile("" : "+v"(tid_));
    const int tid = tid_, wid = __builtin_amdgcn_readfirstlane(tid >> 6), lane = tid & 63, wr = wid >> 2, wc = wid & 3, fr = lane & 15, fq = lane >> 4;
    const int K = g.K, nt = K / BK;
    unsigned voffA[2], voffB[2]; int gR[2]; unsigned gC[2];
    unsigned gcu[2][2], gnx[2][2];
#pragma unroll
    for (int i = 0; i < 2; ++i) { int R, C; stage_rc(tid * 16 + i * 8192, R, C); const int Rb = Epi::PERM ? ((R & ~31) + perm32(R & 31)) : R;
        voffA[i] = (unsigned)(R * K + C) * 2u; voffB[i] = (unsigned)(Rb * K + C) * 2u; gR[i] = R; gC[i] = (unsigned)C * 2u; }
    const size_t kstep = (size_t)(BK * 2);
    const size_t hstep = (size_t)HALF * K * 2;
    const size_t tstep = 2 * hstep;
    const unsigned ldsw = (unsigned)wid * 1024u;
    const int aoff = lds_byte(wr * 64 + fr, fq * 8), boff = lds_byte(wc * 32 + fr, fq * 8);
#define PG8_SA(b, h) (((b) * 2 + (h)) * HTB)
#define PG8_SB(b, h) ((4 + (b) * 2 + (h)) * HTB)
#define PG8_STAGE(bufoff, gbase, voff) do { _Pragma("unroll") for (int _i = 0; _i < 2; ++_i) \
        __builtin_amdgcn_global_load_lds((const unsigned*)((const char*)(gbase) + (voff)[_i]), (PG8_LAS unsigned*)(lds + (bufoff) + ldsw + _i * 8192), 16, 0, 0); } while (0)
#define PG8_LDA(dst, b, h) do { _Pragma("unroll") for (int m = 0; m < 4; ++m) _Pragma("unroll") for (int k = 0; k < 2; ++k) dst[m][k] = *(const PG8_LAS bf16x8*)(lds + PG8_SA(b, h) + aoff + m * 2048 + k * 1024); } while (0)
#define PG8_LDB(dst, b, h) do { _Pragma("unroll") for (int n = 0; n < 2; ++n) _Pragma("unroll") for (int k = 0; k < 2; ++k) dst[n][k] = *(const PG8_LAS bf16x8*)(lds + PG8_SB(b, h) + boff + n * 2048 + k * 1024); } while (0)
#define PG8_MMA(ai, bj, At, Bt) do { __builtin_amdgcn_s_setprio(1); _Pragma("unroll") for (int m = 0; m < 4; ++m) _Pragma("unroll") for (int n = 0; n < 2; ++n) _Pragma("unroll") for (int k = 0; k < 2; ++k) \
        acc[ai][bj][m][n] = __builtin_amdgcn_mfma_f32_16x16x32_bf16(Bt[n][k], At[m][k], acc[ai][bj][m][n], 0, 0, 0); __builtin_amdgcn_s_setprio(0); } while (0)
#define PG8_WAIT_V(n) asm volatile("s_waitcnt vmcnt(" #n ")" ::: "memory")
#define PG8_WAIT_L(n) asm volatile("s_waitcnt lgkmcnt(" #n ")" ::: "memory")
#define PG8_BAR __builtin_amdgcn_s_barrier()
#define PG8_SCHED __builtin_amdgcn_sched_barrier(0)
    Unit cur, nxt; int ui = 0;
    if (!S.next(0, cur)) return;
    f32x4 acc[2][2][4][2];
#pragma unroll
    for (int a = 0; a < 2; ++a)
#pragma unroll
        for (int b = 0; b < 2; ++b)
#pragma unroll
            for (int m = 0; m < 4; ++m)
#pragma unroll
                for (int n = 0; n < 2; ++n) acc[a][b][m][n] = (f32x4){0.f, 0.f, 0.f, 0.f};
    bf16x8 At[4][2], B0[2][2], B1[2][2];
    const char* cA = GATHER ? (const char*)g.A : (const char*)g.A + (size_t)cur.pm * tstep; const char* cB = (const char*)g.Bt + (size_t)cur.pn * tstep;
    S.a_ready(cur);
    if constexpr (GATHER) {
#pragma unroll
        for (int h = 0; h < 2; ++h)
#pragma unroll
            for (int i = 0; i < 2; ++i) { gcu[h][i] = (unsigned)S.arow(cur, h * HALF + gR[i]) * (unsigned)(K * 2) + gC[i]; gnx[h][i] = gcu[h][i]; } }
#define PG8_STAGE_A(bufoff, p, half, nxtsel) do { if constexpr (GATHER) { unsigned vo_[2] = {(nxtsel) ? gnx[half][0] : gcu[half][0], (nxtsel) ? gnx[half][1] : gcu[half][1]}; PG8_STAGE(bufoff, p, vo_); } \
        else { PG8_STAGE(bufoff, (p) + ((half) ? hstep : 0), voffA); } } while (0)
    if constexpr (SP2) {
        PG8_STAGE(PG8_SB(0, 0), cB, voffB); PG8_STAGE(PG8_SB(0, 1), cB + hstep, voffB); PG8_STAGE_A(PG8_SA(0, 0), cA, 0, false); PG8_STAGE_A(PG8_SA(0, 1), cA, 1, false);
        if (wr == 1) PG8_BAR;
        PG8_WAIT_V(2); PG8_BAR;
        PG8_STAGE(PG8_SB(1, 0), cB + kstep, voffB); PG8_STAGE_A(PG8_SA(1, 0), cA + kstep, 0, false); PG8_STAGE(PG8_SB(1, 1), cB + hstep + kstep, voffB);
        PG8_WAIT_V(6); PG8_BAR;
    } else {
        PG8_STAGE(PG8_SB(0, 0), cB, voffB); PG8_STAGE_A(PG8_SA(0, 0), cA, 0, false); PG8_STAGE(PG8_SB(0, 1), cB + hstep, voffB); PG8_STAGE_A(PG8_SA(0, 1), cA, 1, false);
        if (wr == 1) PG8_BAR;
        PG8_WAIT_V(4); PG8_BAR;
        PG8_STAGE(PG8_SB(1, 0), cB + kstep, voffB); PG8_STAGE_A(PG8_SA(1, 0), cA + kstep, 0, false); PG8_STAGE(PG8_SB(1, 1), cB + hstep + kstep, voffB);
        PG8_WAIT_V(6); PG8_BAR;
    }
    for (;;) {
        const bool has_next = S.next(ui + 1, nxt);
        const char* nA = GATHER ? (const char*)g.A : (has_next ? (const char*)g.A + (size_t)nxt.pm * tstep : cA); const char* nB = has_next ? (const char*)g.Bt + (size_t)nxt.pn * tstep : cB;
        if constexpr (GATHER) { if (has_next) {
#pragma unroll
            for (int h = 0; h < 2; ++h)
#pragma unroll
                for (int i = 0; i < 2; ++i) gnx[h][i] = (unsigned)S.arow(nxt, h * HALF + gR[i]) * (unsigned)(K * 2) + gC[i]; } }
        for (int t = 0; t < nt; t += 2) {
            const bool last = (t == nt - 2);
            const char* a1 = cA + (size_t)(t + 1) * kstep;
            const char* a2 = last ? nA : cA + (size_t)(t + 2) * kstep; const char* b2 = last ? nB : cB + (size_t)(t + 2) * kstep;
            const char* a3 = a2 + kstep; const char* b3 = b2 + kstep;
            if (last && has_next) S.a_ready(nxt);
            if constexpr (SP2) {
            PG8_LDB(B0, 0, 0); PG8_LDB(B1, 0, 1); PG8_SCHED; PG8_LDA(At, 0, 0); PG8_STAGE_A(PG8_SA(1, 1), a1, 1, false);
            PG8_WAIT_V(8); PG8_WAIT_L(0); PG8_BAR; PG8_MMA(0, 0, At, B0); PG8_MMA(0, 1, At, B1); PG8_BAR; PG8_SCHED;
            PG8_LDA(At, 0, 1); PG8_STAGE(PG8_SB(0, 0), b2, voffB); PG8_STAGE(PG8_SB(0, 1), b2 + hstep, voffB); PG8_STAGE_A(PG8_SA(0, 0), a2, 0, last);
            PG8_WAIT_V(8); PG8_WAIT_L(0); PG8_BAR; PG8_MMA(1, 0, At, B0); PG8_MMA(1, 1, At, B1); PG8_BAR; PG8_SCHED;
            PG8_LDB(B0, 1, 0); PG8_LDB(B1, 1, 1); PG8_SCHED; PG8_LDA(At, 1, 0); PG8_STAGE_A(PG8_SA(0, 1), a2, 1, last);
            PG8_WAIT_V(8); PG8_WAIT_L(0); PG8_BAR; PG8_MMA(0, 0, At, B0); PG8_MMA(0, 1, At, B1); PG8_BAR; PG8_SCHED;
            PG8_LDA(At, 1, 1); PG8_STAGE(PG8_SB(1, 0), b3, voffB); PG8_STAGE(PG8_SB(1, 1), b3 + hstep, voffB); PG8_STAGE_A(PG8_SA(1, 0), a3, 0, last);
            PG8_WAIT_V(8); PG8_WAIT_L(0); PG8_BAR; PG8_MMA(1, 0, At, B0); PG8_MMA(1, 1, At, B1); PG8_BAR; PG8_SCHED;
            } else {
            PG8_LDB(B0, 0, 0); PG8_SCHED; PG8_LDA(At, 0, 0); PG8_STAGE_A(PG8_SA(1, 1), a1, 1, false);
            PG8_WAIT_L(8); PG8_BAR; PG8_WAIT_L(0); PG8_MMA(0, 0, At, B0); PG8_BAR; PG8_SCHED;
            PG8_LDB(B1, 0, 1); PG8_STAGE(PG8_SB(0, 0), b2, voffB);
            PG8_BAR; PG8_WAIT_L(0); PG8_MMA(0, 1, At, B1); PG8_BAR;
            PG8_LDA(At, 0, 1); PG8_STAGE_A(PG8_SA(0, 0), a2, 0, last);
            PG8_BAR; PG8_WAIT_L(0); PG8_MMA(1, 0, At, B0); PG8_BAR; PG8_SCHED;
            PG8_STAGE(PG8_SB(0, 1), b2 + hstep, voffB);
            PG8_WAIT_V(6); PG8_BAR; PG8_MMA(1, 1, At, B1); PG8_BAR;
            PG8_LDB(B0, 1, 0); PG8_SCHED; PG8_LDA(At, 1, 0); PG8_STAGE_A(PG8_SA(0, 1), a2, 1, last);
            PG8_WAIT_L(8); PG8_BAR; PG8_WAIT_L(0); PG8_MMA(0, 0, At, B0); PG8_BAR; PG8_SCHED;
            PG8_LDB(B1, 1, 1); PG8_STAGE(PG8_SB(1, 0), b3, voffB);
            PG8_BAR; PG8_WAIT_L(0); PG8_MMA(0, 1, At, B1); PG8_BAR;
            PG8_LDA(At, 1, 1); PG8_STAGE_A(PG8_SA(1, 0), a3, 0, last);
            PG8_BAR; PG8_WAIT_L(0); PG8_MMA(1, 0, At, B0); PG8_BAR; PG8_SCHED;
            PG8_STAGE(PG8_SB(1, 1), b3 + hstep, voffB);
            PG8_WAIT_V(6); PG8_BAR; PG8_MMA(1, 1, At, B1); PG8_BAR;
            }
        }
        if constexpr (ALIGN_EPI) { if (wr == 0) PG8_BAR; }
        if constexpr (!Epi::AFTER_DRAIN) { E(acc, cur, wr, wc, fr, fq); S.done(cur); }
        if (!has_next) break;
#pragma unroll
        for (int a = 0; a < 2; ++a)
#pragma unroll
            for (int b = 0; b < 2; ++b)
#pragma unroll
                for (int m = 0; m < 4; ++m)
#pragma unroll
                    for (int n = 0; n < 2; ++n) acc[a][b][m][n] = (f32x4){0.f, 0.f, 0.f, 0.f};
        cur = nxt; cA = nA; cB = nB; ++ui;
        if constexpr (GATHER) {
#pragma unroll
            for (int h = 0; h < 2; ++h)
#pragma unroll
                for (int i = 0; i < 2; ++i) gcu[h][i] = gnx[h][i]; }
        if constexpr (ALIGN_EPI) { if (wr == 1) PG8_BAR; }
    }
    PG8_WAIT_V(0);
    if constexpr (!ALIGN_EPI) { if (wr == 0) PG8_BAR; }
    PG8_BAR;
    if constexpr (Epi::AFTER_DRAIN) { E.fused(acc, cur, wr, wc, fr, fq, lds, wid, lane); S.done(cur); }
#undef PG8_SA
#undef PG8_SB
#undef PG8_STAGE
#undef PG8_STAGE_A
#undef PG8_LDA
#undef PG8_LDB
#undef PG8_MMA
#undef PG8_WAIT_V
#undef PG8_WAIT_L
#undef PG8_BAR
#undef PG8_SCHED
}
}


#ifndef MK_N_LAUNCHES
#define MK_N_LAUNCHES 1
#endif

#define GAS __attribute__((address_space(1)))
#define LAS __attribute__((address_space(3)))
#define CAS __attribute__((address_space(4)))
typedef unsigned short bf16;
typedef unsigned v4u __attribute__((ext_vector_type(4)));
typedef unsigned v2u __attribute__((ext_vector_type(2)));
typedef float f32x4 __attribute__((ext_vector_type(4)));
typedef short bf16x8 __attribute__((ext_vector_type(8)));

constexpr int D = 2048, TC = 256, TL = 16384, T = TC + TL;
constexpr int NL = 2;
constexpr int PIN = 7584, PW = 7680, RWIN = 3488, RET_OFF = 3584;
constexpr int LK = 512, LNN = 5120;
constexpr int NCH = 130;
constexpr int NE = 32, MPAD = 41472, MAXTILES = MPAD / 256;
constexpr int NWAVES = 8, NTHR = 512;
constexpr int KP = 16;

constexpr size_t al256(size_t x) { return (x + 255) & ~(size_t)255; }
constexpr size_t WS_CTL = 0, CTL_BYTES = 1u << 20;
constexpr size_t WS_MODP = CTL_BYTES;
constexpr size_t WS_MOD  = WS_MODP + al256((size_t)NL * KP * 2 * 12288 * 4);
constexpr size_t WS_WIN  = WS_MOD + al256((size_t)NL * 2 * 12288 * 4);
constexpr size_t WS_WOUT = WS_WIN + al256((size_t)NL * PW * D * 2);
constexpr size_t WS_LB   = WS_WOUT + al256((size_t)NL * D * D * 2);
constexpr size_t WS_W1   = WS_LB + al256((size_t)NL * LNN * LK * 2);
constexpr size_t WS_W2   = WS_W1 + al256((size_t)NL * NE * 2048 * 2048 * 2);
constexpr size_t WS_X    = WS_W2 + al256((size_t)NL * NE * 2048 * 1024 * 2);
constexpr size_t WS_XN   = WS_X + al256((size_t)T * D * 4);
constexpr size_t WS_H    = WS_XN + al256((size_t)T * D * 4);
constexpr size_t WS_P    = WS_H + al256((size_t)T * D * 2);
constexpr size_t WS_LA   = WS_P + al256((size_t)T * PW * 2);
constexpr size_t WS_LORA = WS_LA + al256((size_t)T * LK * 2);
constexpr size_t SZ_S    = al256((size_t)T * 1024 * 4);
constexpr size_t SZ_CK   = al256((size_t)32 * 520 * 2048 * 2);
constexpr size_t SZ_CM   = al256((size_t)32 * 520 * 1024 * 2);
constexpr size_t WS_AGP  = WS_LORA + al256((size_t)T * LNN * 2);
constexpr size_t WS_RGP  = WS_AGP + SZ_CK, WS_BGI = WS_RGP + SZ_CK, WS_KGI = WS_BGI + SZ_CK, WS_KGT = WS_KGI + SZ_CK, WS_BGT = WS_KGT + SZ_CK, WS_VTP = WS_BGT + SZ_CK;
constexpr size_t WS_TP   = WS_VTP + SZ_CK, WS_AAK = WS_TP + SZ_CM, WS_ARK = WS_AAK + SZ_CM, WS_ARB = WS_ARK + SZ_CM;
constexpr size_t WS_GC   = WS_ARB + SZ_CM;
constexpr size_t WS_VTOK = WS_GC + al256((size_t)32 * 520 * 256 * 4);
constexpr size_t WS_SY   = WS_VTOK + al256((size_t)2 * T * 1024 * 2);
constexpr size_t WS_BON  = WS_SY + 2 * SZ_S;
constexpr size_t WS_KNRM = WS_BON + al256((size_t)2 * T * 16 * 4 * 4);
constexpr size_t SZ_RT   = al256((size_t)T * 1024 * 2);
constexpr size_t WS_SCT  = WS_KNRM + al256((size_t)T * 16 * 4);
constexpr size_t WS_RT   = WS_SCT + al256((size_t)320 * 32 * 2 * 4);
constexpr size_t WS_QR   = WS_RT + al256((size_t)2 * 32 * 2048 * 2);
constexpr size_t WS_KR   = WS_QR + SZ_RT, WS_VT = WS_KR + SZ_RT, WS_KTF = WS_VT + SZ_RT, WS_KTB = WS_KTF + SZ_RT;
constexpr size_t WS_KVT  = WS_KTB + SZ_RT;
constexpr size_t WS_ST   = WS_KVT + al256((size_t)2 * 8 * NCH * 16384 * 4);
constexpr size_t WS_YALL = WS_ST + al256((size_t)2 * 8 * NCH * 16384 * 2);
constexpr size_t WS_RE   = WS_YALL + al256((size_t)T * D * 2);
constexpr size_t WS_RWT  = WS_RE + al256((size_t)T * 2 * 4);
constexpr size_t WS_RI   = WS_RWT + al256((size_t)T * 2 * 4);
constexpr size_t WS_DEST = WS_RI + al256((size_t)T * 2 * 4);
constexpr size_t WS_TILE = WS_DEST + al256((size_t)T * 2 * 4);
constexpr size_t WS_XB   = WS_TILE + 1024;
constexpr size_t WS_ACT  = WS_XB + al256((size_t)MPAD * D * 2);
constexpr size_t WS_YB   = WS_ACT + al256((size_t)MPAD * 1024 * 2);
constexpr size_t WS_END  = WS_YB + al256((size_t)MPAD * D * 2);
constexpr int CW_BAR = 4096;
constexpr int CW_CNT = 8192;

constexpr int RING_BYTES = 131072, EXTRA_OFF = RING_BYTES, EXTRA_BYTES = 24576, MISC_OFF = EXTRA_OFF + EXTRA_BYTES, LDS_BYTES = MISC_OFF + 256;

__device__ __forceinline__ float bf_lo(unsigned w) { return __uint_as_float(w << 16); }
__device__ __forceinline__ float bf_hi(unsigned w) { return __uint_as_float(w & 0xffff0000u); }
__device__ __forceinline__ unsigned pk2(float lo, float hi) { return pg8::cvt_pk_bf16(lo, hi); }
__device__ __forceinline__ unsigned short f2bf1(float f) { return (unsigned short)(pg8::cvt_pk_bf16(f, 0.f) & 0xffffu); }
__device__ __forceinline__ float wave_sum(float v) {
#pragma unroll
    for (int o = 1; o < 64; o <<= 1) v += __shfl_xor(v, o);
    return v;
}
template <int CTRL> __device__ __forceinline__ float dppf(float v) { return __builtin_bit_cast(float, __builtin_amdgcn_update_dpp(0, __builtin_bit_cast(int, v), CTRL, 0xf, 0xf, true)); }
__device__ __forceinline__ float quadsum(float v) { v += dppf<0xB1>(v); v += dppf<0x4E>(v); return v; }
__device__ __forceinline__ float rowsum16(float v) { v += dppf<0xB1>(v); v += dppf<0x4E>(v); v += dppf<0x141>(v); v += dppf<0x140>(v); return v; }
__device__ __forceinline__ float sigmoidf_(float x) { return 1.0f / (1.0f + __expf(-x)); }
#define LDS_WAIT() asm volatile("s_waitcnt lgkmcnt(0)" ::: "memory")

#define XB_TMO      128
#define XB_XCNT(j)  (256  + 64 * (j))
#define XB_XSUB(j)  (1280 + 64 * (j))
#define XB_XGEN(j)  (2304 + 64 * (j))
#define XB_TOP      3328
#define XB_TOPGEN   3392
#define XCD_BAR_WORDS 3456
#define XB_SPIN_CAP (1u << 20)
__device__ __forceinline__ unsigned xb_ld(unsigned* p)              { return __hip_atomic_load(p, __ATOMIC_RELAXED, __HIP_MEMORY_SCOPE_AGENT); }
__device__ __forceinline__ unsigned xb_add(unsigned* p, unsigned v) { return __hip_atomic_fetch_add(p, v, __ATOMIC_RELAXED, __HIP_MEMORY_SCOPE_AGENT); }
__device__ __forceinline__ unsigned xb_xcc_id() { return (unsigned)__builtin_amdgcn_s_getreg((3 << 11) | 20) & 0xFu; }
#define XB_SPIN(cond, bar) do { unsigned _sp = 0; while (cond) { __builtin_amdgcn_s_sleep(1); \
    if ((++_sp & 255u) == 0u) { if (xb_ld(&(bar)[XB_TMO])) break; if (_sp > XB_SPIN_CAP) { atomicAdd(&(bar)[XB_TMO], 1u); break; } } } } while (0)
struct XcdBarrier { unsigned* bar; unsigned x; volatile LAS unsigned* st; };
__device__ __forceinline__ XcdBarrier xcd_barrier_post(unsigned* bar, volatile LAS unsigned* st) {
    XcdBarrier b; b.bar = bar; b.x = xb_xcc_id(); b.st = st;
    if (threadIdx.x == 0) (void)xb_add(&bar[XB_XCNT(b.x)], 1u);
    return b;
}
__device__ __forceinline__ void xcd_barrier_complete(unsigned* bar, unsigned x, unsigned& nloc, unsigned& nx) {
    const unsigned G = gridDim.x * gridDim.y * gridDim.z;
    unsigned sum, cnt, mine, sp = 0u;
    for (;;) {
        sum = 0u; cnt = 0u; mine = 0u;
#pragma unroll
        for (unsigned j = 0; j < 16; ++j) { const unsigned c = xb_ld(&bar[XB_XCNT(j)]); sum += c; cnt += (c > 0u) ? 1u : 0u; mine = (j == x) ? c : mine; }
        if (sum == G) break;
        __builtin_amdgcn_s_sleep(1);
        if ((++sp & 255u) == 0u) { if (xb_ld(&bar[XB_TMO])) break; if (sp > XB_SPIN_CAP) { atomicAdd(&bar[XB_TMO], 1u); break; } }
    }
    nloc = mine > 0u ? mine : 1u; nx = cnt > 0u ? cnt : 1u;
}
__device__ __forceinline__ void xcd_barrier(const XcdBarrier& b) {
    asm volatile("s_waitcnt vmcnt(0)" ::: "memory");
    __syncthreads();
    if (threadIdx.x == 0) {
        unsigned* bar = b.bar; asm volatile("" : "+s"(bar));
        __builtin_amdgcn_s_waitcnt(0);
        unsigned nloc = b.st[0], nx = b.st[1];
        if (nloc == 0u) { xcd_barrier_complete(bar, b.x, nloc, nx); b.st[0] = nloc; b.st[1] = nx; }
        const unsigned old = xb_add(&bar[XB_XSUB(b.x)], 1u);
        const unsigned gen = old / nloc;
        if (old + 1u == (gen + 1u) * nloc) {
            __builtin_amdgcn_fence(__ATOMIC_RELEASE, "agent");
            asm volatile("s_waitcnt vmcnt(0)" ::: "memory");
            const unsigned og = xb_add(&bar[XB_TOP], 1u);
            const unsigned tg = og / nx;
            if (og + 1u == (tg + 1u) * nx) xb_add(&bar[XB_TOPGEN], 1u);
            else XB_SPIN(xb_ld(&bar[XB_TOPGEN]) == tg, bar);
            __builtin_amdgcn_fence(__ATOMIC_ACQUIRE, "agent");
            xb_add(&bar[XB_XGEN(b.x)], 1u);
            asm volatile("s_waitcnt vmcnt(0)" ::: "memory");
        } else {
            XB_SPIN(xb_ld(&bar[XB_XGEN(b.x)]) == gen, bar);
            __builtin_amdgcn_fence(__ATOMIC_ACQUIRE, "agent");
            asm volatile("s_waitcnt vmcnt(0)" ::: "memory");
        }
    }
    __syncthreads();
}

struct Args { const float* in[28]; float* out; unsigned char* ws; int ph_lo, ph_hi; };
enum { I_X = 0, I_C, I_CTX, I_CCTX, I_ADAW, I_ADAB, I_N1G, I_N2G, I_WIN, I_MU, I_W0, I_W2, I_A0, I_A2, I_G2, I_KK, I_KA, I_RK, I_LNW, I_LNB, I_L2D, I_GNW, I_WOUT, I_RTW, I_RTB, I_MW1, I_MW2, I_FG };

struct Ctx {
    LAS unsigned char* lds;
    int tid, lane, wave, G, bx, gw, NGW;
};

__device__ __forceinline__ void tr_item(const float* W, int K, int N, bf16* WT, int k0, int n0, int orow0, LAS float* scr, int lane) {
#pragma unroll 8
    for (int i = 0; i < 32; ++i) { const int kk = 2 * i + (lane >> 5); scr[kk * 33 + (lane & 31)] = W[(size_t)(k0 + kk) * N + n0 + (lane & 31)]; }
    LDS_WAIT();
    const int c = lane & 7;
#pragma unroll
    for (int j = 0; j < 4; ++j) { const int n = (lane >> 3) + 8 * j; const LAS float* s = scr + (8 * c) * 33 + n;
        v4u o; o.x = pk2(s[0 * 33], s[1 * 33]); o.y = pk2(s[2 * 33], s[3 * 33]); o.z = pk2(s[4 * 33], s[5 * 33]); o.w = pk2(s[6 * 33], s[7 * 33]);
        *(v4u*)(WT + (size_t)(orow0 + n) * K + k0 + 8 * c) = o; }
    LDS_WAIT();
}
__device__ __forceinline__ void ph_prologue(const Args& a, const Ctx& C) {
    unsigned char* ws = a.ws;
    LAS float* scr = (LAS float*)(C.lds + C.wave * 16384);
    constexpr int IW_IN = 32 * 237, IW_OUT = 32 * 64, PER = IW_IN + IW_OUT;
    for (int it = C.gw; it < NL * PER; it += C.NGW) {
        const int l = it / PER; int r = it % PER;
        if (r < IW_IN) { const int kb = r / 237, nb = r % 237, n0 = 32 * nb;
            tr_item(a.in[I_WIN] + (size_t)l * D * PIN, D, PIN, (bf16*)(ws + WS_WIN) + (size_t)l * PW * D, 64 * kb, n0, n0 < RWIN ? n0 : n0 + (RET_OFF - RWIN), scr, C.lane); continue; }
        r -= IW_IN;
        { const int kb = r / 64, nb = r % 64;
            tr_item(a.in[I_WOUT] + (size_t)l * D * D, D, D, (bf16*)(ws + WS_WOUT) + (size_t)l * D * D, 64 * kb, 32 * nb, 32 * nb, scr, C.lane); }
    }
    const int gtid = C.gw * 64 + C.lane, NGT = C.NGW * 64;
    for (int i = gtid; i < NL * 96 * (D / 8); i += NGT) { const int l = i / (96 * 256), r = (i / 256) % 96, c8 = i % 256;
        *(v4u*)((bf16*)(ws + WS_WIN) + ((size_t)l * PW + RWIN + r) * D + 8 * c8) = (v4u){0u, 0u, 0u, 0u}; }
    for (int i = gtid; i < NL * LNN * (LK / 8); i += NGT) {
        const int l = i / (LNN * 64), n = (i / 64) % LNN, k0 = 8 * (i % 64);
        const int blk = n >> 10, nn = n & 1023;
        float v[8];
#pragma unroll
        for (int j = 0; j < 8; ++j) { const int k = k0 + j; float x = 0.f;
            if (blk < 2) { if ((k >> 6) == blk) x = a.in[I_W2][((size_t)(l * 2 + blk) * 64 + (k & 63)) * 1024 + nn]; }
            else if (blk < 4) { if ((k >> 6) == blk) x = a.in[I_A2][((size_t)(l * 2 + (blk - 2)) * 64 + (k & 63)) * 1024 + nn]; }
            else { if (k >= 256 && k < 416) x = a.in[I_G2][((size_t)l * 160 + (k - 256)) * 1024 + nn]; }
            v[j] = x; }
        *(v4u*)((bf16*)(ws + WS_LB) + ((size_t)l * LNN + n) * LK + k0) = (v4u){pk2(v[0], v[1]), pk2(v[2], v[3]), pk2(v[4], v[5]), pk2(v[6], v[7])};
    }
    for (int i = gtid; i < 32 * 2048; i += NGT) { const int e = i >> 11, k = i & 2047; const float w = a.in[I_RTW][(size_t)k * 32 + e];
        const unsigned short hi = f2bf1(w); const float hf = __uint_as_float((unsigned)hi << 16);
        bf16* rt = (bf16*)(ws + WS_RT); rt[i] = hi; rt[32 * 2048 + i] = f2bf1(w - hf); }
    for (int i = gtid; i < 320 * 32; i += NGT) { const int pv = i >> 5, fi = i & 31; const float ang = (float)(pv < 256 ? pv : pv - 256) * exp2f(-(float)(2 * fi) * (13.287712379549449f / 64.0f));
        float* sct = (float*)(ws + WS_SCT); sct[2 * i] = cosf(ang); sct[2 * i + 1] = sinf(ang); }
    for (int it = C.gw; it < NL * KP * 48; it += C.NGW) {
        const int l = it / (KP * 48), kp = (it / 48) % KP, jb = it % 48;
        const int kb = 128 * kp;
        { const float c0 = a.in[I_C][kb + C.lane], c1 = a.in[I_C][kb + 64 + C.lane], x0 = a.in[I_CCTX][kb + C.lane], x1 = a.in[I_CCTX][kb + 64 + C.lane];
          scr[C.lane] = c0 * sigmoidf_(c0); scr[64 + C.lane] = c1 * sigmoidf_(c1); scr[128 + C.lane] = x0 * sigmoidf_(x0); scr[192 + C.lane] = x1 * sigmoidf_(x1); }
        LDS_WAIT();
        f32x4 ax = {0.f, 0.f, 0.f, 0.f}, ac = {0.f, 0.f, 0.f, 0.f};
        const float* wp = a.in[I_ADAW] + ((size_t)l * D + kb) * 12288 + 256 * jb + 4 * C.lane;
#pragma unroll 8
        for (int k = 0; k < 128; ++k) { const f32x4 w = *(const f32x4*)(wp + (size_t)k * 12288); const float sx = scr[k], sc = scr[128 + k]; ax += w * sx; ac += w * sc; }
        float* mp = (float*)(ws + WS_MODP) + ((size_t)(l * KP + kp) * 2) * 12288 + 256 * jb + 4 * C.lane;
        *(f32x4*)mp = ax; *(f32x4*)(mp + 12288) = ac;
        LDS_WAIT();
    }
}

__device__ __forceinline__ void ph_convert_moe(const Args& a, const Ctx& C, int l, int wid, int nw, LAS float* scr) {
    unsigned char* ws = a.ws;
    constexpr int IW_1 = 32 * 32 * 64, IW_2 = 32 * 16 * 64;
    for (int it = wid; it < IW_1 + IW_2; it += nw) {
        int r = it;
        if (r < IW_1) { const int e = r / 2048, rr = r % 2048, kb = rr / 64, nb = rr % 64, n0 = 32 * nb;
            const int orow = n0 < 1024 ? 256 * (n0 >> 7) + (n0 & 127) : 256 * ((n0 - 1024) >> 7) + 128 + ((n0 - 1024) & 127);
            tr_item(a.in[I_MW1] + (size_t)(l * NE + e) * 2048 * 2048, 2048, 2048, (bf16*)(ws + WS_W1) + (size_t)(l * NE + e) * 2048 * 2048, 64 * kb, n0, orow, scr, C.lane); continue; }
        r -= IW_1;
        { const int e = r / 1024, rr = r % 1024, kb = rr / 64, nb = rr % 64;
            tr_item(a.in[I_MW2] + (size_t)(l * NE + e) * 1024 * 2048, 1024, 2048, (bf16*)(ws + WS_W2) + (size_t)(l * NE + e) * 2048 * 1024, 64 * kb, 32 * nb, 32 * nb, scr, C.lane); }
    }
}
__device__ __forceinline__ float mod_from_partials(const Args& a, int l, int which, int j) {
    float s = a.in[I_ADAB][l * 12288 + j];
    const float* mp = (const float*)(a.ws + WS_MODP) + ((size_t)(l * KP) * 2 + which) * 12288 + j;
#pragma unroll
    for (int kp = 0; kp < KP; ++kp) s += mp[(size_t)kp * 2 * 12288];
    return s;
}

__device__ __forceinline__ const float* xrow_ptr(const Args& a, int l, int r) {
    if (l == 0) return r < TC ? a.in[I_CTX] + (size_t)r * D : a.in[I_X] + (size_t)(r - TC) * D;
    return (const float*)(a.ws + WS_XN) + (size_t)r * D;
}
__device__ __forceinline__ void ph_norm1(const Args& a, const Ctx& C, int l) {
    LAS float* GV = (LAS float*)C.lds;
    if (l == 0) {
        float* modf = (float*)(a.ws + WS_MOD);
        for (int i = C.bx * NTHR + C.tid; i < NL * 2 * 12288; i += C.G * NTHR) { const int ll = i / (2 * 12288), wh = (i / 12288) & 1, j = i % 12288; modf[i] = mod_from_partials(a, ll, wh, j); }
    }
    for (int i = C.tid; i < 2 * D; i += NTHR) { const int wh = i / D, k = i % D;
        const float sh = mod_from_partials(a, l, wh, k), sc = mod_from_partials(a, l, wh, D + k);
        GV[wh * D + k] = a.in[I_N1G][l * D + k] * (1.0f + sc); GV[2 * D + wh * D + k] = sh; }
    __syncthreads();
    bf16* H = (bf16*)(a.ws + WS_H);
    for (int r = C.gw; r < T; r += C.NGW) {
        const float* xr = xrow_ptr(a, l, r); const int wh = r < TC ? 1 : 0;
        f32x4 v[8]; float ss = 0.f;
#pragma unroll
        for (int j = 0; j < 8; ++j) { v[j] = *(const f32x4*)(xr + 4 * C.lane + 256 * j); ss += v[j].x * v[j].x + v[j].y * v[j].y + v[j].z * v[j].z + v[j].w * v[j].w; }
        const float rstd = rsqrtf(wave_sum(ss) * (1.0f / D) + 1e-6f);
#pragma unroll
        for (int j = 0; j < 8; ++j) { const int k = 4 * C.lane + 256 * j;
            const f32x4 g = *(const LAS f32x4*)(GV + wh * D + k), s = *(const LAS f32x4*)(GV + 2 * D + wh * D + k);
            const f32x4 h = v[j] * rstd * g + s;
            *(v2u*)(H + (size_t)r * D + k) = (v2u){pk2(h.x, h.y), pk2(h.z, h.w)}; }
    }
    __syncthreads();
}

__device__ __forceinline__ void shift_rows(int t, int (&nb)[4], int& nn) {
    const bool isc = t < TC; const int p = t - TC, gc = p & 63, gr = p >> 6;
    nn = isc ? 2 : 4;
    nb[0] = isc ? (t > 0 ? t - 1 : -1) : (gc > 0 ? t - 1 : -1);
    nb[1] = isc ? (t < TC - 1 ? t + 1 : -1) : (gc < 63 ? t + 1 : -1);
    nb[2] = isc ? -1 : (gr > 0 ? t - 64 : -1);
    nb[3] = isc ? -1 : (gr < 255 ? t + 64 : -1);
}
__device__ __forceinline__ void shift8(const bf16* P, const float* mu  , int t, int col0, const int (&nb)[4], int nn, float (&u)[8]) {
    const v4u pc = *(const v4u*)(P + (size_t)t * PW + col0);
    v4u q[4];
#pragma unroll
    for (int j = 0; j < 4; ++j) q[j] = *(const v4u*)(P + (size_t)(nb[j] >= 0 ? nb[j] : t) * PW + col0);
    float p[8] = {bf_lo(pc.x), bf_hi(pc.x), bf_lo(pc.y), bf_hi(pc.y), bf_lo(pc.z), bf_hi(pc.z), bf_lo(pc.w), bf_hi(pc.w)};
#pragma unroll
    for (int i = 0; i < 8; ++i) u[i] = p[i];
#pragma unroll
    for (int j = 0; j < 4; ++j) {
        const float on = (j < nn) ? 1.0f : 0.0f, has = (nb[j] >= 0) ? 1.0f : 0.0f;
        const float n8[8] = {bf_lo(q[j].x), bf_hi(q[j].x), bf_lo(q[j].y), bf_hi(q[j].y), bf_lo(q[j].z), bf_hi(q[j].z), bf_lo(q[j].w), bf_hi(q[j].w)};
        const f32x4 m0 = *(const f32x4*)(mu + (size_t)j * RWIN + col0), m1 = *(const f32x4*)(mu + (size_t)j * RWIN + col0 + 4);
        const float m8[8] = {m0.x, m0.y, m0.z, m0.w, m1.x, m1.y, m1.z, m1.w};
#pragma unroll
        for (int i = 0; i < 8; ++i) u[i] += on * m8[i] * (has * n8[i] - p[i]);
    }
}

__device__ __forceinline__ void ph_prep(const Args& a, const Ctx& C, int l) {
    const bf16* P = (const bf16*)(a.ws + WS_P);
    const float* mu = a.in[I_MU] + (size_t)l * 4 * RWIN;
    bf16* LA = (bf16*)(a.ws + WS_LA);
    for (int t = C.gw; t < T; t += C.NGW) {
        v4u o = {0u, 0u, 0u, 0u};
        if (C.lane < 52) {
            int nb[4], nn; shift_rows(t, nb, nn);
            float u[8]; shift8(P, mu, t, 3072 + 8 * C.lane, nb, nn, u);
            const int cc = 8 * C.lane;
#pragma unroll
            for (int i = 0; i < 8; ++i) { if (cc < 128) u[i] = tanhf(u[i]); else if (cc >= 256) u[i] = sigmoidf_(u[i]); }
            o = (v4u){pk2(u[0], u[1]), pk2(u[2], u[3]), pk2(u[4], u[5]), pk2(u[6], u[7])};
        }
        *(v4u*)(LA + (size_t)t * LK + 8 * C.lane) = o;
    }
    { float* KNRM = (float*)(a.ws + WS_KNRM);
      for (int t = C.gw; t < T; t += C.NGW) {
          int nb[4], nn; shift_rows(t, nb, nn);
          float u[8], ss = 0.f;
#pragma unroll
          for (int hh = 0; hh < 2; ++hh) { shift8(P, mu, t, 1024 + 16 * C.lane + 8 * hh, nb, nn, u);
#pragma unroll
              for (int i = 0; i < 8; ++i) { const float x = u[i] * a.in[I_KK][l * 1024 + 16 * C.lane + 8 * hh + i]; ss += x * x; } }
          ss = quadsum(ss);
          if ((C.lane & 3) == 0) KNRM[(size_t)t * 16 + (C.lane >> 2)] = ss; } }
    bf16* QR = (bf16*)(a.ws + WS_QR); bf16* KR = (bf16*)(a.ws + WS_KR);
    bf16* VT = (bf16*)(a.ws + WS_VT); bf16* KTF = (bf16*)(a.ws + WS_KTF); bf16* KTB = (bf16*)(a.ws + WS_KTB);
    LAS unsigned short* TL0 = (LAS unsigned short*)C.lds;
    constexpr int TP = 136, TSZ = 128 * TP;
    for (int un = C.bx; un < NCH * 8; un += C.G) {
        const int c = un >> 3, h = un & 7, t0 = 128 * c;
        const float l2f = a.in[I_L2D][(l * 2 + 0) * 8 + h], l2b = a.in[I_L2D][(l * 2 + 1) * 8 + h];
        const float lgf = log1pf(-exp2f(-l2f)), lgb = log1pf(-exp2f(-l2b));
        const int m = C.tid >> 2, p = C.tid & 3, t = t0 + m;
        const bool lat = c >= 2; const int pos = t - TC;
        const int half = p >> 1, ib = 16 * (p & 1);
        const int pvi = lat ? (half ? 256 + (pos & 63) : (pos >> 6)) : 0; const float* sct = (const float*)(a.ws + WS_SCT);
        const int d1 = 64 * half + ib;
        const bf16* prow = P + (size_t)t * PW + RET_OFF + 128 * h;
        float q1[16], q2[16], k1[16], k2[16];
        { const v4u a0 = *(const v4u*)(prow + d1), a1 = *(const v4u*)(prow + d1 + 8), b0 = *(const v4u*)(prow + d1 + 32), b1 = *(const v4u*)(prow + d1 + 40);
          const unsigned wa[8] = {a0.x, a0.y, a0.z, a0.w, a1.x, a1.y, a1.z, a1.w}, wb[8] = {b0.x, b0.y, b0.z, b0.w, b1.x, b1.y, b1.z, b1.w};
#pragma unroll
          for (int i = 0; i < 8; ++i) { q1[2 * i] = bf_lo(wa[i]); q1[2 * i + 1] = bf_hi(wa[i]); q2[2 * i] = bf_lo(wb[i]); q2[2 * i + 1] = bf_hi(wb[i]); } }
        { const bf16* kp = prow + 1024;
          const v4u a0 = *(const v4u*)(kp + d1), a1 = *(const v4u*)(kp + d1 + 8), b0 = *(const v4u*)(kp + d1 + 32), b1 = *(const v4u*)(kp + d1 + 40);
          const unsigned wa[8] = {a0.x, a0.y, a0.z, a0.w, a1.x, a1.y, a1.z, a1.w}, wb[8] = {b0.x, b0.y, b0.z, b0.w, b1.x, b1.y, b1.z, b1.w};
#pragma unroll
          for (int i = 0; i < 8; ++i) { k1[2 * i] = bf_lo(wa[i]); k1[2 * i + 1] = bf_hi(wa[i]); k2[2 * i] = bf_lo(wb[i]); k2[2 * i + 1] = bf_hi(wb[i]); } }
        const float ksc = 0.08838834764831845f;
#pragma unroll
        for (int i = 0; i < 16; ++i) {
            float cs = 1.f, sn = 0.f;
            if (lat) { const float* e2 = sct + ((size_t)pvi * 32 + ib + i) * 2; cs = e2[0]; sn = e2[1]; }
            const float qa = q1[i] * cs - q2[i] * sn, qb = q1[i] * sn + q2[i] * cs;
            const float ka = (k1[i] * cs - k2[i] * sn) * ksc, kb = (k1[i] * sn + k2[i] * cs) * ksc;
            q1[i] = qa; q2[i] = qb; k1[i] = ka; k2[i] = kb;
        }
        { bf16* qo = QR + (size_t)t * 1024 + 128 * h; bf16* ko = KR + (size_t)t * 1024 + 128 * h;
          *(v4u*)(qo + d1) = (v4u){pk2(q1[0], q1[1]), pk2(q1[2], q1[3]), pk2(q1[4], q1[5]), pk2(q1[6], q1[7])};
          *(v4u*)(qo + d1 + 8) = (v4u){pk2(q1[8], q1[9]), pk2(q1[10], q1[11]), pk2(q1[12], q1[13]), pk2(q1[14], q1[15])};
          *(v4u*)(qo + d1 + 32) = (v4u){pk2(q2[0], q2[1]), pk2(q2[2], q2[3]), pk2(q2[4], q2[5]), pk2(q2[6], q2[7])};
          *(v4u*)(qo + d1 + 40) = (v4u){pk2(q2[8], q2[9]), pk2(q2[10], q2[11]), pk2(q2[12], q2[13]), pk2(q2[14], q2[15])};
          *(v4u*)(ko + d1) = (v4u){pk2(k1[0], k1[1]), pk2(k1[2], k1[3]), pk2(k1[4], k1[5]), pk2(k1[6], k1[7])};
          *(v4u*)(ko + d1 + 8) = (v4u){pk2(k1[8], k1[9]), pk2(k1[10], k1[11]), pk2(k1[12], k1[13]), pk2(k1[14], k1[15])};
          *(v4u*)(ko + d1 + 32) = (v4u){pk2(k2[0], k2[1]), pk2(k2[2], k2[3]), pk2(k2[4], k2[5]), pk2(k2[6], k2[7])};
          *(v4u*)(ko + d1 + 40) = (v4u){pk2(k2[8], k2[9]), pk2(k2[10], k2[11]), pk2(k2[12], k2[13]), pk2(k2[14], k2[15])}; }
        const float zf = __expf(lgf * (float)(127 - m)), zb = __expf(lgb * (float)m);
#pragma unroll
        for (int i = 0; i < 16; ++i) {
            TL0[TSZ + (d1 + i) * TP + m] = f2bf1(k1[i] * zf);      TL0[TSZ + (d1 + 32 + i) * TP + m] = f2bf1(k2[i] * zf);
            TL0[2 * TSZ + (d1 + i) * TP + m] = f2bf1(k1[i] * zb);  TL0[2 * TSZ + (d1 + 32 + i) * TP + m] = f2bf1(k2[i] * zb);
        }
        { const bf16* vp = prow + 2048 + 32 * p;
#pragma unroll
          for (int j = 0; j < 4; ++j) { const v4u w = *(const v4u*)(vp + 8 * j); const unsigned ww[4] = {w.x, w.y, w.z, w.w};
#pragma unroll
              for (int i = 0; i < 4; ++i) { TL0[(32 * p + 8 * j + 2 * i) * TP + m] = (unsigned short)(ww[i] & 0xffffu); TL0[(32 * p + 8 * j + 2 * i + 1) * TP + m] = (unsigned short)(ww[i] >> 16); } } }
        __syncthreads();
        { const int d = C.tid >> 2, part = C.tid & 3; const size_t go = ((size_t)(h * NCH + c) * 128 + d) * 128 + 32 * part;
#pragma unroll
          for (int j = 0; j < 4; ++j) *(v4u*)(VT + go + 8 * j)  = *(const LAS v4u*)(TL0 + d * TP + 32 * part + 8 * j); }
        { const int fr = C.lane & 15, fq = C.lane >> 4; float* KVT = (float*)(a.ws + WS_KVT);
          bf16x8 A[4];
#pragma unroll
          for (int s = 0; s < 4; ++s) A[s] = *(const LAS bf16x8*)(TL0 + (16 * C.wave + fr) * TP + 32 * s + 8 * fq);
#pragma unroll
          for (int dir = 0; dir < 2; ++dir) { float* outp = KVT + ((size_t)dir * 8 * NCH + (size_t)(h * NCH + c)) * 16384;
#pragma unroll
              for (int n = 0; n < 8; ++n) { f32x4 acc = {0.f, 0.f, 0.f, 0.f};
#pragma unroll
                  for (int s = 0; s < 4; ++s) { const bf16x8 B = *(const LAS bf16x8*)(TL0 + (1 + dir) * TSZ + (16 * n + fr) * TP + 32 * s + 8 * fq); acc = __builtin_amdgcn_mfma_f32_16x16x32_bf16(B, A[s], acc, 0, 0, 0); }
                  *(f32x4*)(outp + (size_t)(16 * C.wave + fr) * 128 + 16 * n + 4 * fq) = acc; } } }
        __syncthreads();
    }
}

__device__ __forceinline__ void ph_ret_kv(const Args& a, const Ctx& C) {
    const bf16* VT = (const bf16*)(a.ws + WS_VT); float* KVT = (float*)(a.ws + WS_KVT);
    const int fr = C.lane & 15, fq = C.lane >> 4;
    for (int un = C.bx; un < 2 * 8 * NCH; un += C.G) {
        const int dir = un / (8 * NCH), hc = un % (8 * NCH);
        const bf16* KT = (const bf16*)(a.ws + (dir ? WS_KTB : WS_KTF)) + (size_t)hc * 16384;
        const bf16* vt = VT + (size_t)hc * 16384 + (size_t)(16 * C.wave + fr) * 128 + 8 * fq;
        bf16x8 A[4];
#pragma unroll
        for (int s = 0; s < 4; ++s) A[s] = *(const bf16x8*)(vt + 32 * s);
        float* outp = KVT + ((size_t)dir * 8 * NCH + hc) * 16384;
#pragma unroll
        for (int n = 0; n < 8; ++n) {
            f32x4 acc = {0.f, 0.f, 0.f, 0.f};
            const bf16* kt = KT + (size_t)(16 * n + fr) * 128 + 8 * fq;
#pragma unroll
            for (int s = 0; s < 4; ++s) { const bf16x8 B = *(const bf16x8*)(kt + 32 * s); acc = __builtin_amdgcn_mfma_f32_16x16x32_bf16(B, A[s], acc, 0, 0, 0); }
            *(f32x4*)(outp + (size_t)(16 * C.wave + fr) * 128 + 16 * n + 4 * fq) = acc;
        }
    }
}
__device__ __forceinline__ void ph_ret_prefix(const Args& a, const Ctx& C, int l) {
    const float* KVT = (const float*)(a.ws + WS_KVT); bf16* ST = (bf16*)(a.ws + WS_ST);
    for (int i = C.bx * NTHR + C.tid; i < 16 * 16384; i += C.G * NTHR) {
        const int dh = i >> 14, el = i & 16383, dir = dh >> 3, h = dh & 7;
        const float l2 = a.in[I_L2D][(l * 2 + dir) * 8 + h]; const float gC = __expf(128.0f * log1pf(-exp2f(-l2)));
        const float* kv = KVT + (size_t)dh * NCH * 16384 + el; bf16* st = ST + (size_t)dh * NCH * 16384 + el;
        float s = 0.f;
        for (int b0 = 0; b0 < NCH; b0 += 10) {
            float kvv[10]; int cc[10];
#pragma unroll
            for (int j = 0; j < 10; ++j) { const int o = b0 + j; cc[j] = dir == 0 ? o : (o < 2 ? 1 - o : (NCH + 1) - o); kvv[j] = kv[(size_t)cc[j] * 16384]; }
#pragma unroll
            for (int j = 0; j < 10; ++j) { st[(size_t)cc[j] * 16384] = f2bf1(s); s = s * gC + kvv[j]; }
        }
    }
}
__device__ __forceinline__ void ph_ret_out(const Args& a, const Ctx& C, int l, int ub, int nblk) {
    const bf16* QR = (const bf16*)(a.ws + WS_QR); const bf16* KR = (const bf16*)(a.ws + WS_KR); const bf16* VT = (const bf16*)(a.ws + WS_VT);
    const bf16* ST = (const bf16*)(a.ws + WS_ST); const bf16* P = (const bf16*)(a.ws + WS_P); bf16* YALL = (bf16*)(a.ws + WS_YALL);
    const int fr = C.lane & 15, fq = C.lane >> 4;
    constexpr int PP = 136, TSZ = 128 * PP;
    LAS unsigned short* T0 = (LAS unsigned short*)C.lds; LAS unsigned short* T1 = T0 + TSZ; LAS unsigned short* T2 = T1 + TSZ;
    LAS unsigned short* Pw = T0 + 3 * TSZ + C.wave * 16 * PP;
    for (int un = ub; un < NCH * 8; un += nblk) {
        const int c = un >> 3, h = un & 7, t0 = 128 * c, hc = h * NCH + c, rs = C.wave;
        const float l2f = a.in[I_L2D][(l * 2 + 0) * 8 + h], l2b = a.in[I_L2D][(l * 2 + 1) * 8 + h];
        const float lgf2 = log1pf(-exp2f(-l2f)) * 1.4426950408889634f, lgb2 = log1pf(-exp2f(-l2b)) * 1.4426950408889634f;
#pragma unroll
        for (int j = 0; j < 4; ++j) { const int pc = C.tid + NTHR * j, r = pc >> 4, c16 = pc & 15;
            *(LAS v4u*)(T0 + r * PP + 8 * c16) = *(const v4u*)(KR + (size_t)(t0 + r) * 1024 + 128 * h + 8 * c16); }
        bf16x8 QA[4];
        { const bf16* qp = QR + (size_t)(t0 + 16 * rs + fr) * 1024 + 128 * h + 8 * fq;
#pragma unroll
          for (int s = 0; s < 4; ++s) QA[s] = *(const bf16x8*)(qp + 32 * s); }
        __syncthreads();
#pragma unroll
        for (int j = 0; j < 8; ++j) {
            f32x4 acc = {0.f, 0.f, 0.f, 0.f};
#pragma unroll
            for (int s = 0; s < 4; ++s) { const bf16x8 B = *(const LAS bf16x8*)(T0 + (16 * j + fr) * PP + 32 * s + 8 * fq); acc = __builtin_amdgcn_mfma_f32_16x16x32_bf16(QA[s], B, acc, 0, 0, 0); }
#pragma unroll
            for (int r = 0; r < 4; ++r) { const int n = 16 * rs + 4 * fq + r, m = 16 * j + fr, df = n - m;
                const float f = df >= 0 ? exp2f(lgf2 * (float)df) : exp2f(lgb2 * (float)(-df));
                Pw[(4 * fq + r) * PP + m] = f2bf1(acc[r] * f); }
        }
        __syncthreads();
#pragma unroll
        for (int j = 0; j < 4; ++j) { const int pc = C.tid + NTHR * j, r = pc >> 4, c16 = pc & 15; const size_t go = (size_t)hc * 16384 + (size_t)r * 128 + 8 * c16;
            *(LAS v4u*)(T0 + r * PP + 8 * c16) = *(const v4u*)(VT + go);
            *(LAS v4u*)(T1 + r * PP + 8 * c16) = *(const v4u*)(ST + (size_t)(0 * 8) * NCH * 16384 + go);
            *(LAS v4u*)(T2 + r * PP + 8 * c16) = *(const v4u*)(ST + (size_t)(1 * 8) * NCH * 16384 + go); }
        __syncthreads();
        f32x4 aY[8];
        bf16x8 PA[4];
#pragma unroll
        for (int s = 0; s < 4; ++s) PA[s] = *(const LAS bf16x8*)(Pw + fr * PP + 32 * s + 8 * fq);
        const int n = 16 * rs + fr;
        const float xf = exp2f(lgf2 * (float)(n + 1)), xb = exp2f(lgb2 * (float)(128 - n));
        float ss = 0.f;
#pragma unroll
        for (int j = 0; j < 8; ++j) {
            const int dvr = 32 * (j >> 1) + 8 * (fr >> 2) + 4 * (j & 1) + (fr & 3);
            f32x4 y = {0.f, 0.f, 0.f, 0.f}, zf = y, zb = y;
#pragma unroll
            for (int s = 0; s < 4; ++s) {
                const bf16x8 Av = *(const LAS bf16x8*)(T0 + dvr * PP + 32 * s + 8 * fq), Af = *(const LAS bf16x8*)(T1 + dvr * PP + 32 * s + 8 * fq), Ab = *(const LAS bf16x8*)(T2 + dvr * PP + 32 * s + 8 * fq);
                y = __builtin_amdgcn_mfma_f32_16x16x32_bf16(Av, PA[s], y, 0, 0, 0);
                zf = __builtin_amdgcn_mfma_f32_16x16x32_bf16(Af, QA[s], zf, 0, 0, 0);
                zb = __builtin_amdgcn_mfma_f32_16x16x32_bf16(Ab, QA[s], zb, 0, 0, 0);
            }
#pragma unroll
            for (int r = 0; r < 4; ++r) { const float v = y[r] + xf * zf[r] + xb * zb[r]; y[r] = v; ss += v * v; }
            aY[j] = y;
            asm volatile("" : "+v"(aY[j]));
        }
        ss += __shfl_xor(ss, 16); ss += __shfl_xor(ss, 32);
        const float rstd = rsqrtf(ss * (1.0f / 128.0f) + 1e-6f);
        const int t = t0 + n;
#pragma unroll
        for (int m = 0; m < 4; ++m) { const int dv0 = 32 * m + 8 * fq;
            const f32x4 w0 = *(const f32x4*)(a.in[I_GNW] + l * 1024 + 128 * h + dv0), w1 = *(const f32x4*)(a.in[I_GNW] + l * 1024 + 128 * h + dv0 + 4);
            const v4u gq = *(const v4u*)(P + (size_t)t * PW + RET_OFF + 3072 + 128 * h + dv0);
            const float g8[8] = {bf_lo(gq.x), bf_hi(gq.x), bf_lo(gq.y), bf_hi(gq.y), bf_lo(gq.z), bf_hi(gq.z), bf_lo(gq.w), bf_hi(gq.w)};
            const float w8[8] = {w0.x, w0.y, w0.z, w0.w, w1.x, w1.y, w1.z, w1.w};
            float o[8];
#pragma unroll
            for (int i = 0; i < 8; ++i) { const float yv = (i < 4) ? aY[2 * m][i] : aY[2 * m + 1][i - 4]; o[i] = yv * rstd * w8[i] * g8[i] * sigmoidf_(g8[i]); }
            *(v4u*)(YALL + (size_t)t * D + 1024 + 128 * h + dv0) = (v4u){pk2(o[0], o[1]), pk2(o[2], o[3]), pk2(o[4], o[5]), pk2(o[6], o[7])}; }
        __syncthreads();
    }
}

constexpr int NCK = T / 32;
__device__ __forceinline__ int scan_row(int s, int dir) { return dir ? (s < TC ? TC - 1 - s : (T + TC - 1) - s) : s; }
__device__ __forceinline__ int pos_c(int c) { return 32 * (c >> 5) + 8 * ((c >> 2) & 3) + 4 * ((c >> 4) & 1) + (c & 3); }
__device__ __forceinline__ int pos_i(int i) { return 8 * ((i >> 2) & 3) + 4 * (i >> 4) + (i & 3); }
__device__ __forceinline__ float wave_sum_all(float v) {
    v = rowsum16(v);
    const float a = __builtin_bit_cast(float, __builtin_amdgcn_readlane(__builtin_bit_cast(int, v), 0)), b = __builtin_bit_cast(float, __builtin_amdgcn_readlane(__builtin_bit_cast(int, v), 16));
    const float c = __builtin_bit_cast(float, __builtin_amdgcn_readlane(__builtin_bit_cast(int, v), 32)), d = __builtin_bit_cast(float, __builtin_amdgcn_readlane(__builtin_bit_cast(int, v), 48));
    return (a + b) + (c + d);
}
__device__ __forceinline__ float ldbf(const bf16* p) { return __uint_as_float((unsigned)(*p) << 16); }

__device__ __forceinline__ void rwkv_mats_unit(const Args& a, const Ctx& C, int cs, LAS float* LA, const LAS unsigned char* bk);
__device__ __forceinline__ void ld8(const bf16* p, float (&o)[8]) { const v4u w = *(const v4u*)p; o[0] = bf_lo(w.x); o[1] = bf_hi(w.x); o[2] = bf_lo(w.y); o[3] = bf_hi(w.y); o[4] = bf_lo(w.z); o[5] = bf_hi(w.z); o[6] = bf_lo(w.w); o[7] = bf_hi(w.w); }
__device__ __forceinline__ float seg_scan32(float x) {
    x += dppf<0x111>(x); x += dppf<0x112>(x); x += dppf<0x114>(x); x += dppf<0x118>(x);
    x += __builtin_bit_cast(float, __builtin_amdgcn_update_dpp(0, __builtin_bit_cast(int, x), 0x142, 0xa, 0xf, false));
    return x;
}
template <int ST> __device__ __forceinline__ void ph_rwkv_prep(const Args& a, const Ctx& C, int l) {
    const bf16* P = (const bf16*)(a.ws + WS_P); const bf16* LO = (const bf16*)(a.ws + WS_LORA); const float* KNRM = (const float*)(a.ws + WS_KNRM);
    bf16* AGP = (bf16*)(a.ws + WS_AGP); bf16* RGP = (bf16*)(a.ws + WS_RGP);
    bf16* KGT = (bf16*)(a.ws + WS_KGT); bf16* BGT = (bf16*)(a.ws + WS_BGT); bf16* VTP = (bf16*)(a.ws + WS_VTP); float* GC = (float*)(a.ws + WS_GC);
    float* BONP = (float*)(a.ws + WS_BON);
    const int gsel = C.lane >> 5, tok = C.lane & 31;
    LAS unsigned short* tl = (LAS unsigned short*)(C.lds + 65536 + C.wave * 9216);
    LAS unsigned char* bkw = C.lds + (((C.wave >> 2) & 1) * 2 + gsel) * 2 * 8192;
    const int nwv = C.NGW & ~63, hq = C.gw & 63, q = hq & 3, h = hq >> 2;
    for (int un = C.gw; (un & ~7) < (NCK / 2) * 64 && C.gw < nwv; un += nwv) {
        const int pp = un >> 6;
        const int g = 2 * pp + gsel, t = 32 * g + tok;
        const int s = q >> 1, fqb = 2 * (q & 1), lcA = 32 * s + 4 * fqb, lcB = lcA + 16;
        const int chA = 64 * h + lcA, chB = 64 * h + lcB;
        int nb[4], nn; shift_rows(t, nb, nn);
        float onf[4], hasf[4]; int nrow[4];
#pragma unroll
        for (int j = 0; j < 4; ++j) { onf[j] = (j < nn) ? 1.0f : 0.0f; hasf[j] = (nb[j] >= 0) ? 1.0f : 0.0f; nrow[j] = nb[j] >= 0 ? nb[j] : t; }
        float r[16], k[16], v[16];
#pragma unroll
        for (int arr = 0; arr < 3; ++arr) {
#pragma unroll
            for (int run = 0; run < 2; ++run) {
                const int cc = 1024 * arr + (run ? chB : chA);
                float pc[8], u[8]; ld8(P + (size_t)t * PW + cc, pc);
#pragma unroll
                for (int i = 0; i < 8; ++i) u[i] = pc[i];
#pragma unroll
                for (int j = 0; j < 4; ++j) { float n8[8]; ld8(P + (size_t)nrow[j] * PW + cc, n8);
                    const CAS float* mu = (const CAS float*)a.in[I_MU] + ((size_t)l * 4 + j) * RWIN + cc;
#pragma unroll
                    for (int i = 0; i < 8; ++i) u[i] += onf[j] * mu[i] * (hasf[j] * n8[i] - pc[i]); }
#pragma unroll
                for (int i = 0; i < 8; ++i) { if (arr == 0) r[8 * run + i] = u[i]; else if (arr == 1) k[8 * run + i] = u[i]; else v[8 * run + i] = u[i]; }
            }
        }
        const float rn = __builtin_amdgcn_rcpf(fmaxf(__builtin_amdgcn_sqrtf(KNRM[(size_t)t * 16 + h]), 1e-12f));
        float kk[16];
#pragma unroll
        for (int i = 0; i < 16; ++i) kk[i] = k[i] * ((const CAS float*)a.in[I_KK])[l * 1024 + (i < 8 ? chA + i : chB + i - 8)] * rn;
#pragma unroll
        for (int d = 0; d < 2; ++d) {
            const int c = d == 0 ? g : (g < 8 ? 7 - g : (NCK + 7) - g);
            const int cs = (d * 16 + h) * NCK + c, ii = d ? 31 - tok : tok, pi = pos_i(ii);
            const bf16* lo = LO + (size_t)t * LNN + d * 1024;
            float bon = 0.f, gcv = 0.f;
            const size_t po = (size_t)cs * 2048 + ((ii >> 4) * 2 + s) * 512 + (ii & 15) * 8;
#pragma unroll
            for (int f = 0; f < 2; ++f) {
                float ag[8], rg[8], bg[8], kg[8], lwv[8], lav[8];
                { const v2u wa = *(const v2u*)(lo + chA + 4 * f), wb = *(const v2u*)(lo + chB + 4 * f), xa = *(const v2u*)(lo + 2048 + chA + 4 * f), xb = *(const v2u*)(lo + 2048 + chB + 4 * f);
                  lwv[0] = bf_lo(wa.x); lwv[1] = bf_hi(wa.x); lwv[2] = bf_lo(wa.y); lwv[3] = bf_hi(wa.y); lwv[4] = bf_lo(wb.x); lwv[5] = bf_hi(wb.x); lwv[6] = bf_lo(wb.y); lwv[7] = bf_hi(wb.y);
                  lav[0] = bf_lo(xa.x); lav[1] = bf_hi(xa.x); lav[2] = bf_lo(xa.y); lav[3] = bf_hi(xa.y); lav[4] = bf_lo(xb.x); lav[5] = bf_hi(xb.x); lav[6] = bf_lo(xb.y); lav[7] = bf_hi(xb.y); }
#pragma unroll
                for (int e = 0; e < 8; ++e) {
                    const int i = (e < 4) ? 4 * f + e : 8 + 4 * f + (e - 4);
                    const int ch = (i < 8 ? chA + i : chB + i - 8), lc = (i < 8 ? lcA + i : lcB + i - 8);
                    const float x = ((const CAS float*)a.in[I_W0])[(size_t)(l * 2 + d) * 1024 + ch] + lwv[e], z = -x;
                    const float sp = fmaxf(z, 0.f) + __logf(1.0f + __expf(-fabsf(z)));
                    const float lw = -__expf(-sp - 0.5f);
                    const float av = __builtin_amdgcn_rcpf(1.0f + __expf(-(((const CAS float*)a.in[I_A0])[(size_t)(l * 2 + d) * 1024 + ch] + lav[e])));
                    const float kd = k[i] * (1.0f + (av - 1.0f) * ((const CAS float*)a.in[I_KA])[l * 1024 + ch]), b = kk[i] * av;
                    float inc = seg_scan32(lw);
                    const float t31 = __builtin_bit_cast(float, __builtin_amdgcn_readlane(__builtin_bit_cast(int, inc), 31)), t63 = __builtin_bit_cast(float, __builtin_amdgcn_readlane(__builtin_bit_cast(int, inc), 63));
                    const float tot = gsel ? t63 : t31;
                    if (d) inc = tot - inc + lw;
                    gcv = (tok == i) ? tot : gcv;
                    const float gp = __expf(inc - lw), gt = __expf(inc), gi = __expf(-inc);
                    ag[e] = kk[i] * gp; rg[e] = r[i] * gt; bg[e] = b * gi; kg[e] = kd * gi;
                    bon += r[i] * kd * ((const CAS float*)a.in[I_RK])[l * 1024 + ch];
                    if (ST & 2) { const int to = i * 64 + 32 * gsel + pi; tl[to] = f2bf1(kg[e]); tl[1024 + to] = f2bf1(-bg[e]); tl[2048 + to] = f2bf1(v[i]); } else asm volatile("" :: "v"(kg[e]), "v"(bg[e]));
                }
                const size_t o = po + (size_t)(fqb + f) * 128;
                if (ST & 1) {
                *(v4u*)(AGP + o) = (v4u){pk2(ag[0], ag[1]), pk2(ag[2], ag[3]), pk2(ag[4], ag[5]), pk2(ag[6], ag[7])};
                *(v4u*)(RGP + o) = (v4u){pk2(rg[0], rg[1]), pk2(rg[2], rg[3]), pk2(rg[4], rg[5]), pk2(rg[6], rg[7])};
                { const int pfe = (int)(o - (size_t)cs * 2048);
                  *(LAS v4u*)(bkw + d * 8192 + pfe * 2) = (v4u){pk2(bg[0], bg[1]), pk2(bg[2], bg[3]), pk2(bg[4], bg[5]), pk2(bg[6], bg[7])};
                  *(LAS v4u*)(bkw + d * 8192 + 4096 + pfe * 2) = (v4u){pk2(kg[0], kg[1]), pk2(kg[2], kg[3]), pk2(kg[4], kg[5]), pk2(kg[6], kg[7])}; }
                } else asm volatile("" :: "v"(ag[0] + ag[1] + ag[2] + ag[3] + ag[4] + ag[5] + ag[6] + ag[7]), "v"(rg[0] + rg[1] + rg[2] + rg[3] + rg[4] + rg[5] + rg[6] + rg[7]));
            }
            if (ST & 2) {
                LDS_WAIT();
                const int kl = C.lane & 15, gs = (C.lane >> 4) & 1, op = C.lane >> 5, lcl = kl < 8 ? lcA + kl : lcB + kl - 8;
                const int gg = 2 * pp + gs, cg = d == 0 ? gg : (gg < 8 ? 7 - gg : (NCK + 7) - gg);
                const size_t ob = (size_t)((d * 16 + h) * NCK + cg) * 2048 + ((lcl >> 4) * 64 + (lcl & 15)) * 8;
#pragma unroll
                for (int oo = 0; oo < 2; ++oo) { const int o = 2 * op + oo; const int la = kl * 64 + 32 * gs + 8 * o;
                    *(v4u*)(KGT + ob + o * 128) = *(const LAS v4u*)(tl + la); *(v4u*)(BGT + ob + o * 128) = *(const LAS v4u*)(tl + 1024 + la); *(v4u*)(VTP + ob + o * 128) = *(const LAS v4u*)(tl + 2048 + la); }
                LDS_WAIT();
            }
            if (ST & 4) BONP[((size_t)(d * 16 + h) * 4 + q) * T + t] = bon; else asm volatile("" :: "v"(bon));
            if ((ST & 4) && tok < 16) GC[(size_t)cs * 64 + (tok < 8 ? lcA + tok : lcB + tok - 8)] = __expf(gcv);
        }
        asm volatile("s_waitcnt vmcnt(0)" ::: "memory");
        __syncthreads();
        { const int hh = (C.wave >> 2) & 1, gs2 = (C.wave >> 1) & 1, d2 = C.wave & 1;
          const int h2 = ((C.gw & ~7) & 63) / 4 + hh, g2 = 2 * pp + gs2, c2 = d2 == 0 ? g2 : (g2 < 8 ? 7 - g2 : (NCK + 7) - g2);
          rwkv_mats_unit(a, C, (d2 * 16 + h2) * NCK + c2, (LAS float*)(C.lds + 65536 + C.wave * 9216), C.lds + ((hh * 2 + gs2) * 2 + d2) * 8192); }
        __syncthreads();
    }
}

__device__ __forceinline__ void rwkv_mats_unit(const Args& a, const Ctx& C, int cs, LAS float* LA, const LAS unsigned char* bk) {
    const bf16* AGP = (const bf16*)(a.ws + WS_AGP); const bf16* RGP = (const bf16*)(a.ws + WS_RGP);
    bf16* TPm = (bf16*)(a.ws + WS_TP); bf16* AAK = (bf16*)(a.ws + WS_AAK); bf16* ARK = (bf16*)(a.ws + WS_ARK); bf16* ARB = (bf16*)(a.ws + WS_ARB);
    LAS float* LT = LA + 32 * 36;
    {
        int ln = C.lane; asm volatile("" : "+v"(ln));
        const int fr = ln & 15, fq = ln >> 4;
        const size_t o = (size_t)cs * 2048 + ln * 8;
        bf16x8 AG[2][2], RG[2][2], BG[2][2], KG[2][2];
#pragma unroll
        for (int tt = 0; tt < 2; ++tt)
#pragma unroll
            for (int s = 0; s < 2; ++s) { const size_t off = o + (tt * 2 + s) * 512;
                AG[tt][s] = *(const bf16x8*)(AGP + off); RG[tt][s] = *(const bf16x8*)(RGP + off);
                BG[tt][s] = *(const LAS bf16x8*)(bk + ((tt * 2 + s) * 512 + ln * 8) * 2); KG[tt][s] = *(const LAS bf16x8*)(bk + 4096 + ((tt * 2 + s) * 512 + ln * 8) * 2); }
#pragma unroll
        for (int tt = 0; tt < 2; ++tt) {
            f32x4 ab[2], ak[2], rk[2], rb[2];
#pragma unroll
            for (int it = 0; it < 2; ++it) {
                ab[it] = (f32x4){0.f, 0.f, 0.f, 0.f}; ak[it] = ab[it]; rk[it] = ab[it]; rb[it] = ab[it];
                if (it <= tt) {
#pragma unroll
                    for (int s = 0; s < 2; ++s) {
                        ab[it] = __builtin_amdgcn_mfma_f32_16x16x32_bf16(BG[it][s], AG[tt][s], ab[it], 0, 0, 0);
                        ak[it] = __builtin_amdgcn_mfma_f32_16x16x32_bf16(KG[it][s], AG[tt][s], ak[it], 0, 0, 0);
                        rk[it] = __builtin_amdgcn_mfma_f32_16x16x32_bf16(KG[it][s], RG[tt][s], rk[it], 0, 0, 0);
                        rb[it] = __builtin_amdgcn_mfma_f32_16x16x32_bf16(BG[it][s], RG[tt][s], rb[it], 0, 0, 0);
                    }
                    const int t = 16 * tt + fr;
#pragma unroll
                    for (int r = 0; r < 4; ++r) { const int i = 16 * it + 4 * fq + r;
                        if (i >= t) { ab[it][r] = 0.f; ak[it][r] = 0.f; }
                        if (i > t) { rk[it][r] = 0.f; rb[it][r] = 0.f; } }
                }
                *(LAS f32x4*)(LA + (16 * tt + fr) * 36 + 16 * it + 4 * fq) = ab[it];
            }
            if (tt == 0) { const size_t so = (size_t)cs * 1024 + ln * 4;
                *(v2u*)(AAK + so) = (v2u){pk2(ak[0][0], ak[0][1]), pk2(ak[0][2], ak[0][3])};
                *(v2u*)(ARK + so) = (v2u){pk2(rk[0][0], rk[0][1]), pk2(rk[0][2], rk[0][3])};
                *(v2u*)(ARB + so) = (v2u){pk2(-rb[0][0], -rb[0][1]), pk2(-rb[0][2], -rb[0][3])}; }
            else { const size_t so = (size_t)cs * 1024 + 256 + ln * 8;
                *(v4u*)(AAK + so) = (v4u){pk2(ak[0][0], ak[0][1]), pk2(ak[0][2], ak[0][3]), pk2(ak[1][0], ak[1][1]), pk2(ak[1][2], ak[1][3])};
                *(v4u*)(ARK + so) = (v4u){pk2(rk[0][0], rk[0][1]), pk2(rk[0][2], rk[0][3]), pk2(rk[1][0], rk[1][1]), pk2(rk[1][2], rk[1][3])};
                *(v4u*)(ARB + so) = (v4u){pk2(-rb[0][0], -rb[0][1]), pk2(-rb[0][2], -rb[0][3]), pk2(-rb[1][0], -rb[1][1]), pk2(-rb[1][2], -rb[1][3])}; }
        }
        LDS_WAIT();
        const int n = ln & 31;
        float x[32];
#pragma unroll
        for (int t = 0; t < 32; ++t) {
            float s = (t == n) ? 1.0f : 0.0f;
#pragma unroll
            for (int m = 0; m < (t + 3) / 4; ++m) { const f32x4 av = *(const LAS f32x4*)(LA + t * 36 + 4 * m);
                if (4 * m + 0 < t) s -= av.x * x[4 * m + 0];
                if (4 * m + 1 < t) s -= av.y * x[4 * m + 1];
                if (4 * m + 2 < t) s -= av.z * x[4 * m + 2];
                if (4 * m + 3 < t) s -= av.w * x[4 * m + 3]; }
            x[t] = s; LT[t * 36 + n] = s;
        }
        LDS_WAIT();
#pragma unroll
        for (int tt = 0; tt < 2; ++tt) { const LAS float* row = LT + (16 * tt + fr) * 36;
            const f32x4 lo = *(const LAS f32x4*)(row + 4 * fq), hi = *(const LAS f32x4*)(row + 16 + 4 * fq);
            if (tt == 0) *(v2u*)(TPm + (size_t)cs * 1024 + ln * 4) = (v2u){pk2(lo.x, lo.y), pk2(lo.z, lo.w)};
            else *(v4u*)(TPm + (size_t)cs * 1024 + 256 + ln * 8) = (v4u){pk2(lo.x, lo.y), pk2(lo.z, lo.w), pk2(hi.x, hi.y), pk2(hi.z, hi.w)}; }
        LDS_WAIT();
    }
}

__device__ __forceinline__ bf16x8 pack_acc2(const f32x4& lo, const f32x4& hi) {
    v4u w = {pk2(lo[0], lo[1]), pk2(lo[2], lo[3]), pk2(hi[0], hi[1]), pk2(hi[2], hi[3])};
    return __builtin_bit_cast(bf16x8, w);
}
struct SeqOpsA { bf16x8 AG[2][2], TPf[2], AK[2], KT[4], BT[4], VB; f32x4 GCv[4]; };
struct SeqOpsB { bf16x8 RG[2][2], RK[2], RB[2]; };
__device__ __forceinline__ void ph_rwkv_seq(const Args& a, const Ctx& C, int hd, int vs) {
    const int fq = C.lane >> 4;
    const bf16* AGP = (const bf16*)(a.ws + WS_AGP); const bf16* KGT = (const bf16*)(a.ws + WS_KGT); const bf16* BGT = (const bf16*)(a.ws + WS_BGT);
    const bf16* VTP = (const bf16*)(a.ws + WS_VTP); const float* GC = (const float*)(a.ws + WS_GC);
    const bf16* TPm = (const bf16*)(a.ws + WS_TP); const bf16* AAK = (const bf16*)(a.ws + WS_AAK);
    const size_t ol = (size_t)C.lane * 8;
#define SEQ_LD64(dst, base, cs_, tt, s) dst = *(const bf16x8*)((base) + (size_t)(cs_) * 2048 + ((tt) * 2 + (s)) * 512 + ol)
#define SEQ_LD32(dst, base, cs_, tt) do { if ((tt) == 0) { const v2u w_ = *(const v2u*)((base) + (size_t)(cs_) * 1024 + C.lane * 4); dst = __builtin_bit_cast(bf16x8, (v4u){w_.x, w_.y, 0u, 0u}); } \
        else dst = *(const bf16x8*)((base) + (size_t)(cs_) * 1024 + 256 + ol); } while (0)
#define SEQ_LDT(dst, base, cs_, mt) dst = *(const bf16x8*)((base) + (size_t)(cs_) * 2048 + (mt) * 512 + ol)
#define SEQA_LOAD1(O, cs_) do { _Pragma("unroll") for (int tt = 0; tt < 2; ++tt) { _Pragma("unroll") for (int s = 0; s < 2; ++s) SEQ_LD64(O.AG[tt][s], AGP, cs_, tt, s); SEQ_LD32(O.AK[tt], AAK, cs_, tt); } } while (0)
#define SEQA_LOAD2(O, cs_) do { _Pragma("unroll") for (int tt = 0; tt < 2; ++tt) SEQ_LD32(O.TPf[tt], TPm, cs_, tt); } while (0)
#define SEQA_LOAD3(O, cs_) do { _Pragma("unroll") for (int mt = 0; mt < 4; ++mt) { SEQ_LDT(O.KT[mt], KGT, cs_, mt); SEQ_LDT(O.BT[mt], BGT, cs_, mt); O.GCv[mt] = *(const f32x4*)(GC + (size_t)(cs_) * 64 + 16 * mt + 4 * fq); } SEQ_LDT(O.VB, VTP, cs_, vs); } while (0)
    const int cs0 = hd * NCK;
    SeqOpsA P0, P1;
    SEQA_LOAD1(P0, cs0); SEQA_LOAD2(P0, cs0); SEQA_LOAD3(P0, cs0);
    SEQA_LOAD1(P1, cs0 + 1); SEQA_LOAD2(P1, cs0 + 1); SEQA_LOAD3(P1, cs0 + 1);
    f32x4 Hc[4];
#pragma unroll
    for (int mt = 0; mt < 4; ++mt) Hc[mt] = (f32x4){0.f, 0.f, 0.f, 0.f};
    bf16x8 Hb[2]; Hb[0] = pack_acc2(Hc[0], Hc[1]); Hb[1] = pack_acc2(Hc[2], Hc[3]);
    volatile LAS int* prog = (volatile LAS int*)(C.lds + MISC_OFF + 64);
    volatile LAS int* fa = (volatile LAS int*)(C.lds + MISC_OFF + 68);
    volatile LAS int* fb = (volatile LAS int*)(C.lds + MISC_OFF + 72);
    LAS unsigned char* ring = C.lds;
#define SEQA_BODY(O, c) do { \
        if (C.lane == 0) *prog = (c); \
        const int cn = cs0 + ((c) + 2 < NCK ? (c) + 2 : NCK - 1); \
        LAS unsigned char* slot = ring + ((c) & 7) * 4096 + C.lane * 16; \
        if ((c) >= 8) { unsigned sp = 0; while (*fb < (c) - 7 && ++sp < (1u << 24)) __builtin_amdgcn_s_sleep(1); } \
        *(LAS bf16x8*)slot = Hb[0]; *(LAS bf16x8*)(slot + 1024) = Hb[1]; *(LAS bf16x8*)(slot + 3072) = O.VB; \
        f32x4 RH[2], U[2]; \
        _Pragma("unroll") for (int tt = 0; tt < 2; ++tt) { RH[tt] = (f32x4){0.f, 0.f, 0.f, 0.f}; \
            _Pragma("unroll") for (int s = 0; s < 2; ++s) RH[tt] = __builtin_amdgcn_mfma_f32_16x16x32_bf16(O.AG[tt][s], Hb[s], RH[tt], 0, 0, 0); \
            RH[tt] = __builtin_amdgcn_mfma_f32_16x16x32_bf16(O.AK[tt], O.VB, RH[tt], 0, 0, 0); } \
        SEQA_LOAD1(O, cn); \
        const bf16x8 RHb = pack_acc2(RH[0], RH[1]); \
        _Pragma("unroll") for (int tt = 0; tt < 2; ++tt) U[tt] = __builtin_amdgcn_mfma_f32_16x16x32_bf16(O.TPf[tt], RHb, (f32x4){0.f, 0.f, 0.f, 0.f}, 0, 0, 0); \
        SEQA_LOAD2(O, cn); \
        const bf16x8 Ub = pack_acc2(U[0], U[1]); \
        *(LAS bf16x8*)(slot + 2048) = Ub; \
        asm volatile("s_waitcnt lgkmcnt(0)" ::: "memory"); \
        if (C.lane == 0) *fa = (c) + 1; \
        _Pragma("unroll") for (int mt = 0; mt < 4; ++mt) { \
            Hc[mt] = __builtin_amdgcn_mfma_f32_16x16x32_bf16(O.KT[mt], O.VB, Hc[mt], 0, 0, 0); \
            Hc[mt] = __builtin_amdgcn_mfma_f32_16x16x32_bf16(O.BT[mt], Ub, Hc[mt], 0, 0, 0); \
            Hc[mt] = Hc[mt] * O.GCv[mt]; } \
        SEQA_LOAD3(O, cn); \
        Hb[0] = pack_acc2(Hc[0], Hc[1]); Hb[1] = pack_acc2(Hc[2], Hc[3]); } while (0)
    for (int c = 0; c < NCK; c += 2) { SEQA_BODY(P0, c); SEQA_BODY(P1, c + 1); }
    if (C.lane == 0) *prog = NCK + 64;
#undef SEQA_BODY
#undef SEQA_LOAD1
#undef SEQA_LOAD2
#undef SEQA_LOAD3
}
__device__ __forceinline__ void ph_rwkv_seq_y(const Args& a, const Ctx& C, int hd, int vs) {
    const int d = hd >> 4, h = hd & 15, fr = C.lane & 15, fq = C.lane >> 4;
    const bf16* RGP = (const bf16*)(a.ws + WS_RGP); const bf16* VTP = (const bf16*)(a.ws + WS_VTP); const bf16* ARK = (const bf16*)(a.ws + WS_ARK); const bf16* ARB = (const bf16*)(a.ws + WS_ARB);
    bf16* YF = (bf16*)(a.ws + WS_SY) + (size_t)d * T * 1024 + 64 * h + 16 * vs + 4 * fq;
    const size_t ol = (size_t)C.lane * 8;
    const int cs0 = hd * NCK;
#define SEQB_LOAD(O, cs_) do { _Pragma("unroll") for (int tt = 0; tt < 2; ++tt) { _Pragma("unroll") for (int s = 0; s < 2; ++s) SEQ_LD64(O.RG[tt][s], RGP, cs_, tt, s); SEQ_LD32(O.RK[tt], ARK, cs_, tt); SEQ_LD32(O.RB[tt], ARB, cs_, tt); } } while (0)
    SeqOpsB P0, P1;
    SEQB_LOAD(P0, cs0); SEQB_LOAD(P1, cs0 + 1);
    volatile LAS int* fa = (volatile LAS int*)(C.lds + MISC_OFF + 68);
    volatile LAS int* fb = (volatile LAS int*)(C.lds + MISC_OFF + 72);
    LAS unsigned char* ring = C.lds;
#define SEQB_BODY(O, c) do { \
        const int cn = cs0 + ((c) + 2 < NCK ? (c) + 2 : NCK - 1); \
        const int ystep = d ? -1 : 1, yrow0 = d ? ((c) < 8 ? TC - 1 : T + TC - 1) : 0; \
        { unsigned sp = 0; while (*fa <= (c) && ++sp < (1u << 24)) __builtin_amdgcn_s_sleep(1); } \
        asm volatile("" ::: "memory"); \
        const LAS unsigned char* slot = ring + ((c) & 7) * 4096 + C.lane * 16; \
        const bf16x8 H0 = *(const LAS bf16x8*)slot, H1 = *(const LAS bf16x8*)(slot + 1024), Ub = *(const LAS bf16x8*)(slot + 2048), VBs = *(const LAS bf16x8*)(slot + 3072); \
        asm volatile("s_waitcnt lgkmcnt(0)" ::: "memory"); \
        if (C.lane == 0) *fb = (c) + 1; \
        f32x4 Y[2];     \
        _Pragma("unroll") for (int tt = 0; tt < 2; ++tt) { Y[tt] = (f32x4){0.f, 0.f, 0.f, 0.f}; \
            Y[tt] = __builtin_amdgcn_mfma_f32_16x16x32_bf16(H0, O.RG[tt][0], Y[tt], 0, 0, 0); \
            Y[tt] = __builtin_amdgcn_mfma_f32_16x16x32_bf16(H1, O.RG[tt][1], Y[tt], 0, 0, 0); \
            Y[tt] = __builtin_amdgcn_mfma_f32_16x16x32_bf16(VBs, O.RK[tt], Y[tt], 0, 0, 0); \
            Y[tt] = __builtin_amdgcn_mfma_f32_16x16x32_bf16(Ub, O.RB[tt], Y[tt], 0, 0, 0); } \
        SEQB_LOAD(O, cn); \
        _Pragma("unroll") for (int tt = 0; tt < 2; ++tt) *(v2u*)(YF + (size_t)(unsigned)((yrow0 + ystep * (32 * (c) + 16 * tt + fr)) * 1024)) = (v2u){pk2(Y[tt][0], Y[tt][1]), pk2(Y[tt][2], Y[tt][3])}; } while (0)
    for (int c = 0; c < NCK; c += 2) { SEQB_BODY(P0, c); SEQB_BODY(P1, c + 1); }
#undef SEQB_BODY
#undef SEQB_LOAD
#undef SEQ_LD64
#undef SEQ_LD32
#undef SEQ_LDT
}
__device__ __forceinline__ void ph_rwkv_pref(const Args& a, const Ctx& C, int hd, int vs) {
    const unsigned char* ws = a.ws;
    volatile LAS int* prog = (volatile LAS int*)(C.lds + MISC_OFF + 64);
    const int cs0 = hd * NCK;
    constexpr int DEPTH = 12, INFL = 6;
    unsigned x[INFL][4];
#pragma unroll
    for (int i = 0; i < INFL; ++i)
#pragma unroll
        for (int k = 0; k < 4; ++k) x[i][k] = 0u;
#define PREF_ADDR(cs_, k) ({ const int L_ = 64 * (k) + C.lane; const size_t c2_ = (size_t)(cs_) * 4096, c1_ = (size_t)(cs_) * 2048; \
        (L_ < 32 ? ws + WS_AGP + c2_ + 128 * L_ : L_ < 64 ? ws + WS_GC + (size_t)(cs_) * 256   : L_ < 96 ? ws + WS_KGT + c2_ + 128 * (L_ - 64) : L_ < 128 ? ws + WS_BGT + c2_ + 128 * (L_ - 96) : \
         L_ < 160 ? ws + WS_VTP + c2_ + 128 * (L_ - 128) : L_ < 172 ? ws + WS_TP + c1_ + 128 * (L_ - 160) : L_ < 184 ? ws + WS_AAK + c1_ + 128 * (L_ - 172) : L_ < 208 ? ws + WS_GC + (size_t)(cs_) * 256 : \
         L_ >= 210 ? ws + WS_GC + (size_t)(cs_) * 256   : ws + WS_GC + (size_t)(cs_) * 256 + 128 * ((L_ - 224) & 1)); })
    for (int c0 = 2; c0 < NCK; c0 += INFL) {
#pragma unroll
        for (int i = 0; i < INFL; ++i) {
            const int c = c0 + i < NCK ? c0 + i : NCK - 1;
            unsigned spins = 0;
            while (c > *prog + DEPTH && ++spins < (1u << 22)) __builtin_amdgcn_s_sleep(8);
#pragma unroll
            for (int k = 0; k < 4; ++k) { asm volatile("" :: "v"(x[i][k])); x[i][k] = *(const unsigned*)PREF_ADDR(cs0 + c, k); }
        }
    }
#pragma unroll
    for (int i = 0; i < INFL; ++i)
#pragma unroll
        for (int k = 0; k < 4; ++k) asm volatile("" :: "v"(x[i][k]));
#undef PREF_ADDR
}

__device__ __forceinline__ void ph_rwkv_out(const Args& a, const Ctx& C, int l) {
    const bf16* SY = (const bf16*)(a.ws + WS_SY); const bf16* P = (const bf16*)(a.ws + WS_P); const float* mu = a.in[I_MU] + (size_t)l * 4 * RWIN; const float* BON = (const float*)(a.ws + WS_BON);
    const bf16* LO = (const bf16*)(a.ws + WS_LORA); bf16* YALL = (bf16*)(a.ws + WS_YALL);
    const int c0 = 16 * C.lane;
    for (int t = C.gw; t < T; t += C.NGW) {
        const size_t o = (size_t)t * 1024 + c0;
        float y[16], v[16]; float s = 0.f;
        { const v4u f0 = *(const v4u*)(SY + o), f1 = *(const v4u*)(SY + o + 8), b0 = *(const v4u*)(SY + (size_t)T * 1024 + o), b1 = *(const v4u*)(SY + (size_t)T * 1024 + o + 8);
          const unsigned ff[8] = {f0.x, f0.y, f0.z, f0.w, f1.x, f1.y, f1.z, f1.w}, bb[8] = {b0.x, b0.y, b0.z, b0.w, b1.x, b1.y, b1.z, b1.w};
#pragma unroll
          for (int i = 0; i < 8; ++i) { y[2 * i] = bf_lo(ff[i]) + bf_lo(bb[i]); y[2 * i + 1] = bf_hi(ff[i]) + bf_hi(bb[i]); } }
        { int nb[4], nn; shift_rows(t, nb, nn); float u[8];
          shift8(P, mu, t, 2048 + c0, nb, nn, u);
#pragma unroll
          for (int i = 0; i < 8; ++i) v[i] = u[i];
          shift8(P, mu, t, 2048 + c0 + 8, nb, nn, u);
#pragma unroll
          for (int i = 0; i < 8; ++i) v[8 + i] = u[i]; }
#pragma unroll
        for (int i = 0; i < 16; ++i) s += y[i];
        const float mean = quadsum(s) * (1.0f / 64.0f); float q = 0.f;
#pragma unroll
        for (int i = 0; i < 16; ++i) { y[i] -= mean; q += y[i] * y[i]; }
        const float rstd = rsqrtf(quadsum(q) * (1.0f / 64.0f) + 64e-5f);
        float bon = 0.f;
#pragma unroll
        for (int j = 0; j < 8; ++j) bon += BON[((size_t)((j >> 2) * 16 + (C.lane >> 2)) * 4 + (j & 3)) * T + t];
        const bf16* gp = LO + (size_t)t * LNN + 4096 + c0; const v4u g0 = *(const v4u*)gp, g1 = *(const v4u*)(gp + 8);
        const unsigned gg[8] = {g0.x, g0.y, g0.z, g0.w, g1.x, g1.y, g1.z, g1.w};
        float out[16];
#pragma unroll
        for (int i = 0; i < 16; ++i) { const float g = (i & 1) ? bf_hi(gg[i >> 1]) : bf_lo(gg[i >> 1]);
            out[i] = (y[i] * rstd * a.in[I_LNW][l * 1024 + c0 + i] + a.in[I_LNB][l * 1024 + c0 + i] + bon * v[i]) * g; }
        bf16* yo = YALL + (size_t)t * D + c0;
        *(v4u*)yo = (v4u){pk2(out[0], out[1]), pk2(out[2], out[3]), pk2(out[4], out[5]), pk2(out[6], out[7])};
        *(v4u*)(yo + 8) = (v4u){pk2(out[8], out[9]), pk2(out[10], out[11]), pk2(out[12], out[13]), pk2(out[14], out[15])};
    }
}

__device__ __forceinline__ void ph_norm2_route(const Args& a, const Ctx& C, int l, int cslot) {
    const bf16* X = (const bf16*)(a.ws + WS_X); bf16* H = (bf16*)(a.ws + WS_H);
    const float* modf = (const float*)(a.ws + WS_MOD);
    constexpr int TPH = 2056;
    LAS unsigned short* TH = (LAS unsigned short*)C.lds; LAS unsigned short* TLo = TH + 16 * TPH;
    LAS float* PART = (LAS float*)(C.lds + 2 * 16 * TPH * 2);
    LAS float* SC = PART + 8 * 16 * 32;
    int* RE = (int*)(a.ws + WS_RE); float* RWT = (float*)(a.ws + WS_RWT); int* RI = (int*)(a.ws + WS_RI);
    unsigned* cnt = (unsigned*)(a.ws + WS_CTL) + CW_CNT + 64 * cslot;
    const bf16* RT = (const bf16*)(a.ws + WS_RT);
    const int fr = C.lane & 15, fq = C.lane >> 4;
    for (int tl = C.bx; tl < T / 16; tl += C.G) {
#pragma unroll
        for (int rr = 0; rr < 2; ++rr) {
            const int r = 16 * tl + 2 * C.wave + rr; const int wh = r < TC ? 1 : 0;
            const bf16* xr = X + (size_t)r * D; const float* md = modf + (size_t)(l * 2 + wh) * 12288;
            f32x4 v[8]; float ss = 0.f;
#pragma unroll
            for (int j = 0; j < 8; ++j) { const v2u xw = *(const v2u*)(xr + 4 * C.lane + 256 * j); v[j] = (f32x4){bf_lo(xw.x), bf_hi(xw.x), bf_lo(xw.y), bf_hi(xw.y)}; ss += v[j].x * v[j].x + v[j].y * v[j].y + v[j].z * v[j].z + v[j].w * v[j].w; }
            const float rstd = rsqrtf(wave_sum(ss) * (1.0f / D) + 1e-6f);
#pragma unroll
            for (int j = 0; j < 8; ++j) { const int k = 4 * C.lane + 256 * j;
                const f32x4 g = *(const f32x4*)(a.in[I_N2G] + l * D + k), sc = *(const f32x4*)(md + 4 * D + k), sh = *(const f32x4*)(md + 3 * D + k);
                const f32x4 h = v[j] * rstd * (g * (1.0f + sc)) + sh;
                const unsigned p0 = pk2(h.x, h.y), p1 = pk2(h.z, h.w);
                const float l0 = h.x - bf_lo(p0), l1 = h.y - bf_hi(p0), l2 = h.z - bf_lo(p1), l3 = h.w - bf_hi(p1);
                *(LAS v2u*)(TH + (2 * C.wave + rr) * TPH + k) = (v2u){p0, p1};
                *(LAS v2u*)(TLo + (2 * C.wave + rr) * TPH + k) = (v2u){pk2(l0, l1), pk2(l2, l3)};
                *(v2u*)(H + (size_t)r * D + k) = (v2u){p0, p1}; }
        }
        __syncthreads();
        { f32x4 acc[2] = {{0.f, 0.f, 0.f, 0.f}, {0.f, 0.f, 0.f, 0.f}};
#pragma unroll
          for (int s = 0; s < 8; ++s) { const int k = 256 * C.wave + 32 * s + 8 * fq;
              const bf16x8 ah = *(const LAS bf16x8*)(TH + fr * TPH + k), al = *(const LAS bf16x8*)(TLo + fr * TPH + k);
#pragma unroll
              for (int hf = 0; hf < 2; ++hf) { const bf16* rp = RT + (size_t)(16 * hf + fr) * 2048 + k;
                  const bf16x8 bh = *(const bf16x8*)rp, bl = *(const bf16x8*)(rp + 32 * 2048);
                  acc[hf] = __builtin_amdgcn_mfma_f32_16x16x32_bf16(ah, bh, acc[hf], 0, 0, 0);
                  acc[hf] = __builtin_amdgcn_mfma_f32_16x16x32_bf16(ah, bl, acc[hf], 0, 0, 0);
                  acc[hf] = __builtin_amdgcn_mfma_f32_16x16x32_bf16(al, bh, acc[hf], 0, 0, 0); } }
#pragma unroll
          for (int hf = 0; hf < 2; ++hf)
#pragma unroll
              for (int r = 0; r < 4; ++r) PART[(C.wave * 16 + 4 * fq + r) * 32 + 16 * hf + fr] = acc[hf][r]; }
        __syncthreads();
        { const int row = C.tid >> 5, e = C.tid & 31; float lg = 0.f;
#pragma unroll
          for (int w = 0; w < 8; ++w) lg += PART[(w * 16 + row) * 32 + e];
          const float sc = 1.0f / (1.0f + expf(-lg)); SC[row * 32 + e] = sc; SC[512 + row * 32 + e] = sc + a.in[I_RTB][e]; }
        __syncthreads();
        if (C.tid < 16) { const int row = C.tid, t = 16 * tl + row; const LAS float* bi = SC + 512 + row * 32; const LAS float* sc = SC + row * 32;
            int bg = 0; float bgs = -1e30f;
            for (int g = 0; g < 4; ++g) { float m1 = -1e30f, m2 = -1e30f;
                for (int j = 0; j < 8; ++j) { const float x = bi[8 * g + j]; if (x > m1) { m2 = m1; m1 = x; } else if (x > m2) m2 = x; }
                const float gs = m1 + m2; if (gs > bgs) { bgs = gs; bg = g; } }
            int i1 = 0; float v1 = -1e30f;
            for (int j = 0; j < 8; ++j) { const float x = bi[8 * bg + j]; if (x > v1) { v1 = x; i1 = j; } }
            int i2 = 0; float v2 = -1e30f;
            for (int j = 0; j < 8; ++j) { if (j == i1) continue; const float x = bi[8 * bg + j]; if (x > v2) { v2 = x; i2 = j; } }
            const int e1 = 8 * bg + i1, e2 = 8 * bg + i2; const float w1 = sc[e1], w2 = sc[e2], ws = w1 + w2;
            RE[2 * t] = e1; RE[2 * t + 1] = e2; RWT[2 * t] = w1 / ws; RWT[2 * t + 1] = w2 / ws;
            RI[2 * t] = (int)atomicAdd(cnt + e1, 1u); RI[2 * t + 1] = (int)atomicAdd(cnt + e2, 1u); }
        __syncthreads();
    }
}

__device__ __forceinline__ void ph_scatter(const Args& a, const Ctx& C, int l) {
    LAS int* pst = (LAS int*)(C.lds + EXTRA_OFF);
    unsigned* cnt = (unsigned*)(a.ws + WS_CTL) + CW_CNT + 64 * l;
    if (C.tid < 64) {
        const int c = C.lane < NE ? (int)__hip_atomic_load(cnt + C.lane, __ATOMIC_RELAXED, __HIP_MEMORY_SCOPE_AGENT) : 0;
        const int pad = ((c + 255) >> 8) << 8; int inc = pad;
#pragma unroll
        for (int o = 1; o < 32; o <<= 1) { const int t = __shfl_up(inc, o); if (C.lane >= o) inc += t; }
        const int st = inc - pad;
        if (C.lane < NE) { pst[C.lane] = st; pst[64 + C.lane] = c; if (C.lane == NE - 1) pst[NE] = inc; }
        if (C.bx == 0 && C.lane < NE) { int* tile = (int*)(a.ws + WS_TILE);
            for (int i = 0; i < (pad >> 8); ++i) tile[(st >> 8) + i] = C.lane;
            if (C.lane == NE - 1) tile[192] = inc >> 8; }
    }
    __syncthreads();
    int* ROWTOK = (int*)(a.ws + WS_XB);
    const int* RE = (const int*)(a.ws + WS_RE); const int* RI = (const int*)(a.ws + WS_RI); int* DEST = (int*)(a.ws + WS_DEST);
    for (int sl = C.bx * NTHR + C.tid; sl < 2 * T; sl += C.G * NTHR) {
        const int e = RE[sl], idx = RI[sl]; const int dest = pst[e] + idx;
        ROWTOK[dest] = sl >> 1; DEST[sl] = dest;
    }
    for (int idx = C.bx * NTHR + C.tid; idx < NE * 256; idx += C.G * NTHR) {
        const int e = idx >> 8, r = idx & 255, c = pst[64 + e], npad = pst[e + 1] - pst[e] - c;
        if (r < npad) ROWTOK[pst[e] + c + r] = 0;
    }
    __syncthreads();
}

__device__ __forceinline__ void ph_combine(const Args& a, const Ctx& C, int l) {
    const bf16* X = (const bf16*)(a.ws + WS_X); bf16* XN = (bf16*)(a.ws + WS_XN); const bf16* YB = (const bf16*)(a.ws + WS_YB);
    const int* DEST = (const int*)(a.ws + WS_DEST); const float* RWT = (const float*)(a.ws + WS_RWT);
    const float* modf = (const float*)(a.ws + WS_MOD);
    for (int r = C.gw; r < T; r += C.NGW) {
        const int wh = r < TC ? 1 : 0; const float* gt = modf + (size_t)(l * 2 + wh) * 12288 + 5 * D;
        const int d0 = DEST[2 * r], d1 = DEST[2 * r + 1]; const float w0 = RWT[2 * r], w1 = RWT[2 * r + 1];
        const bf16* xr = X + (size_t)r * D; bf16* xo = XN + (size_t)r * D; const bf16* y0 = YB + (size_t)d0 * D; const bf16* y1 = YB + (size_t)d1 * D;
        f32x4 v[8]; float ss = 0.f;
#pragma unroll
        for (int j = 0; j < 8; ++j) { const int k = 4 * C.lane + 256 * j;
            const v2u xw = *(const v2u*)(xr + k); const f32x4 x = {bf_lo(xw.x), bf_hi(xw.x), bf_lo(xw.y), bf_hi(xw.y)}, g = *(const f32x4*)(gt + k); const v2u p0 = *(const v2u*)(y0 + k), p1 = *(const v2u*)(y1 + k);
            f32x4 f; f.x = w0 * bf_lo(p0.x) + w1 * bf_lo(p1.x); f.y = w0 * bf_hi(p0.x) + w1 * bf_hi(p1.x); f.z = w0 * bf_lo(p0.y) + w1 * bf_lo(p1.y); f.w = w0 * bf_hi(p0.y) + w1 * bf_hi(p1.y);
            v[j] = x + g * f; ss += v[j].x * v[j].x + v[j].y * v[j].y + v[j].z * v[j].z + v[j].w * v[j].w; }
        if (l == NL - 1) {
            if (r >= TC) { const float rstd = rsqrtf(wave_sum(ss) * (1.0f / D) + 1e-6f); float* orow = a.out + (size_t)(r - TC) * D;
#pragma unroll
                for (int j = 0; j < 8; ++j) { const int k = 4 * C.lane + 256 * j; const f32x4 g = *(const f32x4*)(a.in[I_FG] + k); *(f32x4*)(orow + k) = v[j] * rstd * g; } }
        } else {
            const float rstd = rsqrtf(wave_sum(ss) * (1.0f / D) + 1e-6f);
            const float* mdn = modf + (size_t)((l + 1) * 2 + wh) * 12288; bf16* H = (bf16*)(a.ws + WS_H);
#pragma unroll
            for (int j = 0; j < 8; ++j) { const int k = 4 * C.lane + 256 * j;
                *(v2u*)(xo + k) = (v2u){pk2(v[j].x, v[j].y), pk2(v[j].z, v[j].w)};
                const f32x4 g = *(const f32x4*)(a.in[I_N1G] + (l + 1) * D + k), sc = *(const f32x4*)(mdn + D + k), sh = *(const f32x4*)(mdn + k);
                const f32x4 h = v[j] * rstd * (g * (1.0f + sc)) + sh;
                *(v2u*)(H + (size_t)r * D + k) = (v2u){pk2(h.x, h.y), pk2(h.z, h.w)}; }
        }
    }
}

__device__ __forceinline__ Ctx fresh_ctx(const Ctx& C0) {
    Ctx C = C0; int t = C0.tid; asm volatile("" : "+v"(t)); C.tid = t; C.lane = t & 63; C.wave = __builtin_amdgcn_readfirstlane(t >> 6); C.gw = C.bx * NWAVES + C.wave; return C; }
__device__ __forceinline__ int opaque_two() { int n = 2; asm volatile("" : "+s"(n)); return n; }
constexpr int PH_PER_LAYER = 14, N_PHASES = 1 + NL * PH_PER_LAYER;
#ifndef PH_MASK
#define PH_MASK 0xffffffffu
#endif
#define PHM(j) (((PH_MASK) >> (j)) & 1u)
#ifndef GEMM_SP2
#define GEMM_SP2 true
#endif
#ifndef REP_PHASE
#define REP_PHASE (-1)
#endif
#define REPLOOP(j, l) _Pragma("nounroll") for (int rep_ = 0, nrep_ = ((REP_PHASE) == (j) && (l) == 0) ? opaque_two() : 1; rep_ < nrep_; ++rep_)
#define IN(k) (lo <= (k) && (k) < hi)
#define SEAM(k) do { if (IN(k) && IN((k) + 1)) xcd_barrier(bar); } while (0)


template <int l> __device__ __forceinline__ void layer_body(const Args& args, const Ctx& C, const XcdBarrier& bar, const int lo, const int hi, const bool multi) {
    unsigned char* ws = args.ws;
        const int pb = 1 + l * PH_PER_LAYER;
        if (l == 0) {
            if (PHM(0) && IN(pb + 0)) REPLOOP(0, l) ph_norm1(args, fresh_ctx(C), l);
            SEAM(pb + 0);
        }
        if (PHM(1) && IN(pb + 1)) {
            pg8::Gemm g{(const bf16*)(ws + WS_H), (const bf16*)(ws + WS_WIN) + (size_t)l * PW * D, T, PW, D};
            pg8::StaticOrder S; S.init(T, PW, C.G, C.bx);
            pg8::EpiStoreBf16 E{(bf16*)(ws + WS_P), PW, 0x7fffffff};
            pg8::gemm_phase<pg8::EpiStoreBf16, pg8::StaticOrder, true, GEMM_SP2>(C.lds, g, S, E);
        }
        SEAM(pb + 1);
        if (PHM(2) && IN(pb + 2)) REPLOOP(2, l) ph_prep(args, fresh_ctx(C), l);
        SEAM(pb + 2);
        if (PHM(3) && IN(pb + 3)) {
            pg8::Gemm g{(const bf16*)(ws + WS_LA), (const bf16*)(ws + WS_LB) + (size_t)l * LNN * LK, T, LNN, LK};
            pg8::StaticOrder S; S.init(T, LNN, C.G, C.bx);
            pg8::EpiStoreBf16 E{(bf16*)(ws + WS_LORA), LNN, 0x7fffffff};
            pg8::gemm_phase<pg8::EpiStoreBf16, pg8::StaticOrder, true, GEMM_SP2>(C.lds, g, S, E);
        }
        SEAM(pb + 3);
        if (PHM(4) && IN(pb + 4)) { REPLOOP(4, l) ph_rwkv_prep<7>(args, fresh_ctx(C), l); if ((REP_PHASE) >= 420 && (REP_PHASE) < 428 && l == 0) ph_rwkv_prep<((REP_PHASE) >= 420 && (REP_PHASE) < 428) ? (REP_PHASE) - 420 : 0>(args, fresh_ctx(C), l); REPLOOP(41, l) ph_ret_prefix(args, fresh_ctx(C), l); }
        SEAM(pb + 4);
        if (PHM(6) && IN(pb + 6)) {
            const int nsq = C.G >= 128 ? 128 : 0;
            if (nsq == 0) { for (int b = C.bx; b < 128; b += C.G) { if (C.wave == 0) ph_rwkv_seq(args, fresh_ctx(C), b >> 2, b & 3); else if (C.wave == 2) ph_rwkv_seq_y(args, fresh_ctx(C), b >> 2, b & 3);
                    __syncthreads(); if (C.tid == 0) { volatile LAS int* w = (volatile LAS int*)(C.lds + MISC_OFF + 64); w[0] = 0; w[1] = 0; w[2] = 0; } __syncthreads(); } ph_ret_out(args, fresh_ctx(C), l, C.bx, C.G); ph_convert_moe(args, fresh_ctx(C), l, C.gw, C.NGW, (LAS float*)(C.lds + 79872 + (C.wave & 7) * 8704)); }
            else if (C.bx < nsq && C.wave == 0) { const int xi = C.bx >> 3;
                ph_rwkv_seq(args, fresh_ctx(C), (C.bx & 7) * 4 + (xi >> 2), xi & 3); }
            else if (C.bx < nsq && C.wave == 1) { const int xi = C.bx >> 3; ph_rwkv_pref(args, fresh_ctx(C), (C.bx & 7) * 4 + (xi >> 2), xi & 3); }
            else if (C.bx < nsq && C.wave == 2) { const int xi = C.bx >> 3; ph_rwkv_seq_y(args, fresh_ctx(C), (C.bx & 7) * 4 + (xi >> 2), xi & 3); }
            else if (C.bx >= nsq) { const int wid = (C.bx - nsq) * 8 + C.wave; const int nwk = (C.G - nsq) * 8;     REPLOOP(62, l) ph_ret_out(args, fresh_ctx(C), l, C.bx - nsq, C.G - nsq);
                   REPLOOP(63, l) ph_convert_moe(args, fresh_ctx(C), l, wid, nwk, (LAS float*)(C.lds + 79872 + (C.wave & 7) * 8704)); }
        }
        SEAM(pb + 6);
        if (IN(pb + 6) && C.tid == 0) { volatile LAS int* w = (volatile LAS int*)(C.lds + MISC_OFF + 64); w[0] = 0; w[1] = 0; w[2] = 0; }
        if (PHM(7) && IN(pb + 7)) REPLOOP(7, l) ph_rwkv_out(args, fresh_ctx(C), l);
        SEAM(pb + 7);
        if (PHM(8) && IN(pb + 8)) REPLOOP(8, l) {
            constexpr int roff = (l == NL - 1) ? TC : 0;
            pg8::Gemm g{(const bf16*)(ws + WS_YALL) + (size_t)roff * D, (const bf16*)(ws + WS_WOUT) + (size_t)l * D * D, T - roff, D, D};
            pg8::StaticOrder S; S.init(T - roff, D, C.G, C.bx);
            const float* modf = (const float*)(ws + WS_MOD);
            bf16* X = (bf16*)(ws + WS_X); const bf16* XNp = (const bf16*)(ws + WS_XN);
            if constexpr (l == 0) { pg8::EpiResid<false> E{args.in[I_CTX], args.in[I_X], modf + (size_t)(l * 2 + 1) * 12288 + 2 * D, modf + (size_t)(l * 2 + 0) * 12288 + 2 * D, X, D, roff / 256};
                pg8::gemm_phase<pg8::EpiResid<false>, pg8::StaticOrder, true, GEMM_SP2>(C.lds, g, S, E); }
            else { pg8::EpiResid<true> E{XNp, XNp + (size_t)TC * D, modf + (size_t)(l * 2 + 1) * 12288 + 2 * D, modf + (size_t)(l * 2 + 0) * 12288 + 2 * D, X, D, roff / 256};
                pg8::gemm_phase<pg8::EpiResid<true>, pg8::StaticOrder, true, GEMM_SP2>(C.lds, g, S, E); }
        }
        SEAM(pb + 8);
        if (PHM(9) && IN(pb + 9)) REPLOOP(9, l) ph_norm2_route(args, fresh_ctx(C), l, l + 2 * rep_);
        SEAM(pb + 9);
        if (PHM(10) && IN(pb + 10)) REPLOOP(10, l) ph_scatter(args, fresh_ctx(C), l);
        SEAM(pb + 10);
        if (PHM(11) && IN(pb + 11)) REPLOOP(11, l) {
            const int* tile = (const int*)(ws + WS_TILE);
            pg8::Gemm g{(const bf16*)(ws + WS_H), (const bf16*)(ws + WS_W1) + (size_t)l * NE * 2048 * 2048, MPAD, NE * 2048, D};
            pg8::MoeGatherOrder S{tile[192] * 8, C.G, C.bx, tile, (const int*)(ws + WS_XB)};
            pg8::EpiSwiGLU E{(bf16*)(ws + WS_ACT), 1024};
            pg8::gemm_phase<pg8::EpiSwiGLU, pg8::MoeGatherOrder, true, GEMM_SP2, true>(C.lds, g, S, E);
        }
        SEAM(pb + 11);
        if (PHM(12) && IN(pb + 12)) REPLOOP(12, l) {
            const int* tile = (const int*)(ws + WS_TILE);
            pg8::Gemm g{(const bf16*)(ws + WS_ACT), (const bf16*)(ws + WS_W2) + (size_t)l * NE * 2048 * 1024, MPAD, NE * 2048, 1024};
            pg8::MoeOrder S{tile[192] * 8, C.G, C.bx, tile};
            pg8::EpiStoreBf16 E{(bf16*)(ws + WS_YB), D, 7};
            pg8::gemm_phase<pg8::EpiStoreBf16, pg8::MoeOrder, true, GEMM_SP2>(C.lds, g, S, E);
        }
        SEAM(pb + 12);
        if (PHM(13) && IN(pb + 13)) REPLOOP(13, l) ph_combine(args, fresh_ctx(C), l);
        SEAM(pb + 13);
        if ((REP_PHASE) == 77 && l == 0 && multi) { _Pragma("nounroll") for (int i_ = 0, n_ = 5 * opaque_two(); i_ < n_; ++i_) xcd_barrier(bar); }
    }
__global__ void __launch_bounds__(NTHR, 2) fwd_kernel(Args args) {
    extern __shared__ __attribute__((aligned(16))) unsigned char lds_raw[];
    Ctx C; C.lds = (LAS unsigned char*)lds_raw;
    C.tid = threadIdx.x; C.lane = C.tid & 63; C.wave = __builtin_amdgcn_readfirstlane(C.tid >> 6);
    C.G = gridDim.x; C.bx = blockIdx.x; C.gw = C.bx * NWAVES + C.wave; C.NGW = C.G * NWAVES;
    volatile LAS unsigned* MISC = (volatile LAS unsigned*)(C.lds + MISC_OFF);
    if (C.tid < 64) MISC[C.tid] = 0u;
    __syncthreads();
    unsigned char* ws = args.ws;
    XcdBarrier bar; bar.bar = (unsigned*)(ws + WS_CTL) + CW_BAR; bar.x = 0; bar.st = nullptr;
    const bool multi = (args.ph_hi - args.ph_lo) > 1;
    if (multi) bar = xcd_barrier_post((unsigned*)(ws + WS_CTL) + CW_BAR, MISC + 8);
    const int lo = args.ph_lo, hi = args.ph_hi;
    if (PHM(15) && IN(0)) { REPLOOP(15, 0) ph_prologue(args, fresh_ctx(C)); }
    SEAM(0);
    layer_body<0>(args, C, bar, lo, hi, multi);
    layer_body<1>(args, C, bar, lo, hi, multi);
#undef IN
#undef SEAM
}

extern "C" void kernel_launch(void* const* d_in, const int* in_sizes, int n_in, void* d_out, int out_size, void* d_ws, size_t ws_size, hipStream_t stream) {
    static int grid = 0;
    if (grid == 0) {
        if (n_in != 28 || out_size != TL * D || ws_size < WS_END) { fprintf(stderr, "kernel_launch: unexpected shapes (n_in %d out %d ws %zu need %zu)\n", n_in, out_size, ws_size, (size_t)WS_END); grid = -1; return; }
        int dev = 0, cus = 0, per_cu = 0;
        if (hipGetDevice(&dev) != hipSuccess || hipDeviceGetAttribute(&cus, hipDeviceAttributeMultiprocessorCount, dev) != hipSuccess) { grid = -1; return; }
        if (hipFuncSetAttribute((const void*)fwd_kernel, hipFuncAttributeMaxDynamicSharedMemorySize, LDS_BYTES) != hipSuccess) { fprintf(stderr, "kernel_launch: hipFuncSetAttribute failed\n"); grid = -1; return; }
        if (hipOccupancyMaxActiveBlocksPerMultiprocessor(&per_cu, (const void*)fwd_kernel, NTHR, LDS_BYTES) != hipSuccess || per_cu < 1) { fprintf(stderr, "kernel_launch: occupancy query says %d\n", per_cu); }
        (void)hipGetLastError();
        grid = cus;
    }
    if (grid < 0) return;
    if (hipMemsetAsync((char*)d_ws + WS_CTL, 0, CTL_BYTES, stream) != hipSuccess) return;
    Args a{};
    for (int i = 0; i < 28; ++i) a.in[i] = (const float*)d_in[i];
    a.out = (float*)d_out; a.ws = (unsigned char*)d_ws;
#if MK_N_LAUNCHES == 1
    a.ph_lo = 0; a.ph_hi = N_PHASES;
    hipLaunchKernelGGL(fwd_kernel, dim3(grid), dim3(NTHR), LDS_BYTES, stream, a);
#else
    for (int p = 0; p < N_PHASES; ++p) { a.ph_lo = p; a.ph_hi = p + 1; hipLaunchKernelGGL(fwd_kernel, dim3(grid), dim3(NTHR), LDS_BYTES, stream, a); }
#endif
}
```

```cpp
#include <hip/hip_runtime.h>
#include <cstdio>
#include <cstdint>
namespace pg8 {
#define PG8_LAS __attribute__((address_space(3)))
typedef unsigned short bf16_t;
typedef short bf16x8 __attribute__((ext_vector_type(8)));
typedef float f32x4 __attribute__((ext_vector_type(4)));
typedef unsigned u32x4 __attribute__((ext_vector_type(4)));
constexpr int BM = 256, BK = 64, HALF = 128, HTB = HALF * BK * 2  , STAGE_BYTES = 8 * HTB, NXCD = 8, WGM = 8;

__host__ __device__ __forceinline__ int lds_byte(int r, int c) { const int st = (r >> 4) * 2 + (c >> 5), rr = r & 15, cc = c & 31, ob = rr * 64 + cc * 2; return st * 1024 + (ob ^ (((ob >> 9) & 1) << 5)); }
__host__ __device__ __forceinline__ void stage_rc(int b, int& R, int& C) { const int st = b / 1024, sb = b % 1024, swz = sb ^ (((sb >> 9) & 1) << 5); R = (st >> 1) * 16 + swz / 64; C = (st & 1) * 32 + (swz % 64) / 2; }
__host__ __device__ __forceinline__ int perm32(int rho) { const int n = rho >> 4, i = rho & 15; return 8 * (i >> 2) + 4 * n + (i & 3); }

struct Unit { int pm, pn; };
struct Gemm { const bf16_t* A; const bf16_t* Bt; int M, N, K; };

struct StaticOrder {
    int nM, nN, nwg, G, c;
    __host__ __device__ void init(int M, int N, int G_, int c_) { nM = M / BM; nN = N / BM; nwg = nM * nN; G = G_; c = c_; }
    __host__ __device__ bool next(int i, Unit& u) const {
        const long L = (long)i * G + c; if (L >= nwg) return false;
        int wgid = (int)L; { const int q = nwg / NXCD, r = nwg % NXCD, xcd = wgid % NXCD, off = wgid / NXCD; wgid = (xcd < r ? xcd * (q + 1) : r * (q + 1) + (xcd - r) * q) + off; }
        const int nig = WGM * nN, gid = wgid / nig, fm = gid * WGM, gsz = (nM - fm) < WGM ? (nM - fm) : WGM;
        u.pm = fm + ((wgid % nig) % gsz); u.pn = (wgid % nig) / gsz; return true;
    }
    __device__ __forceinline__ void a_ready(const Unit&) const {}
    __device__ __forceinline__ void done(const Unit&) const {}
};

typedef float f32x2c __attribute__((ext_vector_type(2))); typedef __bf16 bf16x2c __attribute__((ext_vector_type(2)));
__device__ __forceinline__ unsigned cvt_pk_bf16(float lo, float hi) { const f32x2c v = {lo, hi}; return __builtin_bit_cast(unsigned, __builtin_convertvector(v, bf16x2c)); }
typedef float f32x2 __attribute__((ext_vector_type(2)));


struct EpiStoreBf16 {
    static constexpr bool PERM = true, AFTER_DRAIN = false;
    bf16_t* O; int ldc; int pn_mask;
    __device__ __forceinline__ void operator()(const f32x4 (&acc)[2][2][4][2], const Unit& u, int wr, int wc, int fr, int fq) const {
        const int row0 = u.pm * BM + wr * 64 + fr; const int col0 = (u.pn & pn_mask) * BM + wc * 32 + 8 * fq;
#pragma unroll
        for (int ai = 0; ai < 2; ++ai)
#pragma unroll
            for (int m = 0; m < 4; ++m) { bf16_t* rowp = O + (size_t)(row0 + ai * HALF + m * 16) * ldc + col0;
#pragma unroll
                for (int bj = 0; bj < 2; ++bj) { const f32x4 v0 = acc[ai][bj][m][0], v1 = acc[ai][bj][m][1];
                    u32x4 w; w.x = cvt_pk_bf16(v0[0], v0[1]); w.y = cvt_pk_bf16(v0[2], v0[3]); w.z = cvt_pk_bf16(v1[0], v1[1]); w.w = cvt_pk_bf16(v1[2], v1[3]);
                    *(u32x4*)(rowp + bj * HALF) = w; } }
    }
};
struct EpiSwiGLU {
    static constexpr bool PERM = true, AFTER_DRAIN = false;
    bf16_t* O; int ldc;
    __device__ __forceinline__ void operator()(const f32x4 (&acc)[2][2][4][2], const Unit& u, int wr, int wc, int fr, int fq) const {
        const int row0 = u.pm * BM + wr * 64 + fr; const int col0 = (u.pn & 7) * HALF + wc * 32 + 8 * fq;
#pragma unroll
        for (int ai = 0; ai < 2; ++ai)
#pragma unroll
            for (int m = 0; m < 4; ++m) { bf16_t* rowp = O + (size_t)(row0 + ai * HALF + m * 16) * ldc + col0;
                float r[8];
#pragma unroll
                for (int n = 0; n < 2; ++n)
#pragma unroll
                    for (int j = 0; j < 4; ++j) { const float g = acc[ai][0][m][n][j], up = acc[ai][1][m][n][j]; r[n * 4 + j] = g * up / (1.0f + __expf(-g)); }
                u32x4 w; w.x = cvt_pk_bf16(r[0], r[1]); w.y = cvt_pk_bf16(r[2], r[3]); w.z = cvt_pk_bf16(r[4], r[5]); w.w = cvt_pk_bf16(r[6], r[7]);
                *(u32x4*)rowp = w; }
    }
};
template <bool BASE_BF16> struct EpiResid {
    static constexpr bool PERM = false, AFTER_DRAIN = false;
    const void* base_c; const void* base_x; const float* gate_c; const float* gate_x; bf16_t* X; int ldc; int pm_off;
    __device__ __forceinline__ void operator()(const f32x4 (&acc)[2][2][4][2], const Unit& u, int wr, int wc, int fr, int fq) const {
        const int pmr = u.pm + pm_off; const int row0 = pmr * BM + wr * 64 + fr, col0 = u.pn * BM + wc * 32 + 4 * fq;
        const bool isc = (pmr == 0);
        const float* gate = isc ? gate_c : gate_x;
        const size_t boff = isc ? 0 : (size_t)BM * ldc;
        const void* base = isc ? base_c : base_x;
        f32x4 gv[2][2];
#pragma unroll
        for (int bj = 0; bj < 2; ++bj)
#pragma unroll
            for (int n = 0; n < 2; ++n) gv[bj][n] = *(const f32x4*)(gate + col0 + bj * HALF + n * 16);
#pragma unroll
        for (int ai = 0; ai < 2; ++ai)
#pragma unroll
            for (int m = 0; m < 4; ++m) { const size_t off = (size_t)(row0 + ai * HALF + m * 16) * ldc + col0;
#pragma unroll
                for (int bj = 0; bj < 2; ++bj)
#pragma unroll
                    for (int n = 0; n < 2; ++n) { f32x4 bs;
                        if (BASE_BF16) { const unsigned long long w = *(const unsigned long long*)((const bf16_t*)base + (off - boff) + bj * HALF + n * 16); const unsigned lo = (unsigned)w, hi = (unsigned)(w >> 32);
                            bs = (f32x4){__uint_as_float(lo << 16), __uint_as_float(lo & 0xffff0000u), __uint_as_float(hi << 16), __uint_as_float(hi & 0xffff0000u)}; }
                        else bs = *(const f32x4*)((const float*)base + (off - boff) + bj * HALF + n * 16);
                        const f32x4 o = bs + gv[bj][n] * acc[ai][bj][m][n];
                        *(unsigned long long*)(X + off + bj * HALF + n * 16) = (unsigned long long)cvt_pk_bf16(o[0], o[1]) | ((unsigned long long)cvt_pk_bf16(o[2], o[3]) << 32); } }
    }
};
struct MoeGatherOrder {
    int n8, G, c; const PG8_LAS int* tb; const int* slot; int slot_ld;
    __device__ __forceinline__ bool next(int i, Unit& u) const {
        const long L = (long)i * G + c; if (L >= n8) return false;
        u.pm = (int)(L >> 3); u.pn = tb[128 + u.pm] * 8 + (int)(L & 7); return true;
    }
    __device__ __forceinline__ int arow(const Unit& u, int r) const { const int e = tb[128 + u.pm]; const int i = u.pm * BM + r - tb[e]; return i < tb[64 + e] ? slot[(size_t)e * slot_ld + i] : 0; }
    __device__ __forceinline__ void a_ready(const Unit&) const {}
    __device__ __forceinline__ void done(const Unit&) const {}
};
struct MoeOrder {
    int n8, G, c; const PG8_LAS int* tb;
    __device__ __forceinline__ bool next(int i, Unit& u) const {
        const long L = (long)i * G + c; if (L >= n8) return false;
        u.pm = (int)(L >> 3); u.pn = tb[128 + u.pm] * 8 + (int)(L & 7); return true;
    }
    __device__ __forceinline__ void a_ready(const Unit&) const {}
    __device__ __forceinline__ void done(const Unit&) const {}
};
template <class Epi, class Sched, bool ALIGN_EPI = false, bool SP2 = false, bool GATHER = false>
__device__ __forceinline__ void gemm_phase(PG8_LAS unsigned char* lds, const Gemm g, const Sched& S, const Epi& E) {
    int tid_ = threadIdx.x; asm volatile("" : "+v"(tid_));
    const int tid = tid_, wid = __builtin_amdgcn_readfirstlane(tid >> 6), lane = tid & 63, wr = wid >> 2, wc = wid & 3, fr = lane & 15, fq = lane >> 4;
    const int K = g.K, nt = K / BK;
    unsigned voffA[2], voffB[2]; int gR[2]; unsigned gC[2];
    unsigned gcu[2][2], gnx[2][2];
#pragma unroll
    for (int i = 0; i < 2; ++i) { int R, C; stage_rc(tid * 16 + i * 8192, R, C); const int Rb = Epi::PERM ? ((R & ~31) + perm32(R & 31)) : R;
        voffA[i] = (unsigned)(R * K + C) * 2u; voffB[i] = (unsigned)(Rb * K + C) * 2u; gR[i] = R; gC[i] = (unsigned)C * 2u; }
    const size_t kstep = (size_t)(BK * 2);
    const size_t hstep = (size_t)HALF * K * 2;
    const size_t tstep = 2 * hstep;
    const unsigned ldsw = (unsigned)wid * 1024u;
    const int aoff = lds_byte(wr * 64 + fr, fq * 8), boff = lds_byte(wc * 32 + fr, fq * 8);
#define PG8_SA(b, h) (((b) * 2 + (h)) * HTB)
#define PG8_SB(b, h) ((4 + (b) * 2 + (h)) * HTB)
#define PG8_STAGE(bufoff, gbase, voff) do { _Pragma("unroll") for (int _i = 0; _i < 2; ++_i) \
        __builtin_amdgcn_global_load_lds((const unsigned*)((const char*)(gbase) + (voff)[_i]), (PG8_LAS unsigned*)(lds + (bufoff) + ldsw + _i * 8192), 16, 0, 0); } while (0)
#define PG8_LDA(dst, b, h) do { _Pragma("unroll") for (int m = 0; m < 4; ++m) _Pragma("unroll") for (int k = 0; k < 2; ++k) dst[m][k] = *(const PG8_LAS bf16x8*)(lds + PG8_SA(b, h) + aoff + m * 2048 + k * 1024); } while (0)
#define PG8_LDB(dst, b, h) do { _Pragma("unroll") for (int n = 0; n < 2; ++n) _Pragma("unroll") for (int k = 0; k < 2; ++k) dst[n][k] = *(const PG8_LAS bf16x8*)(lds + PG8_SB(b, h) + boff + n * 2048 + k * 1024); } while (0)
#define PG8_MMA(ai, bj, At, Bt) do { __builtin_amdgcn_s_setprio(1); _Pragma("unroll") for (int m = 0; m < 4; ++m) _Pragma("unroll") for (int n = 0; n < 2; ++n) _Pragma("unroll") for (int k = 0; k < 2; ++k) \
        acc[ai][bj][m][n] = __builtin_amdgcn_mfma_f32_16x16x32_bf16(Bt[n][k], At[m][k], acc[ai][bj][m][n], 0, 0, 0); __builtin_amdgcn_s_setprio(0); } while (0)
#define PG8_WAIT_V(n) asm volatile("s_waitcnt vmcnt(" #n ")" ::: "memory")
#define PG8_WAIT_L(n) asm volatile("s_waitcnt lgkmcnt(" #n ")" ::: "memory")
#define PG8_BAR __builtin_amdgcn_s_barrier()
#define PG8_SCHED __builtin_amdgcn_sched_barrier(0)
    Unit cur, nxt; int ui = 0;
    if (!S.next(0, cur)) return;
    f32x4 acc[2][2][4][2];
#pragma unroll
    for (int a = 0; a < 2; ++a)
#pragma unroll
        for (int b = 0; b < 2; ++b)
#pragma unroll
            for (int m = 0; m < 4; ++m)
#pragma unroll
                for (int n = 0; n < 2; ++n) acc[a][b][m][n] = (f32x4){0.f, 0.f, 0.f, 0.f};
    bf16x8 At[4][2], B0[2][2], B1[2][2];
    const char* cA = GATHER ? (const char*)g.A : (const char*)g.A + (size_t)cur.pm * tstep; const char* cB = (const char*)g.Bt + (size_t)cur.pn * tstep;
    S.a_ready(cur);
    if constexpr (GATHER) {
#pragma unroll
        for (int h = 0; h < 2; ++h)
#pragma unroll
            for (int i = 0; i < 2; ++i) { gcu[h][i] = (unsigned)S.arow(cur, h * HALF + gR[i]) * (unsigned)(K * 2) + gC[i]; gnx[h][i] = gcu[h][i]; } }
#define PG8_STAGE_A(bufoff, p, half, nxtsel) do { if constexpr (GATHER) { unsigned vo_[2] = {(nxtsel) ? gnx[half][0] : gcu[half][0], (nxtsel) ? gnx[half][1] : gcu[half][1]}; PG8_STAGE(bufoff, p, vo_); } \
        else { PG8_STAGE(bufoff, (p) + ((half) ? hstep : 0), voffA); } } while (0)
    if constexpr (SP2) {
        PG8_STAGE(PG8_SB(0, 0), cB, voffB); PG8_STAGE(PG8_SB(0, 1), cB + hstep, voffB); PG8_STAGE_A(PG8_SA(0, 0), cA, 0, false); PG8_STAGE_A(PG8_SA(0, 1), cA, 1, false);
        if (wr == 1) PG8_BAR;
        PG8_WAIT_V(2); PG8_BAR;
        PG8_STAGE(PG8_SB(1, 0), cB + kstep, voffB); PG8_STAGE_A(PG8_SA(1, 0), cA + kstep, 0, false); PG8_STAGE(PG8_SB(1, 1), cB + hstep + kstep, voffB);
        PG8_WAIT_V(6); PG8_BAR;
    } else {
        PG8_STAGE(PG8_SB(0, 0), cB, voffB); PG8_STAGE_A(PG8_SA(0, 0), cA, 0, false); PG8_STAGE(PG8_SB(0, 1), cB + hstep, voffB); PG8_STAGE_A(PG8_SA(0, 1), cA, 1, false);
        if (wr == 1) PG8_BAR;
        PG8_WAIT_V(4); PG8_BAR;
        PG8_STAGE(PG8_SB(1, 0), cB + kstep, voffB); PG8_STAGE_A(PG8_SA(1, 0), cA + kstep, 0, false); PG8_STAGE(PG8_SB(1, 1), cB + hstep + kstep, voffB);
        PG8_WAIT_V(6); PG8_BAR;
    }
    for (;;) {
        const bool has_next = S.next(ui + 1, nxt);
        const char* nA = GATHER ? (const char*)g.A : (has_next ? (const char*)g.A + (size_t)nxt.pm * tstep : cA); const char* nB = has_next ? (const char*)g.Bt + (size_t)nxt.pn * tstep : cB;
        if constexpr (GATHER) { if (has_next) {
#pragma unroll
            for (int h = 0; h < 2; ++h)
#pragma unroll
                for (int i = 0; i < 2; ++i) gnx[h][i] = (unsigned)S.arow(nxt, h * HALF + gR[i]) * (unsigned)(K * 2) + gC[i]; } }
        for (int t = 0; t < nt; t += 2) {
            const bool last = (t == nt - 2);
            const char* a1 = cA + (size_t)(t + 1) * kstep;
            const char* a2 = last ? nA : cA + (size_t)(t + 2) * kstep; const char* b2 = last ? nB : cB + (size_t)(t + 2) * kstep;
            const char* a3 = a2 + kstep; const char* b3 = b2 + kstep;
            if (last && has_next) S.a_ready(nxt);
            if constexpr (SP2) {
            PG8_LDB(B0, 0, 0); PG8_LDB(B1, 0, 1); PG8_SCHED; PG8_LDA(At, 0, 0); PG8_STAGE_A(PG8_SA(1, 1), a1, 1, false);
            PG8_WAIT_V(8); PG8_WAIT_L(0); PG8_BAR; PG8_MMA(0, 0, At, B0); PG8_MMA(0, 1, At, B1); PG8_BAR; PG8_SCHED;
            PG8_LDA(At, 0, 1); PG8_STAGE(PG8_SB(0, 0), b2, voffB); PG8_STAGE(PG8_SB(0, 1), b2 + hstep, voffB); PG8_STAGE_A(PG8_SA(0, 0), a2, 0, last);
            PG8_WAIT_V(8); PG8_WAIT_L(0); PG8_BAR; PG8_MMA(1, 0, At, B0); PG8_MMA(1, 1, At, B1); PG8_BAR; PG8_SCHED;
            PG8_LDB(B0, 1, 0); PG8_LDB(B1, 1, 1); PG8_SCHED; PG8_LDA(At, 1, 0); PG8_STAGE_A(PG8_SA(0, 1), a2, 1, last);
            PG8_WAIT_V(8); PG8_WAIT_L(0); PG8_BAR; PG8_MMA(0, 0, At, B0); PG8_MMA(0, 1, At, B1); PG8_BAR; PG8_SCHED;
            PG8_LDA(At, 1, 1); PG8_STAGE(PG8_SB(1, 0), b3, voffB); PG8_STAGE(PG8_SB(1, 1), b3 + hstep, voffB); PG8_STAGE_A(PG8_SA(1, 0), a3, 0, last);
            PG8_WAIT_V(8); PG8_WAIT_L(0); PG8_BAR; PG8_MMA(1, 0, At, B0); PG8_MMA(1, 1, At, B1); PG8_BAR; PG8_SCHED;
            } else {
            PG8_LDB(B0, 0, 0); PG8_SCHED; PG8_LDA(At, 0, 0); PG8_STAGE_A(PG8_SA(1, 1), a1, 1, false);
            PG8_WAIT_L(8); PG8_BAR; PG8_WAIT_L(0); PG8_MMA(0, 0, At, B0); PG8_BAR; PG8_SCHED;
            PG8_LDB(B1, 0, 1); PG8_STAGE(PG8_SB(0, 0), b2, voffB);
            PG8_BAR; PG8_WAIT_L(0); PG8_MMA(0, 1, At, B1); PG8_BAR;
            PG8_LDA(At, 0, 1); PG8_STAGE_A(PG8_SA(0, 0), a2, 0, last);
            PG8_BAR; PG8_WAIT_L(0); PG8_MMA(1, 0, At, B0); PG8_BAR; PG8_SCHED;
            PG8_STAGE(PG8_SB(0, 1), b2 + hstep, voffB);
            PG8_WAIT_V(6); PG8_BAR; PG8_MMA(1, 1, At, B1); PG8_BAR;
            PG8_LDB(B0, 1, 0); PG8_SCHED; PG8_LDA(At, 1, 0); PG8_STAGE_A(PG8_SA(0, 1), a2, 1, last);
            PG8_WAIT_L(8); PG8_BAR; PG8_WAIT_L(0); PG8_MMA(0, 0, At, B0); PG8_BAR; PG8_SCHED;
            PG8_LDB(B1, 1, 1); PG8_STAGE(PG8_SB(1, 0), b3, voffB);
            PG8_BAR; PG8_WAIT_L(0); PG8_MMA(0, 1, At, B1); PG8_BAR;
            PG8_LDA(At, 1, 1); PG8_STAGE_A(PG8_SA(1, 0), a3, 0, last);
            PG8_BAR; PG8_WAIT_L(0); PG8_MMA(1, 0, At, B0); PG8_BAR; PG8_SCHED;
            PG8_STAGE(PG8_SB(1, 1), b3 + hstep, voffB);
            PG8_WAIT_V(6); PG8_BAR; PG8_MMA(1, 1, At, B1); PG8_BAR;
            }
        }
        if constexpr (ALIGN_EPI) { if (wr == 0) PG8_BAR; }
        if constexpr (!Epi::AFTER_DRAIN) { E(acc, cur, wr, wc, fr, fq); S.done(cur); }
        if (!has_next) break;
#pragma unroll
        for (int a = 0; a < 2; ++a)
#pragma unroll
            for (int b = 0; b < 2; ++b)
#pragma unroll
                for (int m = 0; m < 4; ++m)
#pragma unroll
                    for (int n = 0; n < 2; ++n) acc[a][b][m][n] = (f32x4){0.f, 0.f, 0.f, 0.f};
        cur = nxt; cA = nA; cB = nB; ++ui;
        if constexpr (GATHER) {
#pragma unroll
            for (int h = 0; h < 2; ++h)
#pragma unroll
                for (int i = 0; i < 2; ++i) gcu[h][i] = gnx[h][i]; }
        if constexpr (ALIGN_EPI) { if (wr == 1) PG8_BAR; }
    }
    PG8_WAIT_V(0);
    if constexpr (!ALIGN_EPI) { if (wr == 0) PG8_BAR; }
    PG8_BAR;
    if constexpr (Epi::AFTER_DRAIN) { E.fused(acc, cur, wr, wc, fr, fq, lds, wid, lane); S.done(cur); }
#undef PG8_SA
#undef PG8_SB
#undef PG8_STAGE
#undef PG8_STAGE_A
#undef PG8_LDA
#undef PG8_LDB
#undef PG8_MMA
#undef PG8_WAIT_V
#undef PG8_WAIT_L
#undef PG8_BAR
#undef PG8_SCHED
}
}


#ifndef MK_N_LAUNCHES
#define MK_N_LAUNCHES 1
#endif

#define GAS __attribute__((address_space(1)))
#define LAS __attribute__((address_space(3)))
#define CAS __attribute__((address_space(4)))
typedef unsigned short bf16;
typedef unsigned v4u __attribute__((ext_vector_type(4)));
typedef unsigned v2u __attribute__((ext_vector_type(2)));
typedef float f32x4 __attribute__((ext_vector_type(4)));
typedef short bf16x8 __attribute__((ext_vector_type(8)));

constexpr int D = 2048, TC = 256, TL = 16384, T = TC + TL;
constexpr int NL = 2;
constexpr int PIN = 7584, PW = 7680, RWIN = 3488, RET_OFF = 3584;
constexpr int LK = 512, LNN = 5120;
constexpr int NCH = 130;
constexpr int NE = 32, MPAD = 41472, MAXTILES = MPAD / 256;
constexpr int NWAVES = 8, NTHR = 512;
constexpr int KP = 16;

constexpr size_t al256(size_t x) { return (x + 255) & ~(size_t)255; }
constexpr size_t WS_CTL = 0, CTL_BYTES = 1u << 20;
constexpr size_t WS_MODP = CTL_BYTES;
constexpr size_t WS_MOD  = WS_MODP + al256((size_t)NL * KP * 2 * 12288 * 4);
constexpr size_t WS_WIN  = WS_MOD + al256((size_t)NL * 2 * 12288 * 4);
constexpr size_t WS_WOUT = WS_WIN + al256((size_t)NL * PW * D * 2);
constexpr size_t WS_LB   = WS_WOUT + al256((size_t)NL * D * D * 2);
constexpr size_t WS_W1   = WS_LB + al256((size_t)NL * LNN * LK * 2);
constexpr size_t WS_W2   = WS_W1 + al256((size_t)NL * NE * 2048 * 2048 * 2);
constexpr size_t WS_X    = WS_W2 + al256((size_t)NL * NE * 2048 * 1024 * 2);
constexpr size_t WS_XN   = WS_X + al256((size_t)T * D * 4);
constexpr size_t WS_H    = WS_XN + al256((size_t)T * D * 4);
constexpr size_t WS_P    = WS_H + al256((size_t)T * D * 2);
constexpr size_t WS_LA   = WS_P + al256((size_t)T * PW * 2);
constexpr size_t WS_LORA = WS_LA + al256((size_t)T * LK * 2);
constexpr size_t SZ_S    = al256((size_t)T * 1024 * 4);
constexpr size_t SZ_CK   = al256((size_t)32 * 520 * 2048 * 2);
constexpr size_t SZ_CM   = al256((size_t)32 * 520 * 1024 * 2);
constexpr size_t WS_AGP  = WS_LORA + al256((size_t)T * LNN * 2);
constexpr size_t WS_RGP  = WS_AGP + SZ_CK, WS_BGI = WS_RGP + SZ_CK, WS_KGI = WS_BGI + SZ_CK, WS_KGT = WS_KGI + SZ_CK, WS_BGT = WS_KGT + SZ_CK, WS_VTP = WS_BGT + SZ_CK;
constexpr size_t WS_TP   = WS_VTP + SZ_CK, WS_AAK = WS_TP + SZ_CM, WS_ARK = WS_AAK + SZ_CM, WS_ARB = WS_ARK + SZ_CM;
constexpr size_t WS_GC   = WS_ARB + SZ_CM;
constexpr size_t WS_VTOK = WS_GC + al256((size_t)32 * 520 * 256 * 4);
constexpr size_t WS_SY   = WS_VTOK + al256((size_t)2 * T * 1024 * 2);
constexpr size_t WS_BON  = WS_SY + 2 * SZ_S;
constexpr size_t WS_KNRM = WS_BON + al256((size_t)2 * T * 16 * 4 * 4);
constexpr size_t SZ_RT   = al256((size_t)T * 1024 * 2);
constexpr size_t WS_SCT  = WS_KNRM + al256((size_t)T * 16 * 4);
constexpr size_t WS_RT   = WS_SCT + al256((size_t)320 * 32 * 2 * 4);
constexpr size_t WS_QR   = WS_RT + al256((size_t)2 * 32 * 2048 * 2);
constexpr size_t WS_KR   = WS_QR + SZ_RT, WS_VT = WS_KR + SZ_RT, WS_KTF = WS_VT + SZ_RT, WS_KTB = WS_KTF + SZ_RT;
constexpr size_t WS_KVT  = WS_KTB + SZ_RT;
constexpr size_t WS_ST   = WS_KVT + al256((size_t)2 * 8 * NCH * 16384 * 4);
constexpr size_t WS_YALL = WS_ST + al256((size_t)2 * 8 * NCH * 16384 * 2);
constexpr size_t WS_RE   = WS_YALL + al256((size_t)T * D * 2);
constexpr size_t WS_RWT  = WS_RE + al256((size_t)T * 2 * 4);
constexpr size_t WS_RI   = WS_RWT + al256((size_t)T * 2 * 4);
constexpr size_t WS_DEST = WS_RI + al256((size_t)T * 2 * 4);
constexpr size_t WS_TILE = WS_DEST + al256((size_t)T * 2 * 4);
constexpr size_t WS_XB   = WS_TILE + 1024;
constexpr size_t WS_ACT  = WS_XB + al256((size_t)MPAD * D * 2);
constexpr size_t WS_YB   = WS_ACT + al256((size_t)MPAD * 1024 * 2);
constexpr size_t WS_END  = WS_YB + al256((size_t)MPAD * D * 2);
constexpr int CW_BAR = 4096;
constexpr int CW_CNT = 8192;

constexpr int RING_BYTES = 131072, EXTRA_OFF = RING_BYTES, EXTRA_BYTES = 24576, MISC_OFF = EXTRA_OFF + EXTRA_BYTES, LDS_BYTES = MISC_OFF + 256;

__device__ __forceinline__ float bf_lo(unsigned w) { return __uint_as_float(w << 16); }
__device__ __forceinline__ float bf_hi(unsigned w) { return __uint_as_float(w & 0xffff0000u); }
__device__ __forceinline__ unsigned pk2(float lo, float hi) { return pg8::cvt_pk_bf16(lo, hi); }
__device__ __forceinline__ unsigned short f2bf1(float f) { return (unsigned short)(pg8::cvt_pk_bf16(f, 0.f) & 0xffffu); }
__device__ __forceinline__ float wave_sum(float v) {
#pragma unroll
    for (int o = 1; o < 64; o <<= 1) v += __shfl_xor(v, o);
    return v;
}
template <int CTRL> __device__ __forceinline__ float dppf(float v) { return __builtin_bit_cast(float, __builtin_amdgcn_update_dpp(0, __builtin_bit_cast(int, v), CTRL, 0xf, 0xf, true)); }
__device__ __forceinline__ float quadsum(float v) { v += dppf<0xB1>(v); v += dppf<0x4E>(v); return v; }
__device__ __forceinline__ float rowsum16(float v) { v += dppf<0xB1>(v); v += dppf<0x4E>(v); v += dppf<0x141>(v); v += dppf<0x140>(v); return v; }
__device__ __forceinline__ float sigmoidf_(float x) { return 1.0f / (1.0f + __expf(-x)); }
#define LDS_WAIT() asm volatile("s_waitcnt lgkmcnt(0)" ::: "memory")

#define XB_TMO      128
#define XB_XCNT(j)  (256  + 64 * (j))
#define XB_XSUB(j)  (1280 + 64 * (j))
#define XB_XGEN(j)  (2304 + 64 * (j))
#define XB_TOP      3328
#define XB_TOPGEN   3392
#define XCD_BAR_WORDS 3456
#define XB_SPIN_CAP (1u << 20)
__device__ __forceinline__ unsigned xb_ld(unsigned* p)              { return __hip_atomic_load(p, __ATOMIC_RELAXED, __HIP_MEMORY_SCOPE_AGENT); }
__device__ __forceinline__ unsigned xb_add(unsigned* p, unsigned v) { return __hip_atomic_fetch_add(p, v, __ATOMIC_RELAXED, __HIP_MEMORY_SCOPE_AGENT); }
__device__ __forceinline__ unsigned xb_xcc_id() { return (unsigned)__builtin_amdgcn_s_getreg((3 << 11) | 20) & 0xFu; }
#define XB_SPIN(cond, bar) do { unsigned _sp = 0; while (cond) { __builtin_amdgcn_s_sleep(1); \
    if ((++_sp & 255u) == 0u) { if (xb_ld(&(bar)[XB_TMO])) break; if (_sp > XB_SPIN_CAP) { atomicAdd(&(bar)[XB_TMO], 1u); break; } } } } while (0)
struct XcdBarrier { unsigned* bar; unsigned x; volatile LAS unsigned* st; };
__device__ __forceinline__ XcdBarrier xcd_barrier_post(unsigned* bar, volatile LAS unsigned* st) {
    XcdBarrier b; b.bar = bar; b.x = xb_xcc_id(); b.st = st;
    if (threadIdx.x == 0) (void)xb_add(&bar[XB_XCNT(b.x)], 1u);
    return b;
}
__device__ __forceinline__ void xcd_barrier_complete(unsigned* bar, unsigned x, unsigned& nloc, unsigned& nx) {
    const unsigned G = gridDim.x * gridDim.y * gridDim.z;
    unsigned sum, cnt, mine, sp = 0u;
    for (;;) {
        sum = 0u; cnt = 0u; mine = 0u;
#pragma unroll
        for (unsigned j = 0; j < 16; ++j) { const unsigned c = xb_ld(&bar[XB_XCNT(j)]); sum += c; cnt += (c > 0u) ? 1u : 0u; mine = (j == x) ? c : mine; }
        if (sum == G) break;
        __builtin_amdgcn_s_sleep(1);
        if ((++sp & 255u) == 0u) { if (xb_ld(&bar[XB_TMO])) break; if (sp > XB_SPIN_CAP) { atomicAdd(&bar[XB_TMO], 1u); break; } }
    }
    nloc = mine > 0u ? mine : 1u; nx = cnt > 0u ? cnt : 1u;
}
__device__ __forceinline__ void xcd_barrier(const XcdBarrier& b) {
    asm volatile("s_waitcnt vmcnt(0)" ::: "memory");
    __syncthreads();
    if (threadIdx.x == 0) {
        unsigned* bar = b.bar; asm volatile("" : "+s"(bar));
        __builtin_amdgcn_s_waitcnt(0);
        unsigned nloc = b.st[0], nx = b.st[1];
        if (nloc == 0u) { xcd_barrier_complete(bar, b.x, nloc, nx); b.st[0] = nloc; b.st[1] = nx; }
        const unsigned old = xb_add(&bar[XB_XSUB(b.x)], 1u);
        const unsigned gen = old / nloc;
        if (old + 1u == (gen + 1u) * nloc) {
            __builtin_amdgcn_fence(__ATOMIC_RELEASE, "agent");
            asm volatile("s_waitcnt vmcnt(0)" ::: "memory");
            const unsigned og = xb_add(&bar[XB_TOP], 1u);
            const unsigned tg = og / nx;
            if (og + 1u == (tg + 1u) * nx) xb_add(&bar[XB_TOPGEN], 1u);
            else XB_SPIN(xb_ld(&bar[XB_TOPGEN]) == tg, bar);
            __builtin_amdgcn_fence(__ATOMIC_ACQUIRE, "agent");
            xb_add(&bar[XB_XGEN(b.x)], 1u);
            asm volatile("s_waitcnt vmcnt(0)" ::: "memory");
        } else {
            XB_SPIN(xb_ld(&bar[XB_XGEN(b.x)]) == gen, bar);
            __builtin_amdgcn_fence(__ATOMIC_ACQUIRE, "agent");
            asm volatile("s_waitcnt vmcnt(0)" ::: "memory");
        }
    }
    __syncthreads();
}

struct Args { const float* in[28]; float* out; unsigned char* ws; int ph_lo, ph_hi; };
enum { I_X = 0, I_C, I_CTX, I_CCTX, I_ADAW, I_ADAB, I_N1G, I_N2G, I_WIN, I_MU, I_W0, I_W2, I_A0, I_A2, I_G2, I_KK, I_KA, I_RK, I_LNW, I_LNB, I_L2D, I_GNW, I_WOUT, I_RTW, I_RTB, I_MW1, I_MW2, I_FG };

struct Ctx {
    LAS unsigned char* lds;
    int tid, lane, wave, G, bx, gw, NGW;
};

__device__ __forceinline__ void tr_item(const float* W, int K, int N, bf16* WT, int k0, int n0, int orow0, LAS float* scr, int lane) {
#pragma unroll 8
    for (int i = 0; i < 32; ++i) { const int kk = 2 * i + (lane >> 5); scr[kk * 33 + (lane & 31)] = W[(size_t)(k0 + kk) * N + n0 + (lane & 31)]; }
    LDS_WAIT();
    const int c = lane & 7;
#pragma unroll
    for (int j = 0; j < 4; ++j) { const int n = (lane >> 3) + 8 * j; const LAS float* s = scr + (8 * c) * 33 + n;
        v4u o; o.x = pk2(s[0 * 33], s[1 * 33]); o.y = pk2(s[2 * 33], s[3 * 33]); o.z = pk2(s[4 * 33], s[5 * 33]); o.w = pk2(s[6 * 33], s[7 * 33]);
        *(v4u*)(WT + (size_t)(orow0 + n) * K + k0 + 8 * c) = o; }
    LDS_WAIT();
}
__device__ __forceinline__ void ph_prologue(const Args& a, const Ctx& C) {
    unsigned char* ws = a.ws;
    LAS float* scr = (LAS float*)(C.lds + C.wave * 16384);
    constexpr int IW_IN = 32 * 237, IW_OUT = 32 * 64, PER = IW_IN + IW_OUT;
    for (int it = C.gw; it < NL * PER; it += C.NGW) {
        const int l = it / PER; int r = it % PER;
        if (r < IW_IN) { const int kb = r / 237, nb = r % 237, n0 = 32 * nb;
            tr_item(a.in[I_WIN] + (size_t)l * D * PIN, D, PIN, (bf16*)(ws + WS_WIN) + (size_t)l * PW * D, 64 * kb, n0, n0 < RWIN ? n0 : n0 + (RET_OFF - RWIN), scr, C.lane); continue; }
        r -= IW_IN;
        { const int kb = r / 64, nb = r % 64;
            tr_item(a.in[I_WOUT] + (size_t)l * D * D, D, D, (bf16*)(ws + WS_WOUT) + (size_t)l * D * D, 64 * kb, 32 * nb, 32 * nb, scr, C.lane); }
    }
    const int gtid = C.gw * 64 + C.lane, NGT = C.NGW * 64;
    for (int i = gtid; i < NL * 96 * (D / 8); i += NGT) { const int l = i / (96 * 256), r = (i / 256) % 96, c8 = i % 256;
        *(v4u*)((bf16*)(ws + WS_WIN) + ((size_t)l * PW + RWIN + r) * D + 8 * c8) = (v4u){0u, 0u, 0u, 0u}; }
    for (int i = gtid; i < NL * LNN * (LK / 8); i += NGT) {
        const int l = i / (LNN * 64), n = (i / 64) % LNN, k0 = 8 * (i % 64);
        const int blk = n >> 10, nn = n & 1023;
        float v[8];
#pragma unroll
        for (int j = 0; j < 8; ++j) { const int k = k0 + j; float x = 0.f;
            if (blk < 2) { if ((k >> 6) == blk) x = a.in[I_W2][((size_t)(l * 2 + blk) * 64 + (k & 63)) * 1024 + nn]; }
            else if (blk < 4) { if ((k >> 6) == blk) x = a.in[I_A2][((size_t)(l * 2 + (blk - 2)) * 64 + (k & 63)) * 1024 + nn]; }
            else { if (k >= 256 && k < 416) x = a.in[I_G2][((size_t)l * 160 + (k - 256)) * 1024 + nn]; }
            v[j] = x; }
        *(v4u*)((bf16*)(ws + WS_LB) + ((size_t)l * LNN + n) * LK + k0) = (v4u){pk2(v[0], v[1]), pk2(v[2], v[3]), pk2(v[4], v[5]), pk2(v[6], v[7])};
    }
    for (int i = gtid; i < 32 * 2048; i += NGT) { const int e = i >> 11, k = i & 2047; const float w = a.in[I_RTW][(size_t)k * 32 + e];
        const unsigned short hi = f2bf1(w); const float hf = __uint_as_float((unsigned)hi << 16);
        bf16* rt = (bf16*)(ws + WS_RT); rt[i] = hi; rt[32 * 2048 + i] = f2bf1(w - hf); }
    for (int i = gtid; i < 320 * 32; i += NGT) { const int pv = i >> 5, fi = i & 31; const float ang = (float)(pv < 256 ? pv : pv - 256) * exp2f(-(float)(2 * fi) * (13.287712379549449f / 64.0f));
        float* sct = (float*)(ws + WS_SCT); sct[2 * i] = cosf(ang); sct[2 * i + 1] = sinf(ang); }
    for (int it = C.gw; it < NL * KP * 48; it += C.NGW) {
        const int l = it / (KP * 48), kp = (it / 48) % KP, jb = it % 48;
        const int kb = 128 * kp;
        { const float c0 = a.in[I_C][kb + C.lane], c1 = a.in[I_C][kb + 64 + C.lane], x0 = a.in[I_CCTX][kb + C.lane], x1 = a.in[I_CCTX][kb + 64 + C.lane];
          scr[C.lane] = c0 * sigmoidf_(c0); scr[64 + C.lane] = c1 * sigmoidf_(c1); scr[128 + C.lane] = x0 * sigmoidf_(x0); scr[192 + C.lane] = x1 * sigmoidf_(x1); }
        LDS_WAIT();
        f32x4 ax = {0.f, 0.f, 0.f, 0.f}, ac = {0.f, 0.f, 0.f, 0.f};
        const float* wp = a.in[I_ADAW] + ((size_t)l * D + kb) * 12288 + 256 * jb + 4 * C.lane;
#pragma unroll 8
        for (int k = 0; k < 128; ++k) { const f32x4 w = *(const f32x4*)(wp + (size_t)k * 12288); const float sx = scr[k], sc = scr[128 + k]; ax += w * sx; ac += w * sc; }
        float* mp = (float*)(ws + WS_MODP) + ((size_t)(l * KP + kp) * 2) * 12288 + 256 * jb + 4 * C.lane;
        *(f32x4*)mp = ax; *(f32x4*)(mp + 12288) = ac;
        LDS_WAIT();
    }
}

__device__ __forceinline__ void ph_convert_moe(const Args& a, const Ctx& C, int l, int wid, int nw, LAS float* scr) {
    unsigned char* ws = a.ws;
    constexpr int IW_1 = 32 * 32 * 64, IW_2 = 32 * 16 * 64;
    for (int it = wid; it < IW_1 + IW_2; it += nw) {
        int r = it;
        if (r < IW_1) { const int e = r / 2048, rr = r % 2048, kb = rr / 64, nb = rr % 64, n0 = 32 * nb;
            const int orow = n0 < 1024 ? 256 * (n0 >> 7) + (n0 & 127) : 256 * ((n0 - 1024) >> 7) + 128 + ((n0 - 1024) & 127);
            tr_item(a.in[I_MW1] + (size_t)(l * NE + e) * 2048 * 2048, 2048, 2048, (bf16*)(ws + WS_W1) + (size_t)(l * NE + e) * 2048 * 2048, 64 * kb, n0, orow, scr, C.lane); continue; }
        r -= IW_1;
        { const int e = r / 1024, rr = r % 1024, kb = rr / 64, nb = rr % 64;
            tr_item(a.in[I_MW2] + (size_t)(l * NE + e) * 1024 * 2048, 1024, 2048, (bf16*)(ws + WS_W2) + (size_t)(l * NE + e) * 2048 * 1024, 64 * kb, 32 * nb, 32 * nb, scr, C.lane); }
    }
}
__device__ __forceinline__ float mod_from_partials(const Args& a, int l, int which, int j) {
    float s = a.in[I_ADAB][l * 12288 + j];
    const float* mp = (const float*)(a.ws + WS_MODP) + ((size_t)(l * KP) * 2 + which) * 12288 + j;
#pragma unroll
    for (int kp = 0; kp < KP; ++kp) s += mp[(size_t)kp * 2 * 12288];
    return s;
}

__device__ __forceinline__ const float* xrow_ptr(const Args& a, int l, int r) {
    if (l == 0) return r < TC ? a.in[I_CTX] + (size_t)r * D : a.in[I_X] + (size_t)(r - TC) * D;
    return (const float*)(a.ws + WS_XN) + (size_t)r * D;
}
__device__ __forceinline__ void ph_norm1(const Args& a, const Ctx& C, int l) {
    LAS float* GV = (LAS float*)C.lds;
    if (l == 0) {
        float* modf = (float*)(a.ws + WS_MOD);
        for (int i = C.bx * NTHR + C.tid; i < NL * 2 * 12288; i += C.G * NTHR) { const int ll = i / (2 * 12288), wh = (i / 12288) & 1, j = i % 12288; modf[i] = mod_from_partials(a, ll, wh, j); }
    }
    for (int i = C.tid; i < 2 * D; i += NTHR) { const int wh = i / D, k = i % D;
        const float sh = mod_from_partials(a, l, wh, k), sc = mod_from_partials(a, l, wh, D + k);
        GV[wh * D + k] = a.in[I_N1G][l * D + k] * (1.0f + sc); GV[2 * D + wh * D + k] = sh; }
    __syncthreads();
    bf16* H = (bf16*)(a.ws + WS_H);
    for (int r = C.gw; r < T; r += C.NGW) {
        const float* xr = xrow_ptr(a, l, r); const int wh = r < TC ? 1 : 0;
        f32x4 v[8]; float ss = 0.f;
#pragma unroll
        for (int j = 0; j < 8; ++j) { v[j] = *(const f32x4*)(xr + 4 * C.lane + 256 * j); ss += v[j].x * v[j].x + v[j].y * v[j].y + v[j].z * v[j].z + v[j].w * v[j].w; }
        const float rstd = rsqrtf(wave_sum(ss) * (1.0f / D) + 1e-6f);
#pragma unroll
        for (int j = 0; j < 8; ++j) { const int k = 4 * C.lane + 256 * j;
            const f32x4 g = *(const LAS f32x4*)(GV + wh * D + k), s = *(const LAS f32x4*)(GV + 2 * D + wh * D + k);
            const f32x4 h = v[j] * rstd * g + s;
            *(v2u*)(H + (size_t)r * D + k) = (v2u){pk2(h.x, h.y), pk2(h.z, h.w)}; }
    }
    __syncthreads();
}

__device__ __forceinline__ void shift_rows(int t, int (&nb)[4], int& nn) {
    const bool isc = t < TC; const int p = t - TC, gc = p & 63, gr = p >> 6;
    nn = isc ? 2 : 4;
    nb[0] = isc ? (t > 0 ? t - 1 : -1) : (gc > 0 ? t - 1 : -1);
    nb[1] = isc ? (t < TC - 1 ? t + 1 : -1) : (gc < 63 ? t + 1 : -1);
    nb[2] = isc ? -1 : (gr > 0 ? t - 64 : -1);
    nb[3] = isc ? -1 : (gr < 255 ? t + 64 : -1);
}
__device__ __forceinline__ void shift8(const bf16* P, const float* mu  , int t, int col0, const int (&nb)[4], int nn, float (&u)[8]) {
    const v4u pc = *(const v4u*)(P + (size_t)t * PW + col0);
    v4u q[4];
#pragma unroll
    for (int j = 0; j < 4; ++j) q[j] = *(const v4u*)(P + (size_t)(nb[j] >= 0 ? nb[j] : t) * PW + col0);
    float p[8] = {bf_lo(pc.x), bf_hi(pc.x), bf_lo(pc.y), bf_hi(pc.y), bf_lo(pc.z), bf_hi(pc.z), bf_lo(pc.w), bf_hi(pc.w)};
#pragma unroll
    for (int i = 0; i < 8; ++i) u[i] = p[i];
#pragma unroll
    for (int j = 0; j < 4; ++j) {
        const float on = (j < nn) ? 1.0f : 0.0f, has = (nb[j] >= 0) ? 1.0f : 0.0f;
        const float n8[8] = {bf_lo(q[j].x), bf_hi(q[j].x), bf_lo(q[j].y), bf_hi(q[j].y), bf_lo(q[j].z), bf_hi(q[j].z), bf_lo(q[j].w), bf_hi(q[j].w)};
        const f32x4 m0 = *(const f32x4*)(mu + (size_t)j * RWIN + col0), m1 = *(const f32x4*)(mu + (size_t)j * RWIN + col0 + 4);
        const float m8[8] = {m0.x, m0.y, m0.z, m0.w, m1.x, m1.y, m1.z, m1.w};
#pragma unroll
        for (int i = 0; i < 8; ++i) u[i] += on * m8[i] * (has * n8[i] - p[i]);
    }
}

__device__ __forceinline__ void ph_prep(const Args& a, const Ctx& C, int l) {
    const bf16* P = (const bf16*)(a.ws + WS_P);
    const float* mu = a.in[I_MU] + (size_t)l * 4 * RWIN;
    bf16* LA = (bf16*)(a.ws + WS_LA);
    for (int t = C.gw; t < T; t += C.NGW) {
        v4u o = {0u, 0u, 0u, 0u};
        if (C.lane < 52) {
            int nb[4], nn; shift_rows(t, nb, nn);
            float u[8]; shift8(P, mu, t, 3072 + 8 * C.lane, nb, nn, u);
            const int cc = 8 * C.lane;
#pragma unroll
            for (int i = 0; i < 8; ++i) { if (cc < 128) u[i] = tanhf(u[i]); else if (cc >= 256) u[i] = sigmoidf_(u[i]); }
            o = (v4u){pk2(u[0], u[1]), pk2(u[2], u[3]), pk2(u[4], u[5]), pk2(u[6], u[7])};
        }
        *(v4u*)(LA + (size_t)t * LK + 8 * C.lane) = o;
    }
    { float* KNRM = (float*)(a.ws + WS_KNRM);
      for (int t = C.gw; t < T; t += C.NGW) {
          int nb[4], nn; shift_rows(t, nb, nn);
          float u[8], ss = 0.f;
#pragma unroll
          for (int hh = 0; hh < 2; ++hh) { shift8(P, mu, t, 1024 + 16 * C.lane + 8 * hh, nb, nn, u);
#pragma unroll
              for (int i = 0; i < 8; ++i) { const float x = u[i] * a.in[I_KK][l * 1024 + 16 * C.lane + 8 * hh + i]; ss += x * x; } }
          ss = quadsum(ss);
          if ((C.lane & 3) == 0) KNRM[(size_t)t * 16 + (C.lane >> 2)] = ss; } }
    bf16* QR = (bf16*)(a.ws + WS_QR); bf16* KR = (bf16*)(a.ws + WS_KR);
    bf16* VT = (bf16*)(a.ws + WS_VT); bf16* KTF = (bf16*)(a.ws + WS_KTF); bf16* KTB = (bf16*)(a.ws + WS_KTB);
    LAS unsigned short* TL0 = (LAS unsigned short*)C.lds;
    constexpr int TP = 136, TSZ = 128 * TP;
    for (int un = C.bx; un < NCH * 8; un += C.G) {
        const int c = un >> 3, h = un & 7, t0 = 128 * c;
        const float l2f = a.in[I_L2D][(l * 2 + 0) * 8 + h], l2b = a.in[I_L2D][(l * 2 + 1) * 8 + h];
        const float lgf = log1pf(-exp2f(-l2f)), lgb = log1pf(-exp2f(-l2b));
        const int m = C.tid >> 2, p = C.tid & 3, t = t0 + m;
        const bool lat = c >= 2; const int pos = t - TC;
        const int half = p >> 1, ib = 16 * (p & 1);
        const int pvi = lat ? (half ? 256 + (pos & 63) : (pos >> 6)) : 0; const float* sct = (const float*)(a.ws + WS_SCT);
        const int d1 = 64 * half + ib;
        const bf16* prow = P + (size_t)t * PW + RET_OFF + 128 * h;
        float q1[16], q2[16], k1[16], k2[16];
        { const v4u a0 = *(const v4u*)(prow + d1), a1 = *(const v4u*)(prow + d1 + 8), b0 = *(const v4u*)(prow + d1 + 32), b1 = *(const v4u*)(prow + d1 + 40);
          const unsigned wa[8] = {a0.x, a0.y, a0.z, a0.w, a1.x, a1.y, a1.z, a1.w}, wb[8] = {b0.x, b0.y, b0.z, b0.w, b1.x, b1.y, b1.z, b1.w};
#pragma unroll
          for (int i = 0; i < 8; ++i) { q1[2 * i] = bf_lo(wa[i]); q1[2 * i + 1] = bf_hi(wa[i]); q2[2 * i] = bf_lo(wb[i]); q2[2 * i + 1] = bf_hi(wb[i]); } }
        { const bf16* kp = prow + 1024;
          const v4u a0 = *(const v4u*)(kp + d1), a1 = *(const v4u*)(kp + d1 + 8), b0 = *(const v4u*)(kp + d1 + 32), b1 = *(const v4u*)(kp + d1 + 40);
          const unsigned wa[8] = {a0.x, a0.y, a0.z, a0.w, a1.x, a1.y, a1.z, a1.w}, wb[8] = {b0.x, b0.y, b0.z, b0.w, b1.x, b1.y, b1.z, b1.w};
#pragma unroll
          for (int i = 0; i < 8; ++i) { k1[2 * i] = bf_lo(wa[i]); k1[2 * i + 1] = bf_hi(wa[i]); k2[2 * i] = bf_lo(wb[i]); k2[2 * i + 1] = bf_hi(wb[i]); } }
        const float ksc = 0.08838834764831845f;
#pragma unroll
        for (int i = 0; i < 16; ++i) {
            float cs = 1.f, sn = 0.f;
            if (lat) { const float* e2 = sct + ((size_t)pvi * 32 + ib + i) * 2; cs = e2[0]; sn = e2[1]; }
            const float qa = q1[i] * cs - q2[i] * sn, qb = q1[i] * sn + q2[i] * cs;
            const float ka = (k1[i] * cs - k2[i] * sn) * ksc, kb = (k1[i] * sn + k2[i] * cs) * ksc;
            q1[i] = qa; q2[i] = qb; k1[i] = ka; k2[i] = kb;
        }
        { bf16* qo = QR + (size_t)t * 1024 + 128 * h; bf16* ko = KR + (size_t)t * 1024 + 128 * h;
          *(v4u*)(qo + d1) = (v4u){pk2(q1[0], q1[1]), pk2(q1[2], q1[3]), pk2(q1[4], q1[5]), pk2(q1[6], q1[7])};
          *(v4u*)(qo + d1 + 8) = (v4u){pk2(q1[8], q1[9]), pk2(q1[10], q1[11]), pk2(q1[12], q1[13]), pk2(q1[14], q1[15])};
          *(v4u*)(qo + d1 + 32) = (v4u){pk2(q2[0], q2[1]), pk2(q2[2], q2[3]), pk2(q2[4], q2[5]), pk2(q2[6], q2[7])};
          *(v4u*)(qo + d1 + 40) = (v4u){pk2(q2[8], q2[9]), pk2(q2[10], q2[11]), pk2(q2[12], q2[13]), pk2(q2[14], q2[15])};
          *(v4u*)(ko + d1) = (v4u){pk2(k1[0], k1[1]), pk2(k1[2], k1[3]), pk2(k1[4], k1[5]), pk2(k1[6], k1[7])};
          *(v4u*)(ko + d1 + 8) = (v4u){pk2(k1[8], k1[9]), pk2(k1[10], k1[11]), pk2(k1[12], k1[13]), pk2(k1[14], k1[15])};
          *(v4u*)(ko + d1 + 32) = (v4u){pk2(k2[0], k2[1]), pk2(k2[2], k2[3]), pk2(k2[4], k2[5]), pk2(k2[6], k2[7])};
          *(v4u*)(ko + d1 + 40) = (v4u){pk2(k2[8], k2[9]), pk2(k2[10], k2[11]), pk2(k2[12], k2[13]), pk2(k2[14], k2[15])}; }
        const float zf = __expf(lgf * (float)(127 - m)), zb = __expf(lgb * (float)m);
#pragma unroll
        for (int i = 0; i < 16; ++i) {
            TL0[TSZ + (d1 + i) * TP + m] = f2bf1(k1[i] * zf);      TL0[TSZ + (d1 + 32 + i) * TP + m] = f2bf1(k2[i] * zf);
            TL0[2 * TSZ + (d1 + i) * TP + m] = f2bf1(k1[i] * zb);  TL0[2 * TSZ + (d1 + 32 + i) * TP + m] = f2bf1(k2[i] * zb);
        }
        { const bf16* vp = prow + 2048 + 32 * p;
#pragma unroll
          for (int j = 0; j < 4; ++j) { const v4u w = *(const v4u*)(vp + 8 * j); const unsigned ww[4] = {w.x, w.y, w.z, w.w};
#pragma unroll
              for (int i = 0; i < 4; ++i) { TL0[(32 * p + 8 * j + 2 * i) * TP + m] = (unsigned short)(ww[i] & 0xffffu); TL0[(32 * p + 8 * j + 2 * i + 1) * TP + m] = (unsigned short)(ww[i] >> 16); } } }
        __syncthreads();
        { const int d = C.tid >> 2, part = C.tid & 3; const size_t go = ((size_t)(h * NCH + c) * 128 + d) * 128 + 32 * part;
#pragma unroll
          for (int j = 0; j < 4; ++j) *(v4u*)(VT + go + 8 * j)  = *(const LAS v4u*)(TL0 + d * TP + 32 * part + 8 * j); }
        { const int fr = C.lane & 15, fq = C.lane >> 4; float* KVT = (float*)(a.ws + WS_KVT);
          bf16x8 A[4];
#pragma unroll
          for (int s = 0; s < 4; ++s) A[s] = *(const LAS bf16x8*)(TL0 + (16 * C.wave + fr) * TP + 32 * s + 8 * fq);
#pragma unroll
          for (int dir = 0; dir < 2; ++dir) { float* outp = KVT + ((size_t)dir * 8 * NCH + (size_t)(h * NCH + c)) * 16384;
#pragma unroll
              for (int n = 0; n < 8; ++n) { f32x4 acc = {0.f, 0.f, 0.f, 0.f};
#pragma unroll
                  for (int s = 0; s < 4; ++s) { const bf16x8 B = *(const LAS bf16x8*)(TL0 + (1 + dir) * TSZ + (16 * n + fr) * TP + 32 * s + 8 * fq); acc = __builtin_amdgcn_mfma_f32_16x16x32_bf16(B, A[s], acc, 0, 0, 0); }
                  *(f32x4*)(outp + (size_t)(16 * C.wave + fr) * 128 + 16 * n + 4 * fq) = acc; } } }
        __syncthreads();
    }
}

__device__ __forceinline__ void ph_ret_kv(const Args& a, const Ctx& C) {
    const bf16* VT = (const bf16*)(a.ws + WS_VT); float* KVT = (float*)(a.ws + WS_KVT);
    const int fr = C.lane & 15, fq = C.lane >> 4;
    for (int un = C.bx; un < 2 * 8 * NCH; un += C.G) {
        const int dir = un / (8 * NCH), hc = un % (8 * NCH);
        const bf16* KT = (const bf16*)(a.ws + (dir ? WS_KTB : WS_KTF)) + (size_t)hc * 16384;
        const bf16* vt = VT + (size_t)hc * 16384 + (size_t)(16 * C.wave + fr) * 128 + 8 * fq;
        bf16x8 A[4];
#pragma unroll
        for (int s = 0; s < 4; ++s) A[s] = *(const bf16x8*)(vt + 32 * s);
        float* outp = KVT + ((size_t)dir * 8 * NCH + hc) * 16384;
#pragma unroll
        for (int n = 0; n < 8; ++n) {
            f32x4 acc = {0.f, 0.f, 0.f, 0.f};
            const bf16* kt = KT + (size_t)(16 * n + fr) * 128 + 8 * fq;
#pragma unroll
            for (int s = 0; s < 4; ++s) { const bf16x8 B = *(const bf16x8*)(kt + 32 * s); acc = __builtin_amdgcn_mfma_f32_16x16x32_bf16(B, A[s], acc, 0, 0, 0); }
            *(f32x4*)(outp + (size_t)(16 * C.wave + fr) * 128 + 16 * n + 4 * fq) = acc;
        }
    }
}
__device__ __forceinline__ void ph_ret_prefix(const Args& a, const Ctx& C, int l) {
    const float* KVT = (const float*)(a.ws + WS_KVT); bf16* ST = (bf16*)(a.ws + WS_ST);
    for (int i = C.bx * NTHR + C.tid; i < 16 * 16384; i += C.G * NTHR) {
        const int dh = i >> 14, el = i & 16383, dir = dh >> 3, h = dh & 7;
        const float l2 = a.in[I_L2D][(l * 2 + dir) * 8 + h]; const float gC = __expf(128.0f * log1pf(-exp2f(-l2)));
        const float* kv = KVT + (size_t)dh * NCH * 16384 + el; bf16* st = ST + (size_t)dh * NCH * 16384 + el;
        float s = 0.f;
        for (int b0 = 0; b0 < NCH; b0 += 10) {
            float kvv[10]; int cc[10];
#pragma unroll
            for (int j = 0; j < 10; ++j) { const int o = b0 + j; cc[j] = dir == 0 ? o : (o < 2 ? 1 - o : (NCH + 1) - o); kvv[j] = kv[(size_t)cc[j] * 16384]; }
#pragma unroll
            for (int j = 0; j < 10; ++j) { st[(size_t)cc[j] * 16384] = f2bf1(s); s = s * gC + kvv[j]; }
        }
    }
}
__device__ __forceinline__ void ph_ret_out(const Args& a, const Ctx& C, int l, int ub, int nblk) {
    const bf16* QR = (const bf16*)(a.ws + WS_QR); const bf16* KR = (const bf16*)(a.ws + WS_KR); const bf16* VT = (const bf16*)(a.ws + WS_VT);
    const bf16* ST = (const bf16*)(a.ws + WS_ST); const bf16* P = (const bf16*)(a.ws + WS_P); bf16* YALL = (bf16*)(a.ws + WS_YALL);
    const int fr = C.lane & 15, fq = C.lane >> 4;
    constexpr int PP = 136, TSZ = 128 * PP;
    LAS unsigned short* T0 = (LAS unsigned short*)C.lds; LAS unsigned short* T1 = T0 + TSZ; LAS unsigned short* T2 = T1 + TSZ;
    LAS unsigned short* Pw = T0 + 3 * TSZ + C.wave * 16 * PP;
    for (int un = ub; un < NCH * 8; un += nblk) {
        const int c = un >> 3, h = un & 7, t0 = 128 * c, hc = h * NCH + c, rs = C.wave;
        const float l2f = a.in[I_L2D][(l * 2 + 0) * 8 + h], l2b = a.in[I_L2D][(l * 2 + 1) * 8 + h];
        const float lgf2 = log1pf(-exp2f(-l2f)) * 1.4426950408889634f, lgb2 = log1pf(-exp2f(-l2b)) * 1.4426950408889634f;
#pragma unroll
        for (int j = 0; j < 4; ++j) { const int pc = C.tid + NTHR * j, r = pc >> 4, c16 = pc & 15;
            *(LAS v4u*)(T0 + r * PP + 8 * c16) = *(const v4u*)(KR + (size_t)(t0 + r) * 1024 + 128 * h + 8 * c16); }
        bf16x8 QA[4];
        { const bf16* qp = QR + (size_t)(t0 + 16 * rs + fr) * 1024 + 128 * h + 8 * fq;
#pragma unroll
          for (int s = 0; s < 4; ++s) QA[s] = *(const bf16x8*)(qp + 32 * s); }
        __syncthreads();
#pragma unroll
        for (int j = 0; j < 8; ++j) {
            f32x4 acc = {0.f, 0.f, 0.f, 0.f};
#pragma unroll
            for (int s = 0; s < 4; ++s) { const bf16x8 B = *(const LAS bf16x8*)(T0 + (16 * j + fr) * PP + 32 * s + 8 * fq); acc = __builtin_amdgcn_mfma_f32_16x16x32_bf16(QA[s], B, acc, 0, 0, 0); }
#pragma unroll
            for (int r = 0; r < 4; ++r) { const int n = 16 * rs + 4 * fq + r, m = 16 * j + fr, df = n - m;
                const float f = df >= 0 ? exp2f(lgf2 * (float)df) : exp2f(lgb2 * (float)(-df));
                Pw[(4 * fq + r) * PP + m] = f2bf1(acc[r] * f); }
        }
        __syncthreads();
#pragma unroll
        for (int j = 0; j < 4; ++j) { const int pc = C.tid + NTHR * j, r = pc >> 4, c16 = pc & 15; const size_t go = (size_t)hc * 16384 + (size_t)r * 128 + 8 * c16;
            *(LAS v4u*)(T0 + r * PP + 8 * c16) = *(const v4u*)(VT + go);
            *(LAS v4u*)(T1 + r * PP + 8 * c16) = *(const v4u*)(ST + (size_t)(0 * 8) * NCH * 16384 + go);
            *(LAS v4u*)(T2 + r * PP + 8 * c16) = *(const v4u*)(ST + (size_t)(1 * 8) * NCH * 16384 + go); }
        __syncthreads();
        f32x4 aY[8];
        bf16x8 PA[4];
#pragma unroll
        for (int s = 0; s < 4; ++s) PA[s] = *(const LAS bf16x8*)(Pw + fr * PP + 32 * s + 8 * fq);
        const int n = 16 * rs + fr;
        const float xf = exp2f(lgf2 * (float)(n + 1)), xb = exp2f(lgb2 * (float)(128 - n));
        float ss = 0.f;
#pragma unroll
        for (int j = 0; j < 8; ++j) {
            const int dvr = 32 * (j >> 1) + 8 * (fr >> 2) + 4 * (j & 1) + (fr & 3);
            f32x4 y = {0.f, 0.f, 0.f, 0.f}, zf = y, zb = y;
#pragma unroll
            for (int s = 0; s < 4; ++s) {
                const bf16x8 Av = *(const LAS bf16x8*)(T0 + dvr * PP + 32 * s + 8 * fq), Af = *(const LAS bf16x8*)(T1 + dvr * PP + 32 * s + 8 * fq), Ab = *(const LAS bf16x8*)(T2 + dvr * PP + 32 * s + 8 * fq);
                y = __builtin_amdgcn_mfma_f32_16x16x32_bf16(Av, PA[s], y, 0, 0, 0);
                zf = __builtin_amdgcn_mfma_f32_16x16x32_bf16(Af, QA[s], zf, 0, 0, 0);
                zb = __builtin_amdgcn_mfma_f32_16x16x32_bf16(Ab, QA[s], zb, 0, 0, 0);
            }
#pragma unroll
            for (int r = 0; r < 4; ++r) { const float v = y[r] + xf * zf[r] + xb * zb[r]; y[r] = v; ss += v * v; }
            aY[j] = y;
            asm volatile("" : "+v"(aY[j]));
        }
        ss += __shfl_xor(ss, 16); ss += __shfl_xor(ss, 32);
        const float rstd = rsqrtf(ss * (1.0f / 128.0f) + 1e-6f);
        const int t = t0 + n;
#pragma unroll
        for (int m = 0; m < 4; ++m) { const int dv0 = 32 * m + 8 * fq;
            const f32x4 w0 = *(const f32x4*)(a.in[I_GNW] + l * 1024 + 128 * h + dv0), w1 = *(const f32x4*)(a.in[I_GNW] + l * 1024 + 128 * h + dv0 + 4);
            const v4u gq = *(const v4u*)(P + (size_t)t * PW + RET_OFF + 3072 + 128 * h + dv0);
            const float g8[8] = {bf_lo(gq.x), bf_hi(gq.x), bf_lo(gq.y), bf_hi(gq.y), bf_lo(gq.z), bf_hi(gq.z), bf_lo(gq.w), bf_hi(gq.w)};
            const float w8[8] = {w0.x, w0.y, w0.z, w0.w, w1.x, w1.y, w1.z, w1.w};
            float o[8];
#pragma unroll
            for (int i = 0; i < 8; ++i) { const float yv = (i < 4) ? aY[2 * m][i] : aY[2 * m + 1][i - 4]; o[i] = yv * rstd * w8[i] * g8[i] * sigmoidf_(g8[i]); }
            *(v4u*)(YALL + (size_t)t * D + 1024 + 128 * h + dv0) = (v4u){pk2(o[0], o[1]), pk2(o[2], o[3]), pk2(o[4], o[5]), pk2(o[6], o[7])}; }
        __syncthreads();
    }
}

constexpr int NCK = T / 32;
__device__ __forceinline__ int scan_row(int s, int dir) { return dir ? (s < TC ? TC - 1 - s : (T + TC - 1) - s) : s; }
__device__ __forceinline__ int pos_c(int c) { return 32 * (c >> 5) + 8 * ((c >> 2) & 3) + 4 * ((c >> 4) & 1) + (c & 3); }
__device__ __forceinline__ int pos_i(int i) { return 8 * ((i >> 2) & 3) + 4 * (i >> 4) + (i & 3); }
__device__ __forceinline__ float wave_sum_all(float v) {
    v = rowsum16(v);
    const float a = __builtin_bit_cast(float, __builtin_amdgcn_readlane(__builtin_bit_cast(int, v), 0)), b = __builtin_bit_cast(float, __builtin_amdgcn_readlane(__builtin_bit_cast(int, v), 16));
    const float c = __builtin_bit_cast(float, __builtin_amdgcn_readlane(__builtin_bit_cast(int, v), 32)), d = __builtin_bit_cast(float, __builtin_amdgcn_readlane(__builtin_bit_cast(int, v), 48));
    return (a + b) + (c + d);
}
__device__ __forceinline__ float ldbf(const bf16* p) { return __uint_as_float((unsigned)(*p) << 16); }

__device__ __forceinline__ void rwkv_mats_unit(const Args& a, const Ctx& C, int cs, LAS float* LA, const LAS unsigned char* bk);
__device__ __forceinline__ void ld8(const bf16* p, float (&o)[8]) { const v4u w = *(const v4u*)p; o[0] = bf_lo(w.x); o[1] = bf_hi(w.x); o[2] = bf_lo(w.y); o[3] = bf_hi(w.y); o[4] = bf_lo(w.z); o[5] = bf_hi(w.z); o[6] = bf_lo(w.w); o[7] = bf_hi(w.w); }
__device__ __forceinline__ float seg_scan32(float x) {
    x += dppf<0x111>(x); x += dppf<0x112>(x); x += dppf<0x114>(x); x += dppf<0x118>(x);
    x += __builtin_bit_cast(float, __builtin_amdgcn_update_dpp(0, __builtin_bit_cast(int, x), 0x142, 0xa, 0xf, false));
    return x;
}
template <int ST> __device__ __forceinline__ void ph_rwkv_prep(const Args& a, const Ctx& C, int l) {
    const bf16* P = (const bf16*)(a.ws + WS_P); const bf16* LO = (const bf16*)(a.ws + WS_LORA); const float* KNRM = (const float*)(a.ws + WS_KNRM);
    bf16* AGP = (bf16*)(a.ws + WS_AGP); bf16* RGP = (bf16*)(a.ws + WS_RGP);
    bf16* KGT = (bf16*)(a.ws + WS_KGT); bf16* BGT = (bf16*)(a.ws + WS_BGT); bf16* VTP = (bf16*)(a.ws + WS_VTP); float* GC = (float*)(a.ws + WS_GC);
    float* BONP = (float*)(a.ws + WS_BON);
    const int gsel = C.lane >> 5, tok = C.lane & 31;
    LAS unsigned short* tl = (LAS unsigned short*)(C.lds + 65536 + C.wave * 9216);
    LAS unsigned char* bkw = C.lds + (((C.wave >> 2) & 1) * 2 + gsel) * 2 * 8192;
    const int nwv = C.NGW & ~63, hq = C.gw & 63, q = hq & 3, h = hq >> 2;
    for (int un = C.gw; (un & ~7) < (NCK / 2) * 64 && C.gw < nwv; un += nwv) {
        const int pp = un >> 6;
        const int g = 2 * pp + gsel, t = 32 * g + tok;
        const int s = q >> 1, fqb = 2 * (q & 1), lcA = 32 * s + 4 * fqb, lcB = lcA + 16;
        const int chA = 64 * h + lcA, chB = 64 * h + lcB;
        int nb[4], nn; shift_rows(t, nb, nn);
        float onf[4], hasf[4]; int nrow[4];
#pragma unroll
        for (int j = 0; j < 4; ++j) { onf[j] = (j < nn) ? 1.0f : 0.0f; hasf[j] = (nb[j] >= 0) ? 1.0f : 0.0f; nrow[j] = nb[j] >= 0 ? nb[j] : t; }
        float r[16], k[16], v[16];
#pragma unroll
        for (int arr = 0; arr < 3; ++arr) {
#pragma unroll
            for (int run = 0; run < 2; ++run) {
                const int cc = 1024 * arr + (run ? chB : chA);
                float pc[8], u[8]; ld8(P + (size_t)t * PW + cc, pc);
#pragma unroll
                for (int i = 0; i < 8; ++i) u[i] = pc[i];
#pragma unroll
                for (int j = 0; j < 4; ++j) { float n8[8]; ld8(P + (size_t)nrow[j] * PW + cc, n8);
                    const CAS float* mu = (const CAS float*)a.in[I_MU] + ((size_t)l * 4 + j) * RWIN + cc;
#pragma unroll
                    for (int i = 0; i < 8; ++i) u[i] += onf[j] * mu[i] * (hasf[j] * n8[i] - pc[i]); }
#pragma unroll
                for (int i = 0; i < 8; ++i) { if (arr == 0) r[8 * run + i] = u[i]; else if (arr == 1) k[8 * run + i] = u[i]; else v[8 * run + i] = u[i]; }
            }
        }
        const float rn = __builtin_amdgcn_rcpf(fmaxf(__builtin_amdgcn_sqrtf(KNRM[(size_t)t * 16 + h]), 1e-12f));
        float kk[16];
#pragma unroll
        for (int i = 0; i < 16; ++i) kk[i] = k[i] * ((const CAS float*)a.in[I_KK])[l * 1024 + (i < 8 ? chA + i : chB + i - 8)] * rn;
#pragma unroll
        for (int d = 0; d < 2; ++d) {
            const int c = d == 0 ? g : (g < 8 ? 7 - g : (NCK + 7) - g);
            const int cs = (d * 16 + h) * NCK + c, ii = d ? 31 - tok : tok, pi = pos_i(ii);
            const bf16* lo = LO + (size_t)t * LNN + d * 1024;
            float bon = 0.f, gcv = 0.f;
            const size_t po = (size_t)cs * 2048 + ((ii >> 4) * 2 + s) * 512 + (ii & 15) * 8;
#pragma unroll
            for (int f = 0; f < 2; ++f) {
                float ag[8], rg[8], bg[8], kg[8], lwv[8], lav[8];
                { const v2u wa = *(const v2u*)(lo + chA + 4 * f), wb = *(const v2u*)(lo + chB + 4 * f), xa = *(const v2u*)(lo + 2048 + chA + 4 * f), xb = *(const v2u*)(lo + 2048 + chB + 4 * f);
                  lwv[0] = bf_lo(wa.x); lwv[1] = bf_hi(wa.x); lwv[2] = bf_lo(wa.y); lwv[3] = bf_hi(wa.y); lwv[4] = bf_lo(wb.x); lwv[5] = bf_hi(wb.x); lwv[6] = bf_lo(wb.y); lwv[7] = bf_hi(wb.y);
                  lav[0] = bf_lo(xa.x); lav[1] = bf_hi(xa.x); lav[2] = bf_lo(xa.y); lav[3] = bf_hi(xa.y); lav[4] = bf_lo(xb.x); lav[5] = bf_hi(xb.x); lav[6] = bf_lo(xb.y); lav[7] = bf_hi(xb.y); }
#pragma unroll
                for (int e = 0; e < 8; ++e) {
                    const int i = (e < 4) ? 4 * f + e : 8 + 4 * f + (e - 4);
                    const int ch = (i < 8 ? chA + i : chB + i - 8), lc = (i < 8 ? lcA + i : lcB + i - 8);
                    const float x = ((const CAS float*)a.in[I_W0])[(size_t)(l * 2 + d) * 1024 + ch] + lwv[e], z = -x;
                    const float sp = fmaxf(z, 0.f) + __logf(1.0f + __expf(-fabsf(z)));
                    const float lw = -__expf(-sp - 0.5f);
                    const float av = __builtin_amdgcn_rcpf(1.0f + __expf(-(((const CAS float*)a.in[I_A0])[(size_t)(l * 2 + d) * 1024 + ch] + lav[e])));
                    const float kd = k[i] * (1.0f + (av - 1.0f) * ((const CAS float*)a.in[I_KA])[l * 1024 + ch]), b = kk[i] * av;
                    float inc = seg_scan32(lw);
                    const float t31 = __builtin_bit_cast(float, __builtin_amdgcn_readlane(__builtin_bit_cast(int, inc), 31)), t63 = __builtin_bit_cast(float, __builtin_amdgcn_readlane(__builtin_bit_cast(int, inc), 63));
                    const float tot = gsel ? t63 : t31;
                    if (d) inc = tot - inc + lw;
                    gcv = (tok == i) ? tot : gcv;
                    const float gp = __expf(inc - lw), gt = __expf(inc), gi = __expf(-inc);
                    ag[e] = kk[i] * gp; rg[e] = r[i] * gt; bg[e] = b * gi; kg[e] = kd * gi;
                    bon += r[i] * kd * ((const CAS float*)a.in[I_RK])[l * 1024 + ch];
                    if (ST & 2) { const int to = i * 64 + 32 * gsel + pi; tl[to] = f2bf1(kg[e]); tl[1024 + to] = f2bf1(-bg[e]); tl[2048 + to] = f2bf1(v[i]); } else asm volatile("" :: "v"(kg[e]), "v"(bg[e]));
                }
                const size_t o = po + (size_t)(fqb + f) * 128;
                if (ST & 1) {
                *(v4u*)(AGP + o) = (v4u){pk2(ag[0], ag[1]), pk2(ag[2], ag[3]), pk2(ag[4], ag[5]), pk2(ag[6], ag[7])};
                *(v4u*)(RGP + o) = (v4u){pk2(rg[0], rg[1]), pk2(rg[2], rg[3]), pk2(rg[4], rg[5]), pk2(rg[6], rg[7])};
                { const int pfe = (int)(o - (size_t)cs * 2048);
                  *(LAS v4u*)(bkw + d * 8192 + pfe * 2) = (v4u){pk2(bg[0], bg[1]), pk2(bg[2], bg[3]), pk2(bg[4], bg[5]), pk2(bg[6], bg[7])};
                  *(LAS v4u*)(bkw + d * 8192 + 4096 + pfe * 2) = (v4u){pk2(kg[0], kg[1]), pk2(kg[2], kg[3]), pk2(kg[4], kg[5]), pk2(kg[6], kg[7])}; }
                } else asm volatile("" :: "v"(ag[0] + ag[1] + ag[2] + ag[3] + ag[4] + ag[5] + ag[6] + ag[7]), "v"(rg[0] + rg[1] + rg[2] + rg[3] + rg[4] + rg[5] + rg[6] + rg[7]));
            }
            if (ST & 2) {
                LDS_WAIT();
                const int kl = C.lane & 15, gs = (C.lane >> 4) & 1, op = C.lane >> 5, lcl = kl < 8 ? lcA + kl : lcB + kl - 8;
                const int gg = 2 * pp + gs, cg = d == 0 ? gg : (gg < 8 ? 7 - gg : (NCK + 7) - gg);
                const size_t ob = (size_t)((d * 16 + h) * NCK + cg) * 2048 + ((lcl >> 4) * 64 + (lcl & 15)) * 8;
#pragma unroll
                for (int oo = 0; oo < 2; ++oo) { const int o = 2 * op + oo; const int la = kl * 64 + 32 * gs + 8 * o;
                    *(v4u*)(KGT + ob + o * 128) = *(const LAS v4u*)(tl + la); *(v4u*)(BGT + ob + o * 128) = *(const LAS v4u*)(tl + 1024 + la); *(v4u*)(VTP + ob + o * 128) = *(const LAS v4u*)(tl + 2048 + la); }
                LDS_WAIT();
            }
            if (ST & 4) BONP[((size_t)(d * 16 + h) * 4 + q) * T + t] = bon; else asm volatile("" :: "v"(bon));
            if ((ST & 4) && tok < 16) GC[(size_t)cs * 64 + (tok < 8 ? lcA + tok : lcB + tok - 8)] = __expf(gcv);
        }
        asm volatile("s_waitcnt vmcnt(0)" ::: "memory");
        __syncthreads();
        { const int hh = (C.wave >> 2) & 1, gs2 = (C.wave >> 1) & 1, d2 = C.wave & 1;
          const int h2 = ((C.gw & ~7) & 63) / 4 + hh, g2 = 2 * pp + gs2, c2 = d2 == 0 ? g2 : (g2 < 8 ? 7 - g2 : (NCK + 7) - g2);
          rwkv_mats_unit(a, C, (d2 * 16 + h2) * NCK + c2, (LAS float*)(C.lds + 65536 + C.wave * 9216), C.lds + ((hh * 2 + gs2) * 2 + d2) * 8192); }
        __syncthreads();
    }
}

__device__ __forceinline__ void rwkv_mats_unit(const Args& a, const Ctx& C, int cs, LAS float* LA, const LAS unsigned char* bk) {
    const bf16* AGP = (const bf16*)(a.ws + WS_AGP); const bf16* RGP = (const bf16*)(a.ws + WS_RGP);
    bf16* TPm = (bf16*)(a.ws + WS_TP); bf16* AAK = (bf16*)(a.ws + WS_AAK); bf16* ARK = (bf16*)(a.ws + WS_ARK); bf16* ARB = (bf16*)(a.ws + WS_ARB);
    LAS float* LT = LA + 32 * 36;
    {
        int ln = C.lane; asm volatile("" : "+v"(ln));
        const int fr = ln & 15, fq = ln >> 4;
        const size_t o = (size_t)cs * 2048 + ln * 8;
        bf16x8 AG[2][2], RG[2][2], BG[2][2], KG[2][2];
#pragma unroll
        for (int tt = 0; tt < 2; ++tt)
#pragma unroll
            for (int s = 0; s < 2; ++s) { const size_t off = o + (tt * 2 + s) * 512;
                AG[tt][s] = *(const bf16x8*)(AGP + off); RG[tt][s] = *(const bf16x8*)(RGP + off);
                BG[tt][s] = *(const LAS bf16x8*)(bk + ((tt * 2 + s) * 512 + ln * 8) * 2); KG[tt][s] = *(const LAS bf16x8*)(bk + 4096 + ((tt * 2 + s) * 512 + ln * 8) * 2); }
#pragma unroll
        for (int tt = 0; tt < 2; ++tt) {
            f32x4 ab[2], ak[2], rk[2], rb[2];
#pragma unroll
            for (int it = 0; it < 2; ++it) {
                ab[it] = (f32x4){0.f, 0.f, 0.f, 0.f}; ak[it] = ab[it]; rk[it] = ab[it]; rb[it] = ab[it];
                if (it <= tt) {
#pragma unroll
                    for (int s = 0; s < 2; ++s) {
                        ab[it] = __builtin_amdgcn_mfma_f32_16x16x32_bf16(BG[it][s], AG[tt][s], ab[it], 0, 0, 0);
                        ak[it] = __builtin_amdgcn_mfma_f32_16x16x32_bf16(KG[it][s], AG[tt][s], ak[it], 0, 0, 0);
                        rk[it] = __builtin_amdgcn_mfma_f32_16x16x32_bf16(KG[it][s], RG[tt][s], rk[it], 0, 0, 0);
                        rb[it] = __builtin_amdgcn_mfma_f32_16x16x32_bf16(BG[it][s], RG[tt][s], rb[it], 0, 0, 0);
                    }
                    const int t = 16 * tt + fr;
#pragma unroll
                    for (int r = 0; r < 4; ++r) { const int i = 16 * it + 4 * fq + r;
                        if (i >= t) { ab[it][r] = 0.f; ak[it][r] = 0.f; }
                        if (i > t) { rk[it][r] = 0.f; rb[it][r] = 0.f; } }
                }
                *(LAS f32x4*)(LA + (16 * tt + fr) * 36 + 16 * it + 4 * fq) = ab[it];
            }
            if (tt == 0) { const size_t so = (size_t)cs * 1024 + ln * 4;
                *(v2u*)(AAK + so) = (v2u){pk2(ak[0][0], ak[0][1]), pk2(ak[0][2], ak[0][3])};
                *(v2u*)(ARK + so) = (v2u){pk2(rk[0][0], rk[0][1]), pk2(rk[0][2], rk[0][3])};
                *(v2u*)(ARB + so) = (v2u){pk2(-rb[0][0], -rb[0][1]), pk2(-rb[0][2], -rb[0][3])}; }
            else { const size_t so = (size_t)cs * 1024 + 256 + ln * 8;
                *(v4u*)(AAK + so) = (v4u){pk2(ak[0][0], ak[0][1]), pk2(ak[0][2], ak[0][3]), pk2(ak[1][0], ak[1][1]), pk2(ak[1][2], ak[1][3])};
                *(v4u*)(ARK + so) = (v4u){pk2(rk[0][0], rk[0][1]), pk2(rk[0][2], rk[0][3]), pk2(rk[1][0], rk[1][1]), pk2(rk[1][2], rk[1][3])};
                *(v4u*)(ARB + so) = (v4u){pk2(-rb[0][0], -rb[0][1]), pk2(-rb[0][2], -rb[0][3]), pk2(-rb[1][0], -rb[1][1]), pk2(-rb[1][2], -rb[1][3])}; }
        }
        LDS_WAIT();
        const int n = ln & 31;
        float x[32];
#pragma unroll
        for (int t = 0; t < 32; ++t) {
            float s = (t == n) ? 1.0f : 0.0f;
#pragma unroll
            for (int m = 0; m < (t + 3) / 4; ++m) { const f32x4 av = *(const LAS f32x4*)(LA + t * 36 + 4 * m);
                if (4 * m + 0 < t) s -= av.x * x[4 * m + 0];
                if (4 * m + 1 < t) s -= av.y * x[4 * m + 1];
                if (4 * m + 2 < t) s -= av.z * x[4 * m + 2];
                if (4 * m + 3 < t) s -= av.w * x[4 * m + 3]; }
            x[t] = s; LT[t * 36 + n] = s;
        }
        LDS_WAIT();
#pragma unroll
        for (int tt = 0; tt < 2; ++tt) { const LAS float* row = LT + (16 * tt + fr) * 36;
            const f32x4 lo = *(const LAS f32x4*)(row + 4 * fq), hi = *(const LAS f32x4*)(row + 16 + 4 * fq);
            if (tt == 0) *(v2u*)(TPm + (size_t)cs * 1024 + ln * 4) = (v2u){pk2(lo.x, lo.y), pk2(lo.z, lo.w)};
            else *(v4u*)(TPm + (size_t)cs * 1024 + 256 + ln * 8) = (v4u){pk2(lo.x, lo.y), pk2(lo.z, lo.w), pk2(hi.x, hi.y), pk2(hi.z, hi.w)}; }
        LDS_WAIT();
    }
}

__device__ __forceinline__ bf16x8 pack_acc2(const f32x4& lo, const f32x4& hi) {
    v4u w = {pk2(lo[0], lo[1]), pk2(lo[2], lo[3]), pk2(hi[0], hi[1]), pk2(hi[2], hi[3])};
    return __builtin_bit_cast(bf16x8, w);
}
struct SeqOpsA { bf16x8 AG[2][2], TPf[2], AK[2], KT[4], BT[4], VB; f32x4 GCv[4]; };
struct SeqOpsB { bf16x8 RG[2][2], RK[2], RB[2]; };
__device__ __forceinline__ void ph_rwkv_seq(const Args& a, const Ctx& C, int hd, int vs) {
    const int fq = C.lane >> 4;
    const bf16* AGP = (const bf16*)(a.ws + WS_AGP); const bf16* KGT = (const bf16*)(a.ws + WS_KGT); const bf16* BGT = (const bf16*)(a.ws + WS_BGT);
    const bf16* VTP = (const bf16*)(a.ws + WS_VTP); const float* GC = (const float*)(a.ws + WS_GC);
    const bf16* TPm = (const bf16*)(a.ws + WS_TP); const bf16* AAK = (const bf16*)(a.ws + WS_AAK);
    const size_t ol = (size_t)C.lane * 8;
#define SEQ_LD64(dst, base, cs_, tt, s) dst = *(const bf16x8*)((base) + (size_t)(cs_) * 2048 + ((tt) * 2 + (s)) * 512 + ol)
#define SEQ_LD32(dst, base, cs_, tt) do { if ((tt) == 0) { const v2u w_ = *(const v2u*)((base) + (size_t)(cs_) * 1024 + C.lane * 4); dst = __builtin_bit_cast(bf16x8, (v4u){w_.x, w_.y, 0u, 0u}); } \
        else dst = *(const bf16x8*)((base) + (size_t)(cs_) * 1024 + 256 + ol); } while (0)
#define SEQ_LDT(dst, base, cs_, mt) dst = *(const bf16x8*)((base) + (size_t)(cs_) * 2048 + (mt) * 512 + ol)
#define SEQA_LOAD1(O, cs_) do { _Pragma("unroll") for (int tt = 0; tt < 2; ++tt) { _Pragma("unroll") for (int s = 0; s < 2; ++s) SEQ_LD64(O.AG[tt][s], AGP, cs_, tt, s); SEQ_LD32(O.AK[tt], AAK, cs_, tt); } } while (0)
#define SEQA_LOAD2(O, cs_) do { _Pragma("unroll") for (int tt = 0; tt < 2; ++tt) SEQ_LD32(O.TPf[tt], TPm, cs_, tt); } while (0)
#define SEQA_LOAD3(O, cs_) do { _Pragma("unroll") for (int mt = 0; mt < 4; ++mt) { SEQ_LDT(O.KT[mt], KGT, cs_, mt); SEQ_LDT(O.BT[mt], BGT, cs_, mt); O.GCv[mt] = *(const f32x4*)(GC + (size_t)(cs_) * 64 + 16 * mt + 4 * fq); } SEQ_LDT(O.VB, VTP, cs_, vs); } while (0)
    const int cs0 = hd * NCK;
    SeqOpsA P0, P1;
    SEQA_LOAD1(P0, cs0); SEQA_LOAD2(P0, cs0); SEQA_LOAD3(P0, cs0);
    SEQA_LOAD1(P1, cs0 + 1); SEQA_LOAD2(P1, cs0 + 1); SEQA_LOAD3(P1, cs0 + 1);
    f32x4 Hc[4];
#pragma unroll
    for (int mt = 0; mt < 4; ++mt) Hc[mt] = (f32x4){0.f, 0.f, 0.f, 0.f};
    bf16x8 Hb[2]; Hb[0] = pack_acc2(Hc[0], Hc[1]); Hb[1] = pack_acc2(Hc[2], Hc[3]);
    volatile LAS int* prog = (volatile LAS int*)(C.lds + MISC_OFF + 64);
    volatile LAS int* fa = (volatile LAS int*)(C.lds + MISC_OFF + 68);
    volatile LAS int* fb = (volatile LAS int*)(C.lds + MISC_OFF + 72);
    LAS unsigned char* ring = C.lds;
#define SEQA_BODY(O, c) do { \
        if (C.lane == 0) *prog = (c); \
        const int cn = cs0 + ((c) + 2 < NCK ? (c) + 2 : NCK - 1); \
        LAS unsigned char* slot = ring + ((c) & 7) * 4096 + C.lane * 16; \
        if ((c) >= 8) { unsigned sp = 0; while (*fb < (c) - 7 && ++sp < (1u << 24)) __builtin_amdgcn_s_sleep(1); } \
        *(LAS bf16x8*)slot = Hb[0]; *(LAS bf16x8*)(slot + 1024) = Hb[1]; *(LAS bf16x8*)(slot + 3072) = O.VB; \
        f32x4 RH[2], U[2]; \
        _Pragma("unroll") for (int tt = 0; tt < 2; ++tt) { RH[tt] = (f32x4){0.f, 0.f, 0.f, 0.f}; \
            _Pragma("unroll") for (int s = 0; s < 2; ++s) RH[tt] = __builtin_amdgcn_mfma_f32_16x16x32_bf16(O.AG[tt][s], Hb[s], RH[tt], 0, 0, 0); \
            RH[tt] = __builtin_amdgcn_mfma_f32_16x16x32_bf16(O.AK[tt], O.VB, RH[tt], 0, 0, 0); } \
        SEQA_LOAD1(O, cn); \
        const bf16x8 RHb = pack_acc2(RH[0], RH[1]); \
        _Pragma("unroll") for (int tt = 0; tt < 2; ++tt) U[tt] = __builtin_amdgcn_mfma_f32_16x16x32_bf16(O.TPf[tt], RHb, (f32x4){0.f, 0.f, 0.f, 0.f}, 0, 0, 0); \
        SEQA_LOAD2(O, cn); \
        const bf16x8 Ub = pack_acc2(U[0], U[1]); \
        *(LAS bf16x8*)(slot + 2048) = Ub; \
        asm volatile("s_waitcnt lgkmcnt(0)" ::: "memory"); \
        if (C.lane == 0) *fa = (c) + 1; \
        _Pragma("unroll") for (int mt = 0; mt < 4; ++mt) { \
            Hc[mt] = __builtin_amdgcn_mfma_f32_16x16x32_bf16(O.KT[mt], O.VB, Hc[mt], 0, 0, 0); \
            Hc[mt] = __builtin_amdgcn_mfma_f32_16x16x32_bf16(O.BT[mt], Ub, Hc[mt], 0, 0, 0); \
            Hc[mt] = Hc[mt] * O.GCv[mt]; } \
        SEQA_LOAD3(O, cn); \
        Hb[0] = pack_acc2(Hc[0], Hc[1]); Hb[1] = pack_acc2(Hc[2], Hc[3]); } while (0)
    for (int c = 0; c < NCK; c += 2) { SEQA_BODY(P0, c); SEQA_BODY(P1, c + 1); }
    if (C.lane == 0) *prog = NCK + 64;
#undef SEQA_BODY
#undef SEQA_LOAD1
#undef SEQA_LOAD2
#undef SEQA_LOAD3
}
__device__ __forceinline__ void ph_rwkv_seq_y(const Args& a, const Ctx& C, int hd, int vs) {
    const int d = hd >> 4, h = hd & 15, fr = C.lane & 15, fq = C.lane >> 4;
    const bf16* RGP = (const bf16*)(a.ws + WS_RGP); const bf16* VTP = (const bf16*)(a.ws + WS_VTP); const bf16* ARK = (const bf16*)(a.ws + WS_ARK); const bf16* ARB = (const bf16*)(a.ws + WS_ARB);
    bf16* YF = (bf16*)(a.ws + WS_SY) + (size_t)d * T * 1024 + 64 * h + 16 * vs + 4 * fq;
    const size_t ol = (size_t)C.lane * 8;
    const int cs0 = hd * NCK;
#define SEQB_LOAD(O, cs_) do { _Pragma("unroll") for (int tt = 0; tt < 2; ++tt) { _Pragma("unroll") for (int s = 0; s < 2; ++s) SEQ_LD64(O.RG[tt][s], RGP, cs_, tt, s); SEQ_LD32(O.RK[tt], ARK, cs_, tt); SEQ_LD32(O.RB[tt], ARB, cs_, tt); } } while (0)
    SeqOpsB P0, P1;
    SEQB_LOAD(P0, cs0); SEQB_LOAD(P1, cs0 + 1);
    volatile LAS int* fa = (volatile LAS int*)(C.lds + MISC_OFF + 68);
    volatile LAS int* fb = (volatile LAS int*)(C.lds + MISC_OFF + 72);
    LAS unsigned char* ring = C.lds;
#define SEQB_BODY(O, c) do { \
        const int cn = cs0 + ((c) + 2 < NCK ? (c) + 2 : NCK - 1); \
        const int ystep = d ? -1 : 1, yrow0 = d ? ((c) < 8 ? TC - 1 : T + TC - 1) : 0; \
        { unsigned sp = 0; while (*fa <= (c) && ++sp < (1u << 24)) __builtin_amdgcn_s_sleep(1); } \
        asm volatile("" ::: "memory"); \
        const LAS unsigned char* slot = ring + ((c) & 7) * 4096 + C.lane * 16; \
        const bf16x8 H0 = *(const LAS bf16x8*)slot, H1 = *(const LAS bf16x8*)(slot + 1024), Ub = *(const LAS bf16x8*)(slot + 2048), VBs = *(const LAS bf16x8*)(slot + 3072); \
        asm volatile("s_waitcnt lgkmcnt(0)" ::: "memory"); \
        if (C.lane == 0) *fb = (c) + 1; \
        f32x4 Y[2];     \
        _Pragma("unroll") for (int tt = 0; tt < 2; ++tt) { Y[tt] = (f32x4){0.f, 0.f, 0.f, 0.f}; \
            Y[tt] = __builtin_amdgcn_mfma_f32_16x16x32_bf16(H0, O.RG[tt][0], Y[tt], 0, 0, 0); \
            Y[tt] = __builtin_amdgcn_mfma_f32_16x16x32_bf16(H1, O.RG[tt][1], Y[tt], 0, 0, 0); \
            Y[tt] = __builtin_amdgcn_mfma_f32_16x16x32_bf16(VBs, O.RK[tt], Y[tt], 0, 0, 0); \
            Y[tt] = __builtin_amdgcn_mfma_f32_16x16x32_bf16(Ub, O.RB[tt], Y[tt], 0, 0, 0); } \
        SEQB_LOAD(O, cn); \
        _Pragma("unroll") for (int tt = 0; tt < 2; ++tt) *(v2u*)(YF + (size_t)(unsigned)((yrow0 + ystep * (32 * (c) + 16 * tt + fr)) * 1024)) = (v2u){pk2(Y[tt][0], Y[tt][1]), pk2(Y[tt][2], Y[tt][3])}; } while (0)
    for (int c = 0; c < NCK; c += 2) { SEQB_BODY(P0, c); SEQB_BODY(P1, c + 1); }
#undef SEQB_BODY
#undef SEQB_LOAD
#undef SEQ_LD64
#undef SEQ_LD32
#undef SEQ_LDT
}
__device__ __forceinline__ void ph_rwkv_pref(const Args& a, const Ctx& C, int hd, int vs) {
    const unsigned char* ws = a.ws;
    volatile LAS int* prog = (volatile LAS int*)(C.lds + MISC_OFF + 64);
    const int cs0 = hd * NCK;
    constexpr int DEPTH = 12, INFL = 6;
    unsigned x[INFL][4];
#pragma unroll
    for (int i = 0; i < INFL; ++i)
#pragma unroll
        for (int k = 0; k < 4; ++k) x[i][k] = 0u;
#define PREF_ADDR(cs_, k) ({ const int L_ = 64 * (k) + C.lane; const size_t c2_ = (size_t)(cs_) * 4096, c1_ = (size_t)(cs_) * 2048; \
        (L_ < 32 ? ws + WS_AGP + c2_ + 128 * L_ : L_ < 64 ? ws + WS_GC + (size_t)(cs_) * 256   : L_ < 96 ? ws + WS_KGT + c2_ + 128 * (L_ - 64) : L_ < 128 ? ws + WS_BGT + c2_ + 128 * (L_ - 96) : \
         L_ < 160 ? ws + WS_VTP + c2_ + 128 * (L_ - 128) : L_ < 172 ? ws + WS_TP + c1_ + 128 * (L_ - 160) : L_ < 184 ? ws + WS_AAK + c1_ + 128 * (L_ - 172) : L_ < 208 ? ws + WS_GC + (size_t)(cs_) * 256 : \
         L_ >= 210 ? ws + WS_GC + (size_t)(cs_) * 256   : ws + WS_GC + (size_t)(cs_) * 256 + 128 * ((L_ - 224) & 1)); })
    for (int c0 = 2; c0 < NCK; c0 += INFL) {
#pragma unroll
        for (int i = 0; i < INFL; ++i) {
            const int c = c0 + i < NCK ? c0 + i : NCK - 1;
            unsigned spins = 0;
            while (c > *prog + DEPTH && ++spins < (1u << 22)) __builtin_amdgcn_s_sleep(8);
#pragma unroll
            for (int k = 0; k < 4; ++k) { asm volatile("" :: "v"(x[i][k])); x[i][k] = *(const unsigned*)PREF_ADDR(cs0 + c, k); }
        }
    }
#pragma unroll
    for (int i = 0; i < INFL; ++i)
#pragma unroll
        for (int k = 0; k < 4; ++k) asm volatile("" :: "v"(x[i][k]));
#undef PREF_ADDR
}

__device__ __forceinline__ void ph_rwkv_out(const Args& a, const Ctx& C, int l) {
    const bf16* SY = (const bf16*)(a.ws + WS_SY); const bf16* P = (const bf16*)(a.ws + WS_P); const float* mu = a.in[I_MU] + (size_t)l * 4 * RWIN; const float* BON = (const float*)(a.ws + WS_BON);
    const bf16* LO = (const bf16*)(a.ws + WS_LORA); bf16* YALL = (bf16*)(a.ws + WS_YALL);
    const int c0 = 16 * C.lane;
    for (int t = C.gw; t < T; t += C.NGW) {
        const size_t o = (size_t)t * 1024 + c0;
        float y[16], v[16]; float s = 0.f;
        { const v4u f0 = *(const v4u*)(SY + o), f1 = *(const v4u*)(SY + o + 8), b0 = *(const v4u*)(SY + (size_t)T * 1024 + o), b1 = *(const v4u*)(SY + (size_t)T * 1024 + o + 8);
          const unsigned ff[8] = {f0.x, f0.y, f0.z, f0.w, f1.x, f1.y, f1.z, f1.w}, bb[8] = {b0.x, b0.y, b0.z, b0.w, b1.x, b1.y, b1.z, b1.w};
#pragma unroll
          for (int i = 0; i < 8; ++i) { y[2 * i] = bf_lo(ff[i]) + bf_lo(bb[i]); y[2 * i + 1] = bf_hi(ff[i]) + bf_hi(bb[i]); } }
        { int nb[4], nn; shift_rows(t, nb, nn); float u[8];
          shift8(P, mu, t, 2048 + c0, nb, nn, u);
#pragma unroll
          for (int i = 0; i < 8; ++i) v[i] = u[i];
          shift8(P, mu, t, 2048 + c0 + 8, nb, nn, u);
#pragma unroll
          for (int i = 0; i < 8; ++i) v[8 + i] = u[i]; }
#pragma unroll
        for (int i = 0; i < 16; ++i) s += y[i];
        const float mean = quadsum(s) * (1.0f / 64.0f); float q = 0.f;
#pragma unroll
        for (int i = 0; i < 16; ++i) { y[i] -= mean; q += y[i] * y[i]; }
        const float rstd = rsqrtf(quadsum(q) * (1.0f / 64.0f) + 64e-5f);
        float bon = 0.f;
#pragma unroll
        for (int j = 0; j < 8; ++j) bon += BON[((size_t)((j >> 2) * 16 + (C.lane >> 2)) * 4 + (j & 3)) * T + t];
        const bf16* gp = LO + (size_t)t * LNN + 4096 + c0; const v4u g0 = *(const v4u*)gp, g1 = *(const v4u*)(gp + 8);
        const unsigned gg[8] = {g0.x, g0.y, g0.z, g0.w, g1.x, g1.y, g1.z, g1.w};
        float out[16];
#pragma unroll
        for (int i = 0; i < 16; ++i) { const float g = (i & 1) ? bf_hi(gg[i >> 1]) : bf_lo(gg[i >> 1]);
            out[i] = (y[i] * rstd * a.in[I_LNW][l * 1024 + c0 + i] + a.in[I_LNB][l * 1024 + c0 + i] + bon * v[i]) * g; }
        bf16* yo = YALL + (size_t)t * D + c0;
        *(v4u*)yo = (v4u){pk2(out[0], out[1]), pk2(out[2], out[3]), pk2(out[4], out[5]), pk2(out[6], out[7])};
        *(v4u*)(yo + 8) = (v4u){pk2(out[8], out[9]), pk2(out[10], out[11]), pk2(out[12], out[13]), pk2(out[14], out[15])};
    }
}

__device__ __forceinline__ void ph_norm2_route(const Args& a, const Ctx& C, int l, int cslot) {
    const bf16* X = (const bf16*)(a.ws + WS_X); bf16* H = (bf16*)(a.ws + WS_H);
    const float* modf = (const float*)(a.ws + WS_MOD);
    constexpr int TPH = 2056;
    LAS unsigned short* TH = (LAS unsigned short*)C.lds; LAS unsigned short* TLo = TH + 16 * TPH;
    LAS float* PART = (LAS float*)(C.lds + 2 * 16 * TPH * 2);
    LAS float* SC = PART + 8 * 16 * 32;
    int* RE = (int*)(a.ws + WS_RE); float* RWT = (float*)(a.ws + WS_RWT); int* RI = (int*)(a.ws + WS_RI); int* SLOT = (int*)(a.ws + WS_XB);
    unsigned* cnt = (unsigned*)(a.ws + WS_CTL) + CW_CNT + 64 * cslot;
    const bf16* RT = (const bf16*)(a.ws + WS_RT);
    const int fr = C.lane & 15, fq = C.lane >> 4;
    for (int tl = C.bx; tl < T / 16; tl += C.G) {
#pragma unroll
        for (int rr = 0; rr < 2; ++rr) {
            const int r = 16 * tl + 2 * C.wave + rr; const int wh = r < TC ? 1 : 0;
            const bf16* xr = X + (size_t)r * D; const float* md = modf + (size_t)(l * 2 + wh) * 12288;
            f32x4 v[8]; float ss = 0.f;
#pragma unroll
            for (int j = 0; j < 8; ++j) { const v2u xw = *(const v2u*)(xr + 4 * C.lane + 256 * j); v[j] = (f32x4){bf_lo(xw.x), bf_hi(xw.x), bf_lo(xw.y), bf_hi(xw.y)}; ss += v[j].x * v[j].x + v[j].y * v[j].y + v[j].z * v[j].z + v[j].w * v[j].w; }
            const float rstd = rsqrtf(wave_sum(ss) * (1.0f / D) + 1e-6f);
#pragma unroll
            for (int j = 0; j < 8; ++j) { const int k = 4 * C.lane + 256 * j;
                const f32x4 g = *(const f32x4*)(a.in[I_N2G] + l * D + k), sc = *(const f32x4*)(md + 4 * D + k), sh = *(const f32x4*)(md + 3 * D + k);
                const f32x4 h = v[j] * rstd * (g * (1.0f + sc)) + sh;
                const unsigned p0 = pk2(h.x, h.y), p1 = pk2(h.z, h.w);
                const float l0 = h.x - bf_lo(p0), l1 = h.y - bf_hi(p0), l2 = h.z - bf_lo(p1), l3 = h.w - bf_hi(p1);
                *(LAS v2u*)(TH + (2 * C.wave + rr) * TPH + k) = (v2u){p0, p1};
                *(LAS v2u*)(TLo + (2 * C.wave + rr) * TPH + k) = (v2u){pk2(l0, l1), pk2(l2, l3)};
                *(v2u*)(H + (size_t)r * D + k) = (v2u){p0, p1}; }
        }
        __syncthreads();
        { f32x4 acc[2] = {{0.f, 0.f, 0.f, 0.f}, {0.f, 0.f, 0.f, 0.f}};
#pragma unroll
          for (int s = 0; s < 8; ++s) { const int k = 256 * C.wave + 32 * s + 8 * fq;
              const bf16x8 ah = *(const LAS bf16x8*)(TH + fr * TPH + k), al = *(const LAS bf16x8*)(TLo + fr * TPH + k);
#pragma unroll
              for (int hf = 0; hf < 2; ++hf) { const bf16* rp = RT + (size_t)(16 * hf + fr) * 2048 + k;
                  const bf16x8 bh = *(const bf16x8*)rp, bl = *(const bf16x8*)(rp + 32 * 2048);
                  acc[hf] = __builtin_amdgcn_mfma_f32_16x16x32_bf16(ah, bh, acc[hf], 0, 0, 0);
                  acc[hf] = __builtin_amdgcn_mfma_f32_16x16x32_bf16(ah, bl, acc[hf], 0, 0, 0);
                  acc[hf] = __builtin_amdgcn_mfma_f32_16x16x32_bf16(al, bh, acc[hf], 0, 0, 0); } }
#pragma unroll
          for (int hf = 0; hf < 2; ++hf)
#pragma unroll
              for (int r = 0; r < 4; ++r) PART[(C.wave * 16 + 4 * fq + r) * 32 + 16 * hf + fr] = acc[hf][r]; }
        __syncthreads();
        { const int row = C.tid >> 5, e = C.tid & 31; float lg = 0.f;
#pragma unroll
          for (int w = 0; w < 8; ++w) lg += PART[(w * 16 + row) * 32 + e];
          const float sc = 1.0f / (1.0f + expf(-lg)); SC[row * 32 + e] = sc; SC[512 + row * 32 + e] = sc + a.in[I_RTB][e]; }
        __syncthreads();
        if (C.tid < 16) { const int row = C.tid, t = 16 * tl + row; const LAS float* bi = SC + 512 + row * 32; const LAS float* sc = SC + row * 32;
            int bg = 0; float bgs = -1e30f;
            for (int g = 0; g < 4; ++g) { float m1 = -1e30f, m2 = -1e30f;
                for (int j = 0; j < 8; ++j) { const float x = bi[8 * g + j]; if (x > m1) { m2 = m1; m1 = x; } else if (x > m2) m2 = x; }
                const float gs = m1 + m2; if (gs > bgs) { bgs = gs; bg = g; } }
            int i1 = 0; float v1 = -1e30f;
            for (int j = 0; j < 8; ++j) { const float x = bi[8 * bg + j]; if (x > v1) { v1 = x; i1 = j; } }
            int i2 = 0; float v2 = -1e30f;
            for (int j = 0; j < 8; ++j) { if (j == i1) continue; const float x = bi[8 * bg + j]; if (x > v2) { v2 = x; i2 = j; } }
            const int e1 = 8 * bg + i1, e2 = 8 * bg + i2; const float w1 = sc[e1], w2 = sc[e2], ws = w1 + w2;
            RE[2 * t] = e1; RE[2 * t + 1] = e2; RWT[2 * t] = w1 / ws; RWT[2 * t + 1] = w2 / ws;
            const int x1 = (int)atomicAdd(cnt + e1, 1u), x2 = (int)atomicAdd(cnt + e2, 1u);
            RI[2 * t] = x1; RI[2 * t + 1] = x2; SLOT[(size_t)e1 * T + x1] = t; SLOT[(size_t)e2 * T + x2] = t; }
        __syncthreads();
    }
}

__device__ __forceinline__ void moe_tables(const Args& a, const Ctx& C, int l) {
    LAS int* pst = (LAS int*)(C.lds + EXTRA_OFF);
    unsigned* cnt = (unsigned*)(a.ws + WS_CTL) + CW_CNT + 64 * l;
    if (C.tid < 64) {
        const int c = C.lane < NE ? (int)__hip_atomic_load(cnt + C.lane, __ATOMIC_RELAXED, __HIP_MEMORY_SCOPE_AGENT) : 0;
        const int pad = ((c + 255) >> 8) << 8; int inc = pad;
#pragma unroll
        for (int o = 1; o < 32; o <<= 1) { const int t = __shfl_up(inc, o); if (C.lane >= o) inc += t; }
        const int st = inc - pad;
        if (C.lane < NE) { pst[C.lane] = st; pst[64 + C.lane] = c; if (C.lane == NE - 1) { pst[NE] = inc; pst[127] = inc >> 8; }
            for (int i = 0; i < (pad >> 8); ++i) pst[128 + (st >> 8) + i] = C.lane; }
    }
    __syncthreads();
}

__device__ __forceinline__ void ph_combine(const Args& a, const Ctx& C, int l) {
    const bf16* X = (const bf16*)(a.ws + WS_X); bf16* XN = (bf16*)(a.ws + WS_XN); const bf16* YB = (const bf16*)(a.ws + WS_YB);
    const int* RE = (const int*)(a.ws + WS_RE); const int* RI = (const int*)(a.ws + WS_RI); const float* RWT = (const float*)(a.ws + WS_RWT);
    moe_tables(a, C, l); LAS const int* pst = (LAS const int*)(C.lds + EXTRA_OFF);
    const float* modf = (const float*)(a.ws + WS_MOD);
    for (int r = C.gw; r < T; r += C.NGW) {
        const int wh = r < TC ? 1 : 0; const float* gt = modf + (size_t)(l * 2 + wh) * 12288 + 5 * D;
        const int d0 = pst[RE[2 * r]] + RI[2 * r], d1 = pst[RE[2 * r + 1]] + RI[2 * r + 1]; const float w0 = RWT[2 * r], w1 = RWT[2 * r + 1];
        const bf16* xr = X + (size_t)r * D; bf16* xo = XN + (size_t)r * D; const bf16* y0 = YB + (size_t)d0 * D; const bf16* y1 = YB + (size_t)d1 * D;
        f32x4 v[8]; float ss = 0.f;
#pragma unroll
        for (int j = 0; j < 8; ++j) { const int k = 4 * C.lane + 256 * j;
            const v2u xw = *(const v2u*)(xr + k); const f32x4 x = {bf_lo(xw.x), bf_hi(xw.x), bf_lo(xw.y), bf_hi(xw.y)}, g = *(const f32x4*)(gt + k); const v2u p0 = *(const v2u*)(y0 + k), p1 = *(const v2u*)(y1 + k);
            f32x4 f; f.x = w0 * bf_lo(p0.x) + w1 * bf_lo(p1.x); f.y = w0 * bf_hi(p0.x) + w1 * bf_hi(p1.x); f.z = w0 * bf_lo(p0.y) + w1 * bf_lo(p1.y); f.w = w0 * bf_hi(p0.y) + w1 * bf_hi(p1.y);
            v[j] = x + g * f; ss += v[j].x * v[j].x + v[j].y * v[j].y + v[j].z * v[j].z + v[j].w * v[j].w; }
        if (l == NL - 1) {
            if (r >= TC) { const float rstd = rsqrtf(wave_sum(ss) * (1.0f / D) + 1e-6f); float* orow = a.out + (size_t)(r - TC) * D;
#pragma unroll
                for (int j = 0; j < 8; ++j) { const int k = 4 * C.lane + 256 * j; const f32x4 g = *(const f32x4*)(a.in[I_FG] + k); *(f32x4*)(orow + k) = v[j] * rstd * g; } }
        } else {
            const float rstd = rsqrtf(wave_sum(ss) * (1.0f / D) + 1e-6f);
            const float* mdn = modf + (size_t)((l + 1) * 2 + wh) * 12288; bf16* H = (bf16*)(a.ws + WS_H);
#pragma unroll
            for (int j = 0; j < 8; ++j) { const int k = 4 * C.lane + 256 * j;
                *(v2u*)(xo + k) = (v2u){pk2(v[j].x, v[j].y), pk2(v[j].z, v[j].w)};
                const f32x4 g = *(const f32x4*)(a.in[I_N1G] + (l + 1) * D + k), sc = *(const f32x4*)(mdn + D + k), sh = *(const f32x4*)(mdn + k);
                const f32x4 h = v[j] * rstd * (g * (1.0f + sc)) + sh;
                *(v2u*)(H + (size_t)r * D + k) = (v2u){pk2(h.x, h.y), pk2(h.z, h.w)}; }
        }
    }
}

__device__ __forceinline__ Ctx fresh_ctx(const Ctx& C0) {
    Ctx C = C0; int t = C0.tid; asm volatile("" : "+v"(t)); C.tid = t; C.lane = t & 63; C.wave = __builtin_amdgcn_readfirstlane(t >> 6); C.gw = C.bx * NWAVES + C.wave; return C; }
__device__ __forceinline__ int opaque_two() { int n = 2; asm volatile("" : "+s"(n)); return n; }
constexpr int PH_PER_LAYER = 14, N_PHASES = 1 + NL * PH_PER_LAYER;
#ifndef PH_MASK
#define PH_MASK 0xffffffffu
#endif
#define PHM(j) (((PH_MASK) >> (j)) & 1u)
#ifndef GEMM_SP2
#define GEMM_SP2 true
#endif
#ifndef REP_PHASE
#define REP_PHASE (-1)
#endif
#define REPLOOP(j, l) _Pragma("nounroll") for (int rep_ = 0, nrep_ = ((REP_PHASE) == (j) && (l) == 0) ? opaque_two() : 1; rep_ < nrep_; ++rep_)
#define IN(k) (lo <= (k) && (k) < hi)
#define SEAM(k) do { if (IN(k) && IN((k) + 1)) xcd_barrier(bar); } while (0)


template <int l> __device__ __forceinline__ void layer_body(const Args& args, const Ctx& C, const XcdBarrier& bar, const int lo, const int hi, const bool multi) {
    unsigned char* ws = args.ws;
        const int pb = 1 + l * PH_PER_LAYER;
        if (l == 0) {
            if (PHM(0) && IN(pb + 0)) REPLOOP(0, l) ph_norm1(args, fresh_ctx(C), l);
            SEAM(pb + 0);
        }
        if (PHM(1) && IN(pb + 1)) {
            pg8::Gemm g{(const bf16*)(ws + WS_H), (const bf16*)(ws + WS_WIN) + (size_t)l * PW * D, T, PW, D};
            pg8::StaticOrder S; S.init(T, PW, C.G, C.bx);
            pg8::EpiStoreBf16 E{(bf16*)(ws + WS_P), PW, 0x7fffffff};
            pg8::gemm_phase<pg8::EpiStoreBf16, pg8::StaticOrder, true, GEMM_SP2>(C.lds, g, S, E);
        }
        SEAM(pb + 1);
        if (PHM(2) && IN(pb + 2)) REPLOOP(2, l) ph_prep(args, fresh_ctx(C), l);
        SEAM(pb + 2);
        if (PHM(3) && IN(pb + 3)) {
            pg8::Gemm g{(const bf16*)(ws + WS_LA), (const bf16*)(ws + WS_LB) + (size_t)l * LNN * LK, T, LNN, LK};
            pg8::StaticOrder S; S.init(T, LNN, C.G, C.bx);
            pg8::EpiStoreBf16 E{(bf16*)(ws + WS_LORA), LNN, 0x7fffffff};
            pg8::gemm_phase<pg8::EpiStoreBf16, pg8::StaticOrder, true, GEMM_SP2>(C.lds, g, S, E);
        }
        SEAM(pb + 3);
        if (PHM(4) && IN(pb + 4)) { REPLOOP(4, l) ph_rwkv_prep<7>(args, fresh_ctx(C), l); if ((REP_PHASE) >= 420 && (REP_PHASE) < 428 && l == 0) ph_rwkv_prep<((REP_PHASE) >= 420 && (REP_PHASE) < 428) ? (REP_PHASE) - 420 : 0>(args, fresh_ctx(C), l); REPLOOP(41, l) ph_ret_prefix(args, fresh_ctx(C), l); }
        SEAM(pb + 4);
        if (PHM(6) && IN(pb + 6)) {
            const int nsq = C.G >= 128 ? 128 : 0;
            if (nsq == 0) { for (int b = C.bx; b < 128; b += C.G) { if (C.wave == 0) ph_rwkv_seq(args, fresh_ctx(C), b >> 2, b & 3); else if (C.wave == 2) ph_rwkv_seq_y(args, fresh_ctx(C), b >> 2, b & 3);
                    __syncthreads(); if (C.tid == 0) { volatile LAS int* w = (volatile LAS int*)(C.lds + MISC_OFF + 64); w[0] = 0; w[1] = 0; w[2] = 0; } __syncthreads(); } ph_ret_out(args, fresh_ctx(C), l, C.bx, C.G); ph_convert_moe(args, fresh_ctx(C), l, C.gw, C.NGW, (LAS float*)(C.lds + 79872 + (C.wave & 7) * 8704)); }
            else if (C.bx < nsq && C.wave == 0) { const int xi = C.bx >> 3;
                ph_rwkv_seq(args, fresh_ctx(C), (C.bx & 7) * 4 + (xi >> 2), xi & 3); }
            else if (C.bx < nsq && C.wave == 1) { const int xi = C.bx >> 3; ph_rwkv_pref(args, fresh_ctx(C), (C.bx & 7) * 4 + (xi >> 2), xi & 3); }
            else if (C.bx < nsq && C.wave == 2) { const int xi = C.bx >> 3; ph_rwkv_seq_y(args, fresh_ctx(C), (C.bx & 7) * 4 + (xi >> 2), xi & 3); }
            else if (C.bx >= nsq) { const int wid = (C.bx - nsq) * 8 + C.wave; const int nwk = (C.G - nsq) * 8;     REPLOOP(62, l) ph_ret_out(args, fresh_ctx(C), l, C.bx - nsq, C.G - nsq);
                   REPLOOP(63, l) ph_convert_moe(args, fresh_ctx(C), l, wid, nwk, (LAS float*)(C.lds + 79872 + (C.wave & 7) * 8704)); }
        }
        SEAM(pb + 6);
        if (IN(pb + 6) && C.tid == 0) { volatile LAS int* w = (volatile LAS int*)(C.lds + MISC_OFF + 64); w[0] = 0; w[1] = 0; w[2] = 0; }
        if (PHM(7) && IN(pb + 7)) REPLOOP(7, l) ph_rwkv_out(args, fresh_ctx(C), l);
        SEAM(pb + 7);
        if (PHM(8) && IN(pb + 8)) REPLOOP(8, l) {
            constexpr int roff = (l == NL - 1) ? TC : 0;
            pg8::Gemm g{(const bf16*)(ws + WS_YALL) + (size_t)roff * D, (const bf16*)(ws + WS_WOUT) + (size_t)l * D * D, T - roff, D, D};
            pg8::StaticOrder S; S.init(T - roff, D, C.G, C.bx);
            const float* modf = (const float*)(ws + WS_MOD);
            bf16* X = (bf16*)(ws + WS_X); const bf16* XNp = (const bf16*)(ws + WS_XN);
            if constexpr (l == 0) { pg8::EpiResid<false> E{args.in[I_CTX], args.in[I_X], modf + (size_t)(l * 2 + 1) * 12288 + 2 * D, modf + (size_t)(l * 2 + 0) * 12288 + 2 * D, X, D, roff / 256};
                pg8::gemm_phase<pg8::EpiResid<false>, pg8::StaticOrder, true, GEMM_SP2>(C.lds, g, S, E); }
            else { pg8::EpiResid<true> E{XNp, XNp + (size_t)TC * D, modf + (size_t)(l * 2 + 1) * 12288 + 2 * D, modf + (size_t)(l * 2 + 0) * 12288 + 2 * D, X, D, roff / 256};
                pg8::gemm_phase<pg8::EpiResid<true>, pg8::StaticOrder, true, GEMM_SP2>(C.lds, g, S, E); }
        }
        SEAM(pb + 8);
        if (PHM(9) && IN(pb + 9)) REPLOOP(9, l) ph_norm2_route(args, fresh_ctx(C), l, l + 2 * rep_);
        SEAM(pb + 9);
        if (PHM(11) && IN(pb + 11)) REPLOOP(11, l) {
            moe_tables(args, fresh_ctx(C), l); LAS const int* tb = (LAS const int*)(C.lds + EXTRA_OFF);
            pg8::Gemm g{(const bf16*)(ws + WS_H), (const bf16*)(ws + WS_W1) + (size_t)l * NE * 2048 * 2048, MPAD, NE * 2048, D};
            pg8::MoeGatherOrder S{tb[127] * 8, C.G, C.bx, tb, (const int*)(ws + WS_XB), T};
            pg8::EpiSwiGLU E{(bf16*)(ws + WS_ACT), 1024};
            pg8::gemm_phase<pg8::EpiSwiGLU, pg8::MoeGatherOrder, true, GEMM_SP2, true>(C.lds, g, S, E);
        }
        SEAM(pb + 11);
        if (PHM(12) && IN(pb + 12)) REPLOOP(12, l) {
            moe_tables(args, fresh_ctx(C), l); LAS const int* tb = (LAS const int*)(C.lds + EXTRA_OFF);
            pg8::Gemm g{(const bf16*)(ws + WS_ACT), (const bf16*)(ws + WS_W2) + (size_t)l * NE * 2048 * 1024, MPAD, NE * 2048, 1024};
            pg8::MoeOrder S{tb[127] * 8, C.G, C.bx, tb};
            pg8::EpiStoreBf16 E{(bf16*)(ws + WS_YB), D, 7};
            pg8::gemm_phase<pg8::EpiStoreBf16, pg8::MoeOrder, true, GEMM_SP2>(C.lds, g, S, E);
        }
        SEAM(pb + 12);
        if (PHM(13) && IN(pb + 13)) REPLOOP(13, l) ph_combine(args, fresh_ctx(C), l);
        SEAM(pb + 13);
        if ((REP_PHASE) == 77 && l == 0 && multi) { _Pragma("nounroll") for (int i_ = 0, n_ = 5 * opaque_two(); i_ < n_; ++i_) xcd_barrier(bar); }
    }
__global__ void __launch_bounds__(NTHR, 2) fwd_kernel(Args args) {
    extern __shared__ __attribute__((aligned(16))) unsigned char lds_raw[];
    Ctx C; C.lds = (LAS unsigned char*)lds_raw;
    C.tid = threadIdx.x; C.lane = C.tid & 63; C.wave = __builtin_amdgcn_readfirstlane(C.tid >> 6);
    C.G = gridDim.x; C.bx = blockIdx.x; C.gw = C.bx * NWAVES + C.wave; C.NGW = C.G * NWAVES;
    volatile LAS unsigned* MISC = (volatile LAS unsigned*)(C.lds + MISC_OFF);
    if (C.tid < 64) MISC[C.tid] = 0u;
    __syncthreads();
    unsigned char* ws = args.ws;
    XcdBarrier bar; bar.bar = (unsigned*)(ws + WS_CTL) + CW_BAR; bar.x = 0; bar.st = nullptr;
    const bool multi = (args.ph_hi - args.ph_lo) > 1;
    if (multi) bar = xcd_barrier_post((unsigned*)(ws + WS_CTL) + CW_BAR, MISC + 8);
    const int lo = args.ph_lo, hi = args.ph_hi;
    if (PHM(15) && IN(0)) { REPLOOP(15, 0) ph_prologue(args, fresh_ctx(C)); }
    SEAM(0);
    layer_body<0>(args, C, bar, lo, hi, multi);
    layer_body<1>(args, C, bar, lo, hi, multi);
#undef IN
#undef SEAM
}

extern "C" void kernel_launch(void* const* d_in, const int* in_sizes, int n_in, void* d_out, int out_size, void* d_ws, size_t ws_size, hipStream_t stream) {
    static int grid = 0;
    if (grid == 0) {
        if (n_in != 28 || out_size != TL * D || ws_size < WS_END) { fprintf(stderr, "kernel_launch: unexpected shapes (n_in %d out %d ws %zu need %zu)\n", n_in, out_size, ws_size, (size_t)WS_END); grid = -1; return; }
        int dev = 0, cus = 0, per_cu = 0;
        if (hipGetDevice(&dev) != hipSuccess || hipDeviceGetAttribute(&cus, hipDeviceAttributeMultiprocessorCount, dev) != hipSuccess) { grid = -1; return; }
        if (hipFuncSetAttribute((const void*)fwd_kernel, hipFuncAttributeMaxDynamicSharedMemorySize, LDS_BYTES) != hipSuccess) { fprintf(stderr, "kernel_launch: hipFuncSetAttribute failed\n"); grid = -1; return; }
        if (hipOccupancyMaxActiveBlocksPerMultiprocessor(&per_cu, (const void*)fwd_kernel, NTHR, LDS_BYTES) != hipSuccess || per_cu < 1) { fprintf(stderr, "kernel_launch: occupancy query says %d\n", per_cu); }
        (void)hipGetLastError();
        grid = cus;
    }
    if (grid < 0) return;
    if (hipMemsetAsync((char*)d_ws + WS_CTL, 0, CTL_BYTES, stream) != hipSuccess) return;
    Args a{};
    for (int i = 0; i < 28; ++i) a.in[i] = (const float*)d_in[i];
    a.out = (float*)d_out; a.ws = (unsigned char*)d_ws;
#if MK_N_LAUNCHES == 1
    a.ph_lo = 0; a.ph_hi = N_PHASES;
    hipLaunchKernelGGL(fwd_kernel, dim3(grid), dim3(NTHR), LDS_BYTES, stream, a);
#else
    for (int p = 0; p < N_PHASES; ++p) { a.ph_lo = p; a.ph_hi = p + 1; hipLaunchKernelGGL(fwd_kernel, dim3(grid), dim3(NTHR), LDS_BYTES, stream, a); }
#endif
}
```

```cpp
#include <hip/hip_runtime.h>
#include <cstdio>
#include <cstdint>
namespace pg8 {
#define PG8_LAS __attribute__((address_space(3)))
typedef unsigned short bf16_t;
typedef short bf16x8 __attribute__((ext_vector_type(8)));
typedef float f32x4 __attribute__((ext_vector_type(4)));
typedef unsigned u32x4 __attribute__((ext_vector_type(4)));
constexpr int BM = 256, BK = 64, HALF = 128, HTB = HALF * BK * 2  , STAGE_BYTES = 8 * HTB, NXCD = 8, WGM = 8;

__host__ __device__ __forceinline__ int lds_byte(int r, int c) { const int st = (r >> 4) * 2 + (c >> 5), rr = r & 15, cc = c & 31, ob = rr * 64 + cc * 2; return st * 1024 + (ob ^ (((ob >> 9) & 1) << 5)); }
__host__ __device__ __forceinline__ void stage_rc(int b, int& R, int& C) { const int st = b / 1024, sb = b % 1024, swz = sb ^ (((sb >> 9) & 1) << 5); R = (st >> 1) * 16 + swz / 64; C = (st & 1) * 32 + (swz % 64) / 2; }
__host__ __device__ __forceinline__ int perm32(int rho) { const int n = rho >> 4, i = rho & 15; return 8 * (i >> 2) + 4 * n + (i & 3); }

struct Unit { int pm, pn, aux; };
struct Gemm { const bf16_t* A; const bf16_t* Bt; int M, N, K; };

struct StaticOrder {
    int nM, nN, nwg, G, c;
    __host__ __device__ void init(int M, int N, int G_, int c_) { nM = M / BM; nN = N / BM; nwg = nM * nN; G = G_; c = c_; }
    __host__ __device__ bool next(int i, Unit& u) const {
        const long L = (long)i * G + c; if (L >= nwg) return false;
        int wgid = (int)L; { const int q = nwg / NXCD, r = nwg % NXCD, xcd = wgid % NXCD, off = wgid / NXCD; wgid = (xcd < r ? xcd * (q + 1) : r * (q + 1) + (xcd - r) * q) + off; }
        const int nig = WGM * nN, gid = wgid / nig, fm = gid * WGM, gsz = (nM - fm) < WGM ? (nM - fm) : WGM;
        u.pm = fm + ((wgid % nig) % gsz); u.pn = (wgid % nig) / gsz; return true;
    }
    __device__ __forceinline__ void a_ready(const Unit&) const {}
    __device__ __forceinline__ void done(const Unit&) const {}
};

typedef float f32x2c __attribute__((ext_vector_type(2))); typedef __bf16 bf16x2c __attribute__((ext_vector_type(2)));
__device__ __forceinline__ unsigned cvt_pk_bf16(float lo, float hi) { const f32x2c v = {lo, hi}; return __builtin_bit_cast(unsigned, __builtin_convertvector(v, bf16x2c)); }
typedef float f32x2 __attribute__((ext_vector_type(2)));


struct EpiStoreBf16 {
    static constexpr bool PERM = true, AFTER_DRAIN = false;
    bf16_t* O; int ldc; int pn_mask;
    __device__ __forceinline__ void operator()(const f32x4 (&acc)[2][2][4][2], const Unit& u, int wr, int wc, int fr, int fq) const {
        const int row0 = u.pm * BM + wr * 64 + fr; const int col0 = (u.pn & pn_mask) * BM + wc * 32 + 8 * fq;
#pragma unroll
        for (int ai = 0; ai < 2; ++ai)
#pragma unroll
            for (int m = 0; m < 4; ++m) { bf16_t* rowp = O + (size_t)(row0 + ai * HALF + m * 16) * ldc + col0;
#pragma unroll
                for (int bj = 0; bj < 2; ++bj) { const f32x4 v0 = acc[ai][bj][m][0], v1 = acc[ai][bj][m][1];
                    u32x4 w; w.x = cvt_pk_bf16(v0[0], v0[1]); w.y = cvt_pk_bf16(v0[2], v0[3]); w.z = cvt_pk_bf16(v1[0], v1[1]); w.w = cvt_pk_bf16(v1[2], v1[3]);
                    *(u32x4*)(rowp + bj * HALF) = w; } }
    }
};
struct EpiSwiGLU {
    static constexpr bool PERM = true, AFTER_DRAIN = false;
    bf16_t* O; int ldc;
    __device__ __forceinline__ void operator()(const f32x4 (&acc)[2][2][4][2], const Unit& u, int wr, int wc, int fr, int fq) const {
        const int row0 = u.pm * BM + wr * 64 + fr; const int col0 = (u.pn & 7) * HALF + wc * 32 + 8 * fq;
#pragma unroll
        for (int ai = 0; ai < 2; ++ai)
#pragma unroll
            for (int m = 0; m < 4; ++m) { bf16_t* rowp = O + (size_t)(row0 + ai * HALF + m * 16) * ldc + col0;
                float r[8];
#pragma unroll
                for (int n = 0; n < 2; ++n)
#pragma unroll
                    for (int j = 0; j < 4; ++j) { const float g = acc[ai][0][m][n][j], up = acc[ai][1][m][n][j]; r[n * 4 + j] = g * up / (1.0f + __expf(-g)); }
                u32x4 w; w.x = cvt_pk_bf16(r[0], r[1]); w.y = cvt_pk_bf16(r[2], r[3]); w.z = cvt_pk_bf16(r[4], r[5]); w.w = cvt_pk_bf16(r[6], r[7]);
                *(u32x4*)rowp = w; }
    }
};
template <bool BASE_BF16> struct EpiResid {
    static constexpr bool PERM = false, AFTER_DRAIN = false;
    const void* base_c; const void* base_x; const float* gate_c; const float* gate_x; bf16_t* X; int ldc; int pm_off;
    __device__ __forceinline__ void operator()(const f32x4 (&acc)[2][2][4][2], const Unit& u, int wr, int wc, int fr, int fq) const {
        const int pmr = u.pm + pm_off; const int row0 = pmr * BM + wr * 64 + fr, col0 = u.pn * BM + wc * 32 + 4 * fq;
        const bool isc = (pmr == 0);
        const float* gate = isc ? gate_c : gate_x;
        const size_t boff = isc ? 0 : (size_t)BM * ldc;
        const void* base = isc ? base_c : base_x;
        f32x4 gv[2][2];
#pragma unroll
        for (int bj = 0; bj < 2; ++bj)
#pragma unroll
            for (int n = 0; n < 2; ++n) gv[bj][n] = *(const f32x4*)(gate + col0 + bj * HALF + n * 16);
#pragma unroll
        for (int ai = 0; ai < 2; ++ai)
#pragma unroll
            for (int m = 0; m < 4; ++m) { const size_t off = (size_t)(row0 + ai * HALF + m * 16) * ldc + col0;
#pragma unroll
                for (int bj = 0; bj < 2; ++bj)
#pragma unroll
                    for (int n = 0; n < 2; ++n) { f32x4 bs;
                        if (BASE_BF16) { const unsigned long long w = *(const unsigned long long*)((const bf16_t*)base + (off - boff) + bj * HALF + n * 16); const unsigned lo = (unsigned)w, hi = (unsigned)(w >> 32);
                            bs = (f32x4){__uint_as_float(lo << 16), __uint_as_float(lo & 0xffff0000u), __uint_as_float(hi << 16), __uint_as_float(hi & 0xffff0000u)}; }
                        else bs = *(const f32x4*)((const float*)base + (off - boff) + bj * HALF + n * 16);
                        const f32x4 o = bs + gv[bj][n] * acc[ai][bj][m][n];
                        *(unsigned long long*)(X + off + bj * HALF + n * 16) = (unsigned long long)cvt_pk_bf16(o[0], o[1]) | ((unsigned long long)cvt_pk_bf16(o[2], o[3]) << 32); } }
    }
};
struct OutL0Order {
    StaticOrder S;
    __device__ __forceinline__ bool next(int i, Unit& u) const {
        if (S.next(i, u)) { u.pm += 1; u.aux = 0; return true; }
        const long s = (long)i * S.G + S.c - S.nwg; if (s < 0 || s >= 32) return false;
        u.pm = 0; u.pn = (int)(s & 7); u.aux = 1 + (int)(s >> 3); return true;
    }
    __device__ __forceinline__ int koff(const Unit& u) const { return u.aux ? (u.aux - 1) * 512 : 0; }
    __device__ __forceinline__ int knt(const Unit& u) const { return u.aux ? 8 : 32; }
    __device__ __forceinline__ void a_ready(const Unit&) const {}
    __device__ __forceinline__ void done(const Unit&) const {}
};
struct EpiResidL0 {
    static constexpr bool PERM = false, AFTER_DRAIN = false;
    EpiResid<false> R; float* part;
    __device__ __forceinline__ void operator()(const f32x4 (&acc)[2][2][4][2], const Unit& u, int wr, int wc, int fr, int fq) const {
        if (u.aux == 0) { R(acc, u, wr, wc, fr, fq); return; }
        float* pp = part + (size_t)(u.aux - 1) * BM * 2048 + (size_t)(wr * 64 + fr) * 2048 + u.pn * BM + wc * 32 + 4 * fq;
#pragma unroll
        for (int ai = 0; ai < 2; ++ai)
#pragma unroll
            for (int m = 0; m < 4; ++m)
#pragma unroll
                for (int bj = 0; bj < 2; ++bj)
#pragma unroll
                    for (int n = 0; n < 2; ++n) *(f32x4*)(pp + (size_t)(ai * HALF + m * 16) * 2048 + bj * HALF + n * 16) = acc[ai][bj][m][n];
    }
};
struct LoraOrder {
    StaticOrder S;
    __device__ __forceinline__ bool next(int i, Unit& u) const { return S.next(i, u); }
    __device__ __forceinline__ int koff(const Unit& u) const { return u.pn < 8 ? 0 : u.pn < 16 ? 128 : 256; }
    __device__ __forceinline__ int knt(const Unit& u) const { return u.pn < 16 ? 2 : 4; }
    __device__ __forceinline__ void a_ready(const Unit&) const {}
    __device__ __forceinline__ void done(const Unit&) const {}
};
struct MoeGatherOrder {
    int n8, G, c; const PG8_LAS int* tb; const int* slot; int slot_ld;
    __device__ __forceinline__ bool next(int i, Unit& u) const {
        int pm, j;
        if ((G & 7) == 0) {
            const int nt = n8 >> 3, x = c & 7, ts = (x * nt) >> 3, te = ((x + 1) * nt) >> 3;
            const int q = i * (G >> 3) + (c >> 3); if (q >= (te - ts) * 8) return false;
            pm = ts + (q >> 3); j = q & 7;
        } else { const long L = (long)i * G + c; if (L >= n8) return false; pm = (int)(L >> 3); j = (int)(L & 7); }
        u.pm = pm; u.pn = tb[128 + pm] * 8 + j; return true;
    }
    __device__ __forceinline__ int arow(const Unit& u, int r) const { const int e = tb[128 + u.pm]; const int i = u.pm * BM + r - tb[e]; return i < tb[64 + e] ? slot[(size_t)e * slot_ld + i] : 0; }
    __device__ __forceinline__ void a_ready(const Unit&) const {}
    __device__ __forceinline__ void done(const Unit&) const {}
};
struct MoeOrder {
    int n8, G, c; const PG8_LAS int* tb;
    __device__ __forceinline__ bool next(int i, Unit& u) const {
        int pm, j;
        if ((G & 7) == 0) {
            const int nt = n8 >> 3, x = c & 7, ts = (x * nt) >> 3, te = ((x + 1) * nt) >> 3;
            const int q = i * (G >> 3) + (c >> 3); if (q >= (te - ts) * 8) return false;
            pm = ts + (q >> 3); j = q & 7;
        } else { const long L = (long)i * G + c; if (L >= n8) return false; pm = (int)(L >> 3); j = (int)(L & 7); }
        u.pm = pm; u.pn = tb[128 + pm] * 8 + j; return true;
    }
    __device__ __forceinline__ void a_ready(const Unit&) const {}
    __device__ __forceinline__ void done(const Unit&) const {}
};
template <class Epi, class Sched, bool ALIGN_EPI = false, bool SP2 = false, bool GATHER = false, bool KRANGE = false>
__device__ __forceinline__ void gemm_phase(PG8_LAS unsigned char* lds, const Gemm g, const Sched& S, const Epi& E) {
    int tid_ = threadIdx.x; asm volatile("" : "+v"(tid_));
    const int tid = tid_, wid = __builtin_amdgcn_readfirstlane(tid >> 6), lane = tid & 63, wr = wid >> 2, wc = wid & 3, fr = lane & 15, fq = lane >> 4;
    const int K = g.K; int nt = K / BK;
    unsigned voffA[2], voffB[2]; int gR[2]; unsigned gC[2];
    unsigned gcu[2][2], gnx[2][2];
#pragma unroll
    for (int i = 0; i < 2; ++i) { int R, C; stage_rc(tid * 16 + i * 8192, R, C); const int Rb = Epi::PERM ? ((R & ~31) + perm32(R & 31)) : R;
        voffA[i] = (unsigned)(R * K + C) * 2u; voffB[i] = (unsigned)(Rb * K + C) * 2u; gR[i] = R; gC[i] = (unsigned)C * 2u; }
    const size_t kstep = (size_t)(BK * 2);
    const size_t hstep = (size_t)HALF * K * 2;
    const size_t tstep = 2 * hstep;
    const unsigned ldsw = (unsigned)wid * 1024u;
    const int aoff = lds_byte(wr * 64 + fr, fq * 8), boff = lds_byte(wc * 32 + fr, fq * 8);
#define PG8_SA(b, h) (((b) * 2 + (h)) * HTB)
#define PG8_SB(b, h) ((4 + (b) * 2 + (h)) * HTB)
#define PG8_STAGE(bufoff, gbase, voff) do { _Pragma("unroll") for (int _i = 0; _i < 2; ++_i) \
        __builtin_amdgcn_global_load_lds((const unsigned*)((const char*)(gbase) + (voff)[_i]), (PG8_LAS unsigned*)(lds + (bufoff) + ldsw + _i * 8192), 16, 0, 0); } while (0)
#define PG8_LDA(dst, b, h) do { _Pragma("unroll") for (int m = 0; m < 4; ++m) _Pragma("unroll") for (int k = 0; k < 2; ++k) dst[m][k] = *(const PG8_LAS bf16x8*)(lds + PG8_SA(b, h) + aoff + m * 2048 + k * 1024); } while (0)
#define PG8_LDB(dst, b, h) do { _Pragma("unroll") for (int n = 0; n < 2; ++n) _Pragma("unroll") for (int k = 0; k < 2; ++k) dst[n][k] = *(const PG8_LAS bf16x8*)(lds + PG8_SB(b, h) + boff + n * 2048 + k * 1024); } while (0)
#define PG8_MMA(ai, bj, At, Bt) do { __builtin_amdgcn_s_setprio(1); _Pragma("unroll") for (int m = 0; m < 4; ++m) _Pragma("unroll") for (int n = 0; n < 2; ++n) _Pragma("unroll") for (int k = 0; k < 2; ++k) \
        acc[ai][bj][m][n] = __builtin_amdgcn_mfma_f32_16x16x32_bf16(Bt[n][k], At[m][k], acc[ai][bj][m][n], 0, 0, 0); __builtin_amdgcn_s_setprio(0); } while (0)
#define PG8_WAIT_V(n) asm volatile("s_waitcnt vmcnt(" #n ")" ::: "memory")
#define PG8_WAIT_L(n) asm volatile("s_waitcnt lgkmcnt(" #n ")" ::: "memory")
#define PG8_BAR __builtin_amdgcn_s_barrier()
#define PG8_SCHED __builtin_amdgcn_sched_barrier(0)
    Unit cur, nxt; int ui = 0;
    if (!S.next(0, cur)) return;
    f32x4 acc[2][2][4][2];
#pragma unroll
    for (int a = 0; a < 2; ++a)
#pragma unroll
        for (int b = 0; b < 2; ++b)
#pragma unroll
            for (int m = 0; m < 4; ++m)
#pragma unroll
                for (int n = 0; n < 2; ++n) acc[a][b][m][n] = (f32x4){0.f, 0.f, 0.f, 0.f};
    bf16x8 At[4][2], B0[2][2], B1[2][2];
    const char* cA = GATHER ? (const char*)g.A : (const char*)g.A + (size_t)cur.pm * tstep; const char* cB = (const char*)g.Bt + (size_t)cur.pn * tstep;
    if constexpr (KRANGE) { cA += S.koff(cur) * 2; cB += S.koff(cur) * 2; nt = S.knt(cur); }
    S.a_ready(cur);
    if constexpr (GATHER) {
#pragma unroll
        for (int h = 0; h < 2; ++h)
#pragma unroll
            for (int i = 0; i < 2; ++i) { gcu[h][i] = (unsigned)S.arow(cur, h * HALF + gR[i]) * (unsigned)(K * 2) + gC[i]; gnx[h][i] = gcu[h][i]; } }
#define PG8_STAGE_A(bufoff, p, half, nxtsel) do { if constexpr (GATHER) { unsigned vo_[2] = {(nxtsel) ? gnx[half][0] : gcu[half][0], (nxtsel) ? gnx[half][1] : gcu[half][1]}; PG8_STAGE(bufoff, p, vo_); } \
        else { PG8_STAGE(bufoff, (p) + ((half) ? hstep : 0), voffA); } } while (0)
    if constexpr (SP2) {
        PG8_STAGE(PG8_SB(0, 0), cB, voffB); PG8_STAGE(PG8_SB(0, 1), cB + hstep, voffB); PG8_STAGE_A(PG8_SA(0, 0), cA, 0, false); PG8_STAGE_A(PG8_SA(0, 1), cA, 1, false);
        if (wr == 1) PG8_BAR;
        PG8_WAIT_V(2); PG8_BAR;
        PG8_STAGE(PG8_SB(1, 0), cB + kstep, voffB); PG8_STAGE_A(PG8_SA(1, 0), cA + kstep, 0, false); PG8_STAGE(PG8_SB(1, 1), cB + hstep + kstep, voffB);
        PG8_WAIT_V(6); PG8_BAR;
    } else {
        PG8_STAGE(PG8_SB(0, 0), cB, voffB); PG8_STAGE_A(PG8_SA(0, 0), cA, 0, false); PG8_STAGE(PG8_SB(0, 1), cB + hstep, voffB); PG8_STAGE_A(PG8_SA(0, 1), cA, 1, false);
        if (wr == 1) PG8_BAR;
        PG8_WAIT_V(4); PG8_BAR;
        PG8_STAGE(PG8_SB(1, 0), cB + kstep, voffB); PG8_STAGE_A(PG8_SA(1, 0), cA + kstep, 0, false); PG8_STAGE(PG8_SB(1, 1), cB + hstep + kstep, voffB);
        PG8_WAIT_V(6); PG8_BAR;
    }
    for (;;) {
        const bool has_next = S.next(ui + 1, nxt);
        const char* nA = GATHER ? (const char*)g.A : (has_next ? (const char*)g.A + (size_t)nxt.pm * tstep : cA); const char* nB = has_next ? (const char*)g.Bt + (size_t)nxt.pn * tstep : cB;
        if constexpr (KRANGE) { if (has_next) { nA += S.koff(nxt) * 2; nB += S.koff(nxt) * 2; } }
        if constexpr (GATHER) { if (has_next) {
#pragma unroll
            for (int h = 0; h < 2; ++h)
#pragma unroll
                for (int i = 0; i < 2; ++i) gnx[h][i] = (unsigned)S.arow(nxt, h * HALF + gR[i]) * (unsigned)(K * 2) + gC[i]; } }
        for (int t = 0; t < nt; t += 2) {
            const bool last = (t == nt - 2);
            const char* a1 = cA + (size_t)(t + 1) * kstep;
            const char* a2 = last ? nA : cA + (size_t)(t + 2) * kstep; const char* b2 = last ? nB : cB + (size_t)(t + 2) * kstep;
            const char* a3 = a2 + kstep; const char* b3 = b2 + kstep;
            if (last && has_next) S.a_ready(nxt);
            if constexpr (SP2) {
            PG8_LDB(B0, 0, 0); PG8_LDB(B1, 0, 1); PG8_SCHED; PG8_LDA(At, 0, 0); PG8_STAGE_A(PG8_SA(1, 1), a1, 1, false);
            PG8_WAIT_V(8); PG8_WAIT_L(0); PG8_BAR; PG8_MMA(0, 0, At, B0); PG8_MMA(0, 1, At, B1); PG8_BAR; PG8_SCHED;
            PG8_LDA(At, 0, 1); PG8_STAGE(PG8_SB(0, 0), b2, voffB); PG8_STAGE(PG8_SB(0, 1), b2 + hstep, voffB); PG8_STAGE_A(PG8_SA(0, 0), a2, 0, last);
            PG8_WAIT_V(8); PG8_WAIT_L(0); PG8_BAR; PG8_MMA(1, 0, At, B0); PG8_MMA(1, 1, At, B1); PG8_BAR; PG8_SCHED;
            PG8_LDB(B0, 1, 0); PG8_LDB(B1, 1, 1); PG8_SCHED; PG8_LDA(At, 1, 0); PG8_STAGE_A(PG8_SA(0, 1), a2, 1, last);
            PG8_WAIT_V(8); PG8_WAIT_L(0); PG8_BAR; PG8_MMA(0, 0, At, B0); PG8_MMA(0, 1, At, B1); PG8_BAR; PG8_SCHED;
            PG8_LDA(At, 1, 1); PG8_STAGE(PG8_SB(1, 0), b3, voffB); PG8_STAGE(PG8_SB(1, 1), b3 + hstep, voffB); PG8_STAGE_A(PG8_SA(1, 0), a3, 0, last);
            PG8_WAIT_V(8); PG8_WAIT_L(0); PG8_BAR; PG8_MMA(1, 0, At, B0); PG8_MMA(1, 1, At, B1); PG8_BAR; PG8_SCHED;
            } else {
            PG8_LDB(B0, 0, 0); PG8_SCHED; PG8_LDA(At, 0, 0); PG8_STAGE_A(PG8_SA(1, 1), a1, 1, false);
            PG8_WAIT_L(8); PG8_BAR; PG8_WAIT_L(0); PG8_MMA(0, 0, At, B0); PG8_BAR; PG8_SCHED;
            PG8_LDB(B1, 0, 1); PG8_STAGE(PG8_SB(0, 0), b2, voffB);
            PG8_BAR; PG8_WAIT_L(0); PG8_MMA(0, 1, At, B1); PG8_BAR;
            PG8_LDA(At, 0, 1); PG8_STAGE_A(PG8_SA(0, 0), a2, 0, last);
            PG8_BAR; PG8_WAIT_L(0); PG8_MMA(1, 0, At, B0); PG8_BAR; PG8_SCHED;
            PG8_STAGE(PG8_SB(0, 1), b2 + hstep, voffB);
            PG8_WAIT_V(6); PG8_BAR; PG8_MMA(1, 1, At, B1); PG8_BAR;
            PG8_LDB(B0, 1, 0); PG8_SCHED; PG8_LDA(At, 1, 0); PG8_STAGE_A(PG8_SA(0, 1), a2, 1, last);
            PG8_WAIT_L(8); PG8_BAR; PG8_WAIT_L(0); PG8_MMA(0, 0, At, B0); PG8_BAR; PG8_SCHED;
            PG8_LDB(B1, 1, 1); PG8_STAGE(PG8_SB(1, 0), b3, voffB);
            PG8_BAR; PG8_WAIT_L(0); PG8_MMA(0, 1, At, B1); PG8_BAR;
            PG8_LDA(At, 1, 1); PG8_STAGE_A(PG8_SA(1, 0), a3, 0, last);
            PG8_BAR; PG8_WAIT_L(0); PG8_MMA(1, 0, At, B0); PG8_BAR; PG8_SCHED;
            PG8_STAGE(PG8_SB(1, 1), b3 + hstep, voffB);
            PG8_WAIT_V(6); PG8_BAR; PG8_MMA(1, 1, At, B1); PG8_BAR;
            }
        }
        if constexpr (ALIGN_EPI) { if (wr == 0) PG8_BAR; }
        if constexpr (!Epi::AFTER_DRAIN) { E(acc, cur, wr, wc, fr, fq); S.done(cur); }
        if (!has_next) break;
#pragma unroll
        for (int a = 0; a < 2; ++a)
#pragma unroll
            for (int b = 0; b < 2; ++b)
#pragma unroll
                for (int m = 0; m < 4; ++m)
#pragma unroll
                    for (int n = 0; n < 2; ++n) acc[a][b][m][n] = (f32x4){0.f, 0.f, 0.f, 0.f};
        cur = nxt; cA = nA; cB = nB; ++ui;
        if constexpr (KRANGE) nt = S.knt(cur);
        if constexpr (GATHER) {
#pragma unroll
            for (int h = 0; h < 2; ++h)
#pragma unroll
                for (int i = 0; i < 2; ++i) gcu[h][i] = gnx[h][i]; }
        if constexpr (ALIGN_EPI) { if (wr == 1) PG8_BAR; }
    }
    PG8_WAIT_V(0);
    if constexpr (!ALIGN_EPI) { if (wr == 0) PG8_BAR; }
    PG8_BAR;
    if constexpr (Epi::AFTER_DRAIN) { E.fused(acc, cur, wr, wc, fr, fq, lds, wid, lane); S.done(cur); }
#undef PG8_SA
#undef PG8_SB
#undef PG8_STAGE
#undef PG8_STAGE_A
#undef PG8_LDA
#undef PG8_LDB
#undef PG8_MMA
#undef PG8_WAIT_V
#undef PG8_WAIT_L
#undef PG8_BAR
#undef PG8_SCHED
}
}


#ifndef MK_N_LAUNCHES
#define MK_N_LAUNCHES 1
#endif

#define GAS __attribute__((address_space(1)))
#define LAS __attribute__((address_space(3)))
#define CAS __attribute__((address_space(4)))
typedef unsigned short bf16;
typedef unsigned v4u __attribute__((ext_vector_type(4)));
typedef unsigned v2u __attribute__((ext_vector_type(2)));
typedef float f32x4 __attribute__((ext_vector_type(4)));
typedef short bf16x8 __attribute__((ext_vector_type(8)));

constexpr int D = 2048, TC = 256, TL = 16384, T = TC + TL;
constexpr int NL = 2;
constexpr int PIN = 7584, PW = 7680, RWIN = 3488, RET_OFF = 3584;
constexpr int LK = 512, LNN = 5120;
constexpr int NCH = 130;
constexpr int NE = 32, MPAD = 41472, MAXTILES = MPAD / 256;
constexpr int NWAVES = 8, NTHR = 512;
constexpr int KP = 16;

constexpr size_t al256(size_t x) { return (x + 255) & ~(size_t)255; }
constexpr size_t WS_CTL = 0, CTL_BYTES = 1u << 20;
constexpr size_t WS_MODP = CTL_BYTES;
constexpr size_t WS_MOD  = WS_MODP + al256((size_t)NL * KP * 2 * 12288 * 4);
constexpr size_t WS_WIN  = WS_MOD + al256((size_t)NL * 2 * 12288 * 4);
constexpr size_t WS_WOUT = WS_WIN + al256((size_t)NL * PW * D * 2);
constexpr size_t WS_LB   = WS_WOUT + al256((size_t)NL * D * D * 2);
constexpr size_t WS_W1   = WS_LB + al256((size_t)NL * LNN * LK * 2);
constexpr size_t WS_W2   = WS_W1 + al256((size_t)NL * NE * 2048 * 2048 * 2);
constexpr size_t WS_X    = WS_W2 + al256((size_t)NL * NE * 2048 * 1024 * 2);
constexpr size_t WS_XN   = WS_X + al256((size_t)T * D * 4);
constexpr size_t WS_H    = WS_XN + al256((size_t)T * D * 4);
constexpr size_t WS_P    = WS_H + al256((size_t)T * D * 2);
constexpr size_t WS_LA   = WS_P + al256((size_t)T * PW * 2);
constexpr size_t WS_LORA = WS_LA + al256((size_t)T * LK * 2);
constexpr size_t SZ_S    = al256((size_t)T * 1024 * 4);
constexpr size_t SZ_CK   = al256((size_t)32 * 520 * 2048 * 2);
constexpr size_t SZ_CM   = al256((size_t)32 * 520 * 1024 * 2);
constexpr size_t WS_AGP  = WS_LORA + al256((size_t)T * LNN * 2);
constexpr size_t WS_RGP  = WS_AGP + SZ_CK, WS_BGI = WS_RGP + SZ_CK, WS_KGI = WS_BGI + SZ_CK, WS_KGT = WS_KGI + SZ_CK, WS_BGT = WS_KGT + SZ_CK, WS_VTP = WS_BGT + SZ_CK;
constexpr size_t WS_TP   = WS_VTP + SZ_CK, WS_AAK = WS_TP + SZ_CM, WS_ARK = WS_AAK + SZ_CM, WS_ARB = WS_ARK + SZ_CM;
constexpr size_t WS_GC   = WS_ARB + SZ_CM;
constexpr size_t WS_VTOK = WS_GC + al256((size_t)32 * 520 * 256 * 4);
constexpr size_t WS_SY   = WS_VTOK + al256((size_t)2 * T * 1024 * 2);
constexpr size_t WS_BON  = WS_SY + 2 * SZ_S;
constexpr size_t WS_KNRM = WS_BON + al256((size_t)2 * T * 16 * 4 * 4);
constexpr size_t SZ_RT   = al256((size_t)T * 1024 * 2);
constexpr size_t WS_SCT  = WS_KNRM + al256((size_t)T * 16 * 4);
constexpr size_t WS_RT   = WS_SCT + al256((size_t)320 * 32 * 2 * 4);
constexpr size_t WS_QR   = WS_RT + al256((size_t)2 * 32 * 2048 * 2);
constexpr size_t WS_KR   = WS_QR + SZ_RT, WS_VT = WS_KR + SZ_RT, WS_KTF = WS_VT + SZ_RT, WS_KTB = WS_KTF + SZ_RT;
constexpr size_t WS_KVT  = WS_KTB + SZ_RT;
constexpr size_t WS_ST   = WS_KVT + al256((size_t)2 * 8 * NCH * 16384 * 4);
constexpr size_t WS_YALL = WS_ST + al256((size_t)2 * 8 * NCH * 16384 * 2);
constexpr size_t WS_RE   = WS_YALL + al256((size_t)T * D * 2);
constexpr size_t WS_RWT  = WS_RE + al256((size_t)T * 2 * 4);
constexpr size_t WS_RI   = WS_RWT + al256((size_t)T * 2 * 4);
constexpr size_t WS_DEST = WS_RI + al256((size_t)T * 2 * 4);
constexpr size_t WS_TILE = WS_DEST + al256((size_t)T * 2 * 4);
constexpr size_t WS_XB   = WS_TILE + 1024;
constexpr size_t WS_ACT  = WS_XB + al256((size_t)MPAD * D * 2);
constexpr size_t WS_YB   = WS_ACT + al256((size_t)MPAD * 1024 * 2);
constexpr size_t WS_END  = WS_YB + al256((size_t)MPAD * D * 2);
constexpr int CW_BAR = 4096;
constexpr size_t CTXPART_OFF = 4u << 20;
constexpr int CW_CNT = 8192;

constexpr int RING_BYTES = 131072, EXTRA_OFF = RING_BYTES, EXTRA_BYTES = 24576, MISC_OFF = EXTRA_OFF + EXTRA_BYTES, LDS_BYTES = MISC_OFF + 256;

__device__ __forceinline__ float bf_lo(unsigned w) { return __uint_as_float(w << 16); }
__device__ __forceinline__ float bf_hi(unsigned w) { return __uint_as_float(w & 0xffff0000u); }
__device__ __forceinline__ unsigned pk2(float lo, float hi) { return pg8::cvt_pk_bf16(lo, hi); }
__device__ __forceinline__ unsigned short f2bf1(float f) { return (unsigned short)(pg8::cvt_pk_bf16(f, 0.f) & 0xffffu); }
__device__ __forceinline__ float wave_sum(float v) {
#pragma unroll
    for (int o = 1; o < 64; o <<= 1) v += __shfl_xor(v, o);
    return v;
}
template <int CTRL> __device__ __forceinline__ float dppf(float v) { return __builtin_bit_cast(float, __builtin_amdgcn_update_dpp(0, __builtin_bit_cast(int, v), CTRL, 0xf, 0xf, true)); }
__device__ __forceinline__ float quadsum(float v) { v += dppf<0xB1>(v); v += dppf<0x4E>(v); return v; }
__device__ __forceinline__ float rowsum16(float v) { v += dppf<0xB1>(v); v += dppf<0x4E>(v); v += dppf<0x141>(v); v += dppf<0x140>(v); return v; }
__device__ __forceinline__ float sigmoidf_(float x) { return 1.0f / (1.0f + __expf(-x)); }
#define LDS_WAIT() asm volatile("s_waitcnt lgkmcnt(0)" ::: "memory")

#define XB_TMO      128
#define XB_XCNT(j)  (256  + 64 * (j))
#define XB_XSUB(j)  (1280 + 64 * (j))
#define XB_XGEN(j)  (2304 + 64 * (j))
#define XB_TOP      3328
#define XB_TOPGEN   3392
#define XCD_BAR_WORDS 3456
#define XB_SPIN_CAP (1u << 20)
__device__ __forceinline__ unsigned xb_ld(unsigned* p)              { return __hip_atomic_load(p, __ATOMIC_RELAXED, __HIP_MEMORY_SCOPE_AGENT); }
__device__ __forceinline__ unsigned xb_add(unsigned* p, unsigned v) { return __hip_atomic_fetch_add(p, v, __ATOMIC_RELAXED, __HIP_MEMORY_SCOPE_AGENT); }
__device__ __forceinline__ unsigned xb_xcc_id() { return (unsigned)__builtin_amdgcn_s_getreg((3 << 11) | 20) & 0xFu; }
#define XB_SPIN(cond, bar) do { unsigned _sp = 0; while (cond) { __builtin_amdgcn_s_sleep(1); \
    if ((++_sp & 255u) == 0u) { if (xb_ld(&(bar)[XB_TMO])) break; if (_sp > XB_SPIN_CAP) { atomicAdd(&(bar)[XB_TMO], 1u); break; } } } } while (0)
struct XcdBarrier { unsigned* bar; unsigned x; volatile LAS unsigned* st; };
__device__ __forceinline__ XcdBarrier xcd_barrier_post(unsigned* bar, volatile LAS unsigned* st) {
    XcdBarrier b; b.bar = bar; b.x = xb_xcc_id(); b.st = st;
    if (threadIdx.x == 0) (void)xb_add(&bar[XB_XCNT(b.x)], 1u);
    return b;
}
__device__ __forceinline__ void xcd_barrier_complete(unsigned* bar, unsigned x, unsigned& nloc, unsigned& nx) {
    const unsigned G = gridDim.x * gridDim.y * gridDim.z;
    unsigned sum, cnt, mine, sp = 0u;
    for (;;) {
        sum = 0u; cnt = 0u; mine = 0u;
#pragma unroll
        for (unsigned j = 0; j < 16; ++j) { const unsigned c = xb_ld(&bar[XB_XCNT(j)]); sum += c; cnt += (c > 0u) ? 1u : 0u; mine = (j == x) ? c : mine; }
        if (sum == G) break;
        __builtin_amdgcn_s_sleep(1);
        if ((++sp & 255u) == 0u) { if (xb_ld(&bar[XB_TMO])) break; if (sp > XB_SPIN_CAP) { atomicAdd(&bar[XB_TMO], 1u); break; } }
    }
    nloc = mine > 0u ? mine : 1u; nx = cnt > 0u ? cnt : 1u;
}
__device__ __forceinline__ void xcd_barrier(const XcdBarrier& b) {
    asm volatile("s_waitcnt vmcnt(0)" ::: "memory");
    __syncthreads();
    if (threadIdx.x == 0) {
        unsigned* bar = b.bar; asm volatile("" : "+s"(bar));
        __builtin_amdgcn_s_waitcnt(0);
        unsigned nloc = b.st[0], nx = b.st[1];
        if (nloc == 0u) { xcd_barrier_complete(bar, b.x, nloc, nx); b.st[0] = nloc; b.st[1] = nx; }
        const unsigned old = xb_add(&bar[XB_XSUB(b.x)], 1u);
        const unsigned gen = old / nloc;
        if (old + 1u == (gen + 1u) * nloc) {
            __builtin_amdgcn_fence(__ATOMIC_RELEASE, "agent");
            asm volatile("s_waitcnt vmcnt(0)" ::: "memory");
            const unsigned og = xb_add(&bar[XB_TOP], 1u);
            const unsigned tg = og / nx;
            if (og + 1u == (tg + 1u) * nx) xb_add(&bar[XB_TOPGEN], 1u);
            else XB_SPIN(xb_ld(&bar[XB_TOPGEN]) == tg, bar);
            __builtin_amdgcn_fence(__ATOMIC_ACQUIRE, "agent");
            xb_add(&bar[XB_XGEN(b.x)], 1u);
            asm volatile("s_waitcnt vmcnt(0)" ::: "memory");
        } else {
            XB_SPIN(xb_ld(&bar[XB_XGEN(b.x)]) == gen, bar);
            __builtin_amdgcn_fence(__ATOMIC_ACQUIRE, "agent");
            asm volatile("s_waitcnt vmcnt(0)" ::: "memory");
        }
    }
    __syncthreads();
}

struct Args { const float* in[28]; float* out; unsigned char* ws; int ph_lo, ph_hi; };
enum { I_X = 0, I_C, I_CTX, I_CCTX, I_ADAW, I_ADAB, I_N1G, I_N2G, I_WIN, I_MU, I_W0, I_W2, I_A0, I_A2, I_G2, I_KK, I_KA, I_RK, I_LNW, I_LNB, I_L2D, I_GNW, I_WOUT, I_RTW, I_RTB, I_MW1, I_MW2, I_FG };

struct Ctx {
    LAS unsigned char* lds;
    int tid, lane, wave, G, bx, gw, NGW;
};

__device__ __forceinline__ int next_row(const Ctx& C, int k, int r0 = 0) {
    const int nfull = (T - r0) / C.NGW;
    if (k < nfull) return r0 + C.gw + k * C.NGW;
    if (C.wave != 0) return -1;
    const int r = r0 + nfull * C.NGW + C.bx + (k - nfull) * C.G; return r < T ? r : -1;
}
#define FOR_ROWS(r) for (int k_ = 0, r = next_row(C, 0); r >= 0; r = next_row(C, ++k_))
#define FOR_ROWS_FROM(r, r0) for (int k_ = 0, r = next_row(C, 0, (r0)); r >= 0; r = next_row(C, ++k_, (r0)))
struct TrSrc { const float* p; int N; };
struct TrDst { bf16* p; int K; };
__device__ __forceinline__ void tr_load(const TrSrc s, f32x4 (&v)[8], int lane) {
#pragma unroll
    for (int i = 0; i < 8; ++i) v[i] = *(const f32x4*)(s.p + (size_t)(8 * i + (lane >> 3)) * s.N + 4 * (lane & 7));
}
__device__ __forceinline__ void tr_to_lds(const f32x4 (&v)[8], LAS float* scr, int lane) {
#pragma unroll
    for (int i = 0; i < 8; ++i) { LAS float* d = scr + (8 * i + (lane >> 3)) * 33 + 4 * (lane & 7); d[0] = v[i].x; d[1] = v[i].y; d[2] = v[i].z; d[3] = v[i].w; }
}
__device__ __forceinline__ void tr_store(const TrDst t, const LAS float* scr, int lane) {
    const int c = lane & 7;
#pragma unroll
    for (int j = 0; j < 4; ++j) { const int n = (lane >> 3) + 8 * j; const LAS float* s = scr + (8 * c) * 33 + n;
        v4u o; o.x = pk2(s[0 * 33], s[1 * 33]); o.y = pk2(s[2 * 33], s[3 * 33]); o.z = pk2(s[4 * 33], s[5 * 33]); o.w = pk2(s[6 * 33], s[7 * 33]);
        *(v4u*)(t.p + (size_t)n * t.K + 8 * c) = o; }
}
#define TR_PIPELINE(FIRST, STRIDE, COUNT, ITEMFN) do { int it_ = (FIRST); if (it_ < (COUNT)) { TrSrc s_; TrDst d_; f32x4 v_[8]; ITEMFN(it_, s_, d_); tr_load(s_, v_, C.lane); \
        for (;;) { tr_to_lds(v_, scr, C.lane); LDS_WAIT(); const int nx_ = it_ + (STRIDE); const bool more_ = nx_ < (COUNT); TrDst dn_ = d_; \
            if (more_) { ITEMFN(nx_, s_, dn_); tr_load(s_, v_, C.lane); } \
            tr_store(d_, scr, C.lane); LDS_WAIT(); if (!more_) break; it_ = nx_; d_ = dn_; } } } while (0)
__device__ __forceinline__ void tr_item(const float* W, int K, int N, bf16* WT, int k0, int n0, int orow0, LAS float* scr, int lane) {
#pragma unroll 8
    for (int i = 0; i < 32; ++i) { const int kk = 2 * i + (lane >> 5); scr[kk * 33 + (lane & 31)] = __builtin_nontemporal_load(W + (size_t)(k0 + kk) * N + n0 + (lane & 31)); }
    LDS_WAIT();
    const int c = lane & 7;
#pragma unroll
    for (int j = 0; j < 4; ++j) { const int n = (lane >> 3) + 8 * j; const LAS float* s = scr + (8 * c) * 33 + n;
        v4u o; o.x = pk2(s[0 * 33], s[1 * 33]); o.y = pk2(s[2 * 33], s[3 * 33]); o.z = pk2(s[4 * 33], s[5 * 33]); o.w = pk2(s[6 * 33], s[7 * 33]);
        __builtin_nontemporal_store(o, (v4u*)(WT + (size_t)(orow0 + n) * K + k0 + 8 * c)); }
    LDS_WAIT();
}
__device__ __forceinline__ void ph_prologue(const Args& a, const Ctx& C) {
    unsigned char* ws = a.ws;
    LAS float* scr = (LAS float*)(C.lds + C.wave * 16384);
    constexpr int IW_IN = 32 * 237, IW_OUT = 32 * 64, PER = IW_IN + IW_OUT;
#define PRO_ITEM(it, s, d) do { const int l = (it) / PER; int r = (it) % PER; \
        if (r < IW_IN) { const int kb = r / 237, nb = r % 237, n0 = 32 * nb; s.p = a.in[I_WIN] + (size_t)l * D * PIN + (size_t)(64 * kb) * PIN + n0; s.N = PIN; \
            d.p = (bf16*)(ws + WS_WIN) + (size_t)l * PW * D + (size_t)(n0 < RWIN ? n0 : n0 + (RET_OFF - RWIN)) * D + 64 * kb; d.K = D; } \
        else { r -= IW_IN; const int kb = r / 64, nb = r % 64; s.p = a.in[I_WOUT] + (size_t)l * D * D + (size_t)(64 * kb) * D + 32 * nb; s.N = D; \
            d.p = (bf16*)(ws + WS_WOUT) + (size_t)l * D * D + (size_t)(32 * nb) * D + 64 * kb; d.K = D; } } while (0)
    TR_PIPELINE(C.gw, C.NGW, NL * PER, PRO_ITEM);
#undef PRO_ITEM
    const int gtid = C.gw * 64 + C.lane, NGT = C.NGW * 64;
    for (int i = gtid; i < NL * 96 * (D / 8); i += NGT) { const int l = i / (96 * 256), r = (i / 256) % 96, c8 = i % 256;
        *(v4u*)((bf16*)(ws + WS_WIN) + ((size_t)l * PW + RWIN + r) * D + 8 * c8) = (v4u){0u, 0u, 0u, 0u}; }
    for (int i = gtid; i < NL * LNN * (LK / 8); i += NGT) {
        const int l = i / (LNN * 64), n = (i / 64) % LNN, k0 = 8 * (i % 64);
        const int blk = n >> 10, nn = n & 1023;
        float v[8];
#pragma unroll
        for (int j = 0; j < 8; ++j) { const int k = k0 + j; float x = 0.f;
            if (blk < 2) { if ((k >> 6) == blk) x = a.in[I_W2][((size_t)(l * 2 + blk) * 64 + (k & 63)) * 1024 + nn]; }
            else if (blk < 4) { if ((k >> 6) == blk) x = a.in[I_A2][((size_t)(l * 2 + (blk - 2)) * 64 + (k & 63)) * 1024 + nn]; }
            else { if (k >= 256 && k < 416) x = a.in[I_G2][((size_t)l * 160 + (k - 256)) * 1024 + nn]; }
            v[j] = x; }
        *(v4u*)((bf16*)(ws + WS_LB) + ((size_t)l * LNN + n) * LK + k0) = (v4u){pk2(v[0], v[1]), pk2(v[2], v[3]), pk2(v[4], v[5]), pk2(v[6], v[7])};
    }
    for (int i = gtid; i < 32 * 2048; i += NGT) { const int e = i >> 11, k = i & 2047; const float w = a.in[I_RTW][(size_t)k * 32 + e];
        const unsigned short hi = f2bf1(w); const float hf = __uint_as_float((unsigned)hi << 16);
        bf16* rt = (bf16*)(ws + WS_RT); rt[i] = hi; rt[32 * 2048 + i] = f2bf1(w - hf); }
    for (int i = gtid; i < 320 * 32; i += NGT) { const int pv = i >> 5, fi = i & 31; const float ang = (float)(pv < 256 ? pv : pv - 256) * exp2f(-(float)(2 * fi) * (13.287712379549449f / 64.0f));
        float* sct = (float*)(ws + WS_SCT); sct[2 * i] = cosf(ang); sct[2 * i + 1] = sinf(ang); }
    for (int it = C.gw; it < NL * KP * 48; it += C.NGW) {
        const int l = it / (KP * 48), kp = (it / 48) % KP, jb = it % 48;
        const int kb = 128 * kp;
        { const float c0 = a.in[I_C][kb + C.lane], c1 = a.in[I_C][kb + 64 + C.lane], x0 = a.in[I_CCTX][kb + C.lane], x1 = a.in[I_CCTX][kb + 64 + C.lane];
          scr[C.lane] = c0 * sigmoidf_(c0); scr[64 + C.lane] = c1 * sigmoidf_(c1); scr[128 + C.lane] = x0 * sigmoidf_(x0); scr[192 + C.lane] = x1 * sigmoidf_(x1); }
        LDS_WAIT();
        f32x4 ax = {0.f, 0.f, 0.f, 0.f}, ac = {0.f, 0.f, 0.f, 0.f};
        const float* wp = a.in[I_ADAW] + ((size_t)l * D + kb) * 12288 + 256 * jb + 4 * C.lane;
#pragma unroll 32
        for (int k = 0; k < 128; ++k) { const f32x4 w = *(const f32x4*)(wp + (size_t)k * 12288);     const float sx = scr[k], sc = scr[128 + k]; ax += w * sx; ac += w * sc; }
        float* mp = (float*)(ws + WS_MODP) + ((size_t)(l * KP + kp) * 2) * 12288 + 256 * jb + 4 * C.lane;
        *(f32x4*)mp = ax; *(f32x4*)(mp + 12288) = ac;
        LDS_WAIT();
    }
}

__device__ __forceinline__ void ph_convert_moe(const Args& a, const Ctx& C, int l, int wid, int nw, LAS float* scr) {
    unsigned char* ws = a.ws;
    constexpr int IW_1 = 32 * 32 * 64, IW_2 = 32 * 16 * 64;
    for (int it = wid; it < IW_1 + IW_2; it += nw) {
        int r = it;
        if (r < IW_1) { const int e = r / 2048, rr = r % 2048, kb = rr / 64, nb = rr % 64, n0 = 32 * nb;
            const int orow = n0 < 1024 ? 256 * (n0 >> 7) + (n0 & 127) : 256 * ((n0 - 1024) >> 7) + 128 + ((n0 - 1024) & 127);
            tr_item(a.in[I_MW1] + (size_t)(l * NE + e) * 2048 * 2048, 2048, 2048, (bf16*)(ws + WS_W1) + (size_t)(l * NE + e) * 2048 * 2048, 64 * kb, n0, orow, scr, C.lane); continue; }
        r -= IW_1;
        { const int e = r / 1024, rr = r % 1024, kb = rr / 64, nb = rr % 64;
            tr_item(a.in[I_MW2] + (size_t)(l * NE + e) * 1024 * 2048, 1024, 2048, (bf16*)(ws + WS_W2) + (size_t)(l * NE + e) * 2048 * 1024, 64 * kb, 32 * nb, 32 * nb, scr, C.lane); }
    }
}
__device__ __forceinline__ float mod_from_partials(const Args& a, int l, int which, int j) {
    float s = a.in[I_ADAB][l * 12288 + j];
    const float* mp = (const float*)(a.ws + WS_MODP) + ((size_t)(l * KP) * 2 + which) * 12288 + j;
#pragma unroll
    for (int kp = 0; kp < KP; ++kp) s += mp[(size_t)kp * 2 * 12288];
    return s;
}

__device__ __forceinline__ const float* xrow_ptr(const Args& a, int l, int r) {
    if (l == 0) return r < TC ? a.in[I_CTX] + (size_t)r * D : a.in[I_X] + (size_t)(r - TC) * D;
    return (const float*)(a.ws + WS_XN) + (size_t)r * D;
}
__device__ __forceinline__ void norm1_rows(const Ctx& C, const float* __restrict__ xc  , const float* __restrict__ xx  , bf16* __restrict__ H, const LAS float* GV) {
#pragma unroll 2
    FOR_ROWS(r) {
        const float* xr = r < TC ? xc + (size_t)r * D : xx + (size_t)(r - TC) * D; const int wh = r < TC ? 1 : 0;
        f32x4 v[8]; float ss = 0.f;
#pragma unroll
        for (int j = 0; j < 8; ++j) { v[j] = *(const f32x4*)(xr + 4 * C.lane + 256 * j); ss += v[j].x * v[j].x + v[j].y * v[j].y + v[j].z * v[j].z + v[j].w * v[j].w; }
        const float rstd = rsqrtf(wave_sum(ss) * (1.0f / D) + 1e-6f);
#pragma unroll
        for (int j = 0; j < 8; ++j) { const int k = 4 * C.lane + 256 * j;
            const f32x4 g = *(const LAS f32x4*)(GV + wh * D + k), s = *(const LAS f32x4*)(GV + 2 * D + wh * D + k);
            const f32x4 h = v[j] * rstd * g + s;
            *(v2u*)(H + (size_t)r * D + k) = (v2u){pk2(h.x, h.y), pk2(h.z, h.w)}; }
    }
}
__device__ __forceinline__ void ph_norm1(const Args& a, const Ctx& C, int l) {
    LAS float* GV = (LAS float*)C.lds;
    if (l == 0) {
        float* modf = (float*)(a.ws + WS_MOD);
        for (int i = C.bx * NTHR + C.tid; i < NL * 2 * 12288; i += C.G * NTHR) { const int ll = i / (2 * 12288), wh = (i / 12288) & 1, j = i % 12288; modf[i] = mod_from_partials(a, ll, wh, j); }
    }
    for (int i = C.tid; i < 2 * D; i += NTHR) { const int wh = i / D, k = i % D;
        const float sh = mod_from_partials(a, l, wh, k), sc = mod_from_partials(a, l, wh, D + k);
        GV[wh * D + k] = a.in[I_N1G][l * D + k] * (1.0f + sc); GV[2 * D + wh * D + k] = sh; }
    __syncthreads();
    bf16* H = (bf16*)(a.ws + WS_H);
    norm1_rows(C, xrow_ptr(a, l, 0), xrow_ptr(a, l, TC), H, GV);
    __syncthreads();
}

__device__ __forceinline__ void shift_rows(int t, int (&nb)[4], int& nn) {
    const bool isc = t < TC; const int p = t - TC, gc = p & 63, gr = p >> 6;
    nn = isc ? 2 : 4;
    nb[0] = isc ? (t > 0 ? t - 1 : -1) : (gc > 0 ? t - 1 : -1);
    nb[1] = isc ? (t < TC - 1 ? t + 1 : -1) : (gc < 63 ? t + 1 : -1);
    nb[2] = isc ? -1 : (gr > 0 ? t - 64 : -1);
    nb[3] = isc ? -1 : (gr < 255 ? t + 64 : -1);
}
__device__ __forceinline__ void shift8(const bf16* P, const float* mu  , int t, int col0, const int (&nb)[4], int nn, float (&u)[8]) {
    const v4u pc = *(const v4u*)(P + (size_t)t * PW + col0);
    v4u q[4];
#pragma unroll
    for (int j = 0; j < 4; ++j) q[j] = *(const v4u*)(P + (size_t)(nb[j] >= 0 ? nb[j] : t) * PW + col0);
    float p[8] = {bf_lo(pc.x), bf_hi(pc.x), bf_lo(pc.y), bf_hi(pc.y), bf_lo(pc.z), bf_hi(pc.z), bf_lo(pc.w), bf_hi(pc.w)};
#pragma unroll
    for (int i = 0; i < 8; ++i) u[i] = p[i];
#pragma unroll
    for (int j = 0; j < 4; ++j) {
        const float on = (j < nn) ? 1.0f : 0.0f, has = (nb[j] >= 0) ? 1.0f : 0.0f;
        const float n8[8] = {bf_lo(q[j].x), bf_hi(q[j].x), bf_lo(q[j].y), bf_hi(q[j].y), bf_lo(q[j].z), bf_hi(q[j].z), bf_lo(q[j].w), bf_hi(q[j].w)};
        const f32x4 m0 = *(const f32x4*)(mu + (size_t)j * RWIN + col0), m1 = *(const f32x4*)(mu + (size_t)j * RWIN + col0 + 4);
        const float m8[8] = {m0.x, m0.y, m0.z, m0.w, m1.x, m1.y, m1.z, m1.w};
#pragma unroll
        for (int i = 0; i < 8; ++i) u[i] += on * m8[i] * (has * n8[i] - p[i]);
    }
}

__device__ __forceinline__ void shift8r(const bf16* P, const float (&m)[4][8], int t, int col0, const int (&nb)[4], int nn, float (&u)[8]) {
    const v4u pc = *(const v4u*)(P + (size_t)t * PW + col0);
    v4u q[4];
#pragma unroll
    for (int j = 0; j < 4; ++j) q[j] = *(const v4u*)(P + (size_t)(nb[j] >= 0 ? nb[j] : t) * PW + col0);
    float p[8] = {bf_lo(pc.x), bf_hi(pc.x), bf_lo(pc.y), bf_hi(pc.y), bf_lo(pc.z), bf_hi(pc.z), bf_lo(pc.w), bf_hi(pc.w)};
#pragma unroll
    for (int i = 0; i < 8; ++i) u[i] = p[i];
#pragma unroll
    for (int j = 0; j < 4; ++j) {
        const float on = (j < nn) ? 1.0f : 0.0f, has = (nb[j] >= 0) ? 1.0f : 0.0f;
        const float n8[8] = {bf_lo(q[j].x), bf_hi(q[j].x), bf_lo(q[j].y), bf_hi(q[j].y), bf_lo(q[j].z), bf_hi(q[j].z), bf_lo(q[j].w), bf_hi(q[j].w)};
#pragma unroll
        for (int i = 0; i < 8; ++i) u[i] += on * m[j][i] * (has * n8[i] - p[i]);
    }
}
__device__ __forceinline__ void load_mu8(const float* mu, int col0, float (&m)[4][8]) {
#pragma unroll
    for (int j = 0; j < 4; ++j) { const f32x4 m0 = *(const f32x4*)(mu + (size_t)j * RWIN + col0), m1 = *(const f32x4*)(mu + (size_t)j * RWIN + col0 + 4);
        m[j][0] = m0.x; m[j][1] = m0.y; m[j][2] = m0.z; m[j][3] = m0.w; m[j][4] = m1.x; m[j][5] = m1.y; m[j][6] = m1.z; m[j][7] = m1.w; }
}

__device__ __forceinline__ void prep_rows(const Args& a, const Ctx& C, int l, const bf16* __restrict__ P, const float* __restrict__ mu, bf16* __restrict__ LA, float* __restrict__ KNRM) {
      const int lc = C.lane < 52 ? C.lane : 51;
      float mA[4][8]; load_mu8(mu, 3072 + 8 * lc, mA);
      float mK[2][4][8], kk[16]; load_mu8(mu, 1024 + 16 * C.lane, mK[0]); load_mu8(mu, 1024 + 16 * C.lane + 8, mK[1]);
#pragma unroll
      for (int i = 0; i < 16; ++i) kk[i] = a.in[I_KK][l * 1024 + 16 * C.lane + i];
#pragma unroll 2
      FOR_ROWS(t) {
          int nb[4], nn; shift_rows(t, nb, nn);
          float ua[8], u0[8], u1[8];
          shift8r(P, mA, t, 3072 + 8 * lc, nb, nn, ua); shift8r(P, mK[0], t, 1024 + 16 * C.lane, nb, nn, u0); shift8r(P, mK[1], t, 1024 + 16 * C.lane + 8, nb, nn, u1);
          const int cc = 8 * C.lane;
#pragma unroll
          for (int i = 0; i < 8; ++i) { if (cc < 128) ua[i] = tanhf(ua[i]); else if (cc >= 256) ua[i] = sigmoidf_(ua[i]); }
          v4u o = (v4u){pk2(ua[0], ua[1]), pk2(ua[2], ua[3]), pk2(ua[4], ua[5]), pk2(ua[6], ua[7])};
          if (C.lane >= 52) o = (v4u){0u, 0u, 0u, 0u};
          float ss = 0.f;
#pragma unroll
          for (int i = 0; i < 8; ++i) { const float x0 = u0[i] * kk[i], x1 = u1[i] * kk[8 + i]; ss += x0 * x0; ss += x1 * x1; }
          ss = quadsum(ss);
          *(v4u*)(LA + (size_t)t * LK + 8 * C.lane) = o;
          if ((C.lane & 3) == 0) KNRM[(size_t)t * 16 + (C.lane >> 2)] = ss; }
}
__device__ __forceinline__ void ph_prep(const Args& a, const Ctx& C, int l) {
    const bf16* P = (const bf16*)(a.ws + WS_P);
    const float* mu = a.in[I_MU] + (size_t)l * 4 * RWIN;
    bf16* LA = (bf16*)(a.ws + WS_LA);
    prep_rows(a, C, l, P, mu, LA, (float*)(a.ws + WS_KNRM));
    bf16* QR = (bf16*)(a.ws + WS_QR); bf16* KR = (bf16*)(a.ws + WS_KR);
    bf16* VT = (bf16*)(a.ws + WS_VT); bf16* KTF = (bf16*)(a.ws + WS_KTF); bf16* KTB = (bf16*)(a.ws + WS_KTB);
    LAS unsigned short* TL0 = (LAS unsigned short*)C.lds;
    constexpr int TP = 136, TSZ = 128 * TP;
    for (int un = C.bx; un < NCH * 8; un += C.G) {
        const int c = un >> 3, h = un & 7, t0 = 128 * c;
        const float l2f = a.in[I_L2D][(l * 2 + 0) * 8 + h], l2b = a.in[I_L2D][(l * 2 + 1) * 8 + h];
        const float lgf = log1pf(-exp2f(-l2f)), lgb = log1pf(-exp2f(-l2b));
        const int m = C.tid >> 2, p = C.tid & 3, t = t0 + m;
        const bool lat = c >= 2; const int pos = t - TC;
        const int half = p >> 1, ib = 16 * (p & 1);
        const int pvi = lat ? (half ? 256 + (pos & 63) : (pos >> 6)) : 0; const float* sct = (const float*)(a.ws + WS_SCT);
        const int d1 = 64 * half + ib;
        const bf16* prow = P + (size_t)t * PW + RET_OFF + 128 * h;
        float q1[16], q2[16], k1[16], k2[16];
        { const v4u a0 = *(const v4u*)(prow + d1), a1 = *(const v4u*)(prow + d1 + 8), b0 = *(const v4u*)(prow + d1 + 32), b1 = *(const v4u*)(prow + d1 + 40);
          const unsigned wa[8] = {a0.x, a0.y, a0.z, a0.w, a1.x, a1.y, a1.z, a1.w}, wb[8] = {b0.x, b0.y, b0.z, b0.w, b1.x, b1.y, b1.z, b1.w};
#pragma unroll
          for (int i = 0; i < 8; ++i) { q1[2 * i] = bf_lo(wa[i]); q1[2 * i + 1] = bf_hi(wa[i]); q2[2 * i] = bf_lo(wb[i]); q2[2 * i + 1] = bf_hi(wb[i]); } }
        { const bf16* kp = prow + 1024;
          const v4u a0 = *(const v4u*)(kp + d1), a1 = *(const v4u*)(kp + d1 + 8), b0 = *(const v4u*)(kp + d1 + 32), b1 = *(const v4u*)(kp + d1 + 40);
          const unsigned wa[8] = {a0.x, a0.y, a0.z, a0.w, a1.x, a1.y, a1.z, a1.w}, wb[8] = {b0.x, b0.y, b0.z, b0.w, b1.x, b1.y, b1.z, b1.w};
#pragma unroll
          for (int i = 0; i < 8; ++i) { k1[2 * i] = bf_lo(wa[i]); k1[2 * i + 1] = bf_hi(wa[i]); k2[2 * i] = bf_lo(wb[i]); k2[2 * i + 1] = bf_hi(wb[i]); } }
        const float ksc = 0.08838834764831845f;
#pragma unroll
        for (int i = 0; i < 16; ++i) {
            float cs = 1.f, sn = 0.f;
            if (lat) { const float* e2 = sct + ((size_t)pvi * 32 + ib + i) * 2; cs = e2[0]; sn = e2[1]; }
            const float qa = q1[i] * cs - q2[i] * sn, qb = q1[i] * sn + q2[i] * cs;
            const float ka = (k1[i] * cs - k2[i] * sn) * ksc, kb = (k1[i] * sn + k2[i] * cs) * ksc;
            q1[i] = qa; q2[i] = qb; k1[i] = ka; k2[i] = kb;
        }
        { bf16* qo = QR + (size_t)t * 1024 + 128 * h; bf16* ko = KR + (size_t)t * 1024 + 128 * h;
          *(v4u*)(qo + d1) = (v4u){pk2(q1[0], q1[1]), pk2(q1[2], q1[3]), pk2(q1[4], q1[5]), pk2(q1[6], q1[7])};
          *(v4u*)(qo + d1 + 8) = (v4u){pk2(q1[8], q1[9]), pk2(q1[10], q1[11]), pk2(q1[12], q1[13]), pk2(q1[14], q1[15])};
          *(v4u*)(qo + d1 + 32) = (v4u){pk2(q2[0], q2[1]), pk2(q2[2], q2[3]), pk2(q2[4], q2[5]), pk2(q2[6], q2[7])};
          *(v4u*)(qo + d1 + 40) = (v4u){pk2(q2[8], q2[9]), pk2(q2[10], q2[11]), pk2(q2[12], q2[13]), pk2(q2[14], q2[15])};
          *(v4u*)(ko + d1) = (v4u){pk2(k1[0], k1[1]), pk2(k1[2], k1[3]), pk2(k1[4], k1[5]), pk2(k1[6], k1[7])};
          *(v4u*)(ko + d1 + 8) = (v4u){pk2(k1[8], k1[9]), pk2(k1[10], k1[11]), pk2(k1[12], k1[13]), pk2(k1[14], k1[15])};
          *(v4u*)(ko + d1 + 32) = (v4u){pk2(k2[0], k2[1]), pk2(k2[2], k2[3]), pk2(k2[4], k2[5]), pk2(k2[6], k2[7])};
          *(v4u*)(ko + d1 + 40) = (v4u){pk2(k2[8], k2[9]), pk2(k2[10], k2[11]), pk2(k2[12], k2[13]), pk2(k2[14], k2[15])}; }
        const float zf = __expf(lgf * (float)(127 - m)), zb = __expf(lgb * (float)m);
#pragma unroll
        for (int i = 0; i < 16; ++i) {
            TL0[TSZ + (d1 + i) * TP + m] = f2bf1(k1[i] * zf);      TL0[TSZ + (d1 + 32 + i) * TP + m] = f2bf1(k2[i] * zf);
            TL0[2 * TSZ + (d1 + i) * TP + m] = f2bf1(k1[i] * zb);  TL0[2 * TSZ + (d1 + 32 + i) * TP + m] = f2bf1(k2[i] * zb);
        }
        { const bf16* vp = prow + 2048 + 32 * p;
#pragma unroll
          for (int j = 0; j < 4; ++j) { const v4u w = *(const v4u*)(vp + 8 * j); const unsigned ww[4] = {w.x, w.y, w.z, w.w};
#pragma unroll
              for (int i = 0; i < 4; ++i) { TL0[(32 * p + 8 * j + 2 * i) * TP + m] = (unsigned short)(ww[i] & 0xffffu); TL0[(32 * p + 8 * j + 2 * i + 1) * TP + m] = (unsigned short)(ww[i] >> 16); } } }
        __syncthreads();
        { const int d = C.tid >> 2, part = C.tid & 3; const size_t go = ((size_t)(h * NCH + c) * 128 + d) * 128 + 32 * part;
#pragma unroll
          for (int j = 0; j < 4; ++j) *(v4u*)(VT + go + 8 * j)  = *(const LAS v4u*)(TL0 + d * TP + 32 * part + 8 * j); }
        { const int fr = C.lane & 15, fq = C.lane >> 4; float* KVT = (float*)(a.ws + WS_KVT);
          bf16x8 A[4];
#pragma unroll
          for (int s = 0; s < 4; ++s) A[s] = *(const LAS bf16x8*)(TL0 + (16 * C.wave + fr) * TP + 32 * s + 8 * fq);
#pragma unroll
          for (int dir = 0; dir < 2; ++dir) { float* outp = KVT + ((size_t)dir * 8 * NCH + (size_t)(h * NCH + c)) * 16384;
#pragma unroll
              for (int n = 0; n < 8; ++n) { f32x4 acc = {0.f, 0.f, 0.f, 0.f};
#pragma unroll
                  for (int s = 0; s < 4; ++s) { const bf16x8 B = *(const LAS bf16x8*)(TL0 + (1 + dir) * TSZ + (16 * n + fr) * TP + 32 * s + 8 * fq); acc = __builtin_amdgcn_mfma_f32_16x16x32_bf16(B, A[s], acc, 0, 0, 0); }
                  *(f32x4*)(outp + (size_t)(16 * C.wave + fr) * 128 + 16 * n + 4 * fq) = acc; } } }
        __syncthreads();
    }
}

__device__ __forceinline__ void ph_ret_kv(const Args& a, const Ctx& C) {
    const bf16* VT = (const bf16*)(a.ws + WS_VT); float* KVT = (float*)(a.ws + WS_KVT);
    const int fr = C.lane & 15, fq = C.lane >> 4;
    for (int un = C.bx; un < 2 * 8 * NCH; un += C.G) {
        const int dir = un / (8 * NCH), hc = un % (8 * NCH);
        const bf16* KT = (const bf16*)(a.ws + (dir ? WS_KTB : WS_KTF)) + (size_t)hc * 16384;
        const bf16* vt = VT + (size_t)hc * 16384 + (size_t)(16 * C.wave + fr) * 128 + 8 * fq;
        bf16x8 A[4];
#pragma unroll
        for (int s = 0; s < 4; ++s) A[s] = *(const bf16x8*)(vt + 32 * s);
        float* outp = KVT + ((size_t)dir * 8 * NCH + hc) * 16384;
#pragma unroll
        for (int n = 0; n < 8; ++n) {
            f32x4 acc = {0.f, 0.f, 0.f, 0.f};
            const bf16* kt = KT + (size_t)(16 * n + fr) * 128 + 8 * fq;
#pragma unroll
            for (int s = 0; s < 4; ++s) { const bf16x8 B = *(const bf16x8*)(kt + 32 * s); acc = __builtin_amdgcn_mfma_f32_16x16x32_bf16(B, A[s], acc, 0, 0, 0); }
            *(f32x4*)(outp + (size_t)(16 * C.wave + fr) * 128 + 16 * n + 4 * fq) = acc;
        }
    }
}
__device__ __forceinline__ void ph_ret_prefix(const Args& a, const Ctx& C, int l) {
    const float* KVT = (const float*)(a.ws + WS_KVT); bf16* ST = (bf16*)(a.ws + WS_ST);
    for (int i = C.bx * NTHR + C.tid; i < 16 * 16384; i += C.G * NTHR) {
        const int dh = i >> 14, el = i & 16383, dir = dh >> 3, h = dh & 7;
        const float l2 = a.in[I_L2D][(l * 2 + dir) * 8 + h]; const float gC = __expf(128.0f * log1pf(-exp2f(-l2)));
        const float* kv = KVT + (size_t)dh * NCH * 16384 + el; bf16* st = ST + (size_t)dh * NCH * 16384 + el;
        float s = 0.f;
        for (int b0 = 0; b0 < NCH; b0 += 10) {
            float kvv[10]; int cc[10];
#pragma unroll
            for (int j = 0; j < 10; ++j) { const int o = b0 + j; cc[j] = dir == 0 ? o : (o < 2 ? 1 - o : (NCH + 1) - o); kvv[j] = kv[(size_t)cc[j] * 16384]; }
#pragma unroll
            for (int j = 0; j < 10; ++j) { st[(size_t)cc[j] * 16384] = f2bf1(s); s = s * gC + kvv[j]; }
        }
    }
}
__device__ __forceinline__ void ph_ret_out(const Args& a, const Ctx& C, int l, int ub, int nblk) {
    const bf16* QR = (const bf16*)(a.ws + WS_QR); const bf16* KR = (const bf16*)(a.ws + WS_KR); const bf16* VT = (const bf16*)(a.ws + WS_VT);
    const bf16* ST = (const bf16*)(a.ws + WS_ST); const bf16* P = (const bf16*)(a.ws + WS_P); bf16* YALL = (bf16*)(a.ws + WS_YALL);
    const int fr = C.lane & 15, fq = C.lane >> 4;
    constexpr int PP = 136, TSZ = 128 * PP;
    LAS unsigned short* T0 = (LAS unsigned short*)C.lds; LAS unsigned short* T1 = T0 + TSZ; LAS unsigned short* T2 = T1 + TSZ;
    LAS unsigned short* Pw = T0 + 3 * TSZ + C.wave * 16 * PP;
    for (int un = (l == NL - 1 ? (TC / 128) * 8 : 0) + ub; un < NCH * 8; un += nblk) {
        const int c = un >> 3, h = un & 7, t0 = 128 * c, hc = h * NCH + c, rs = C.wave;
        const float l2f = a.in[I_L2D][(l * 2 + 0) * 8 + h], l2b = a.in[I_L2D][(l * 2 + 1) * 8 + h];
        const float lgf2 = log1pf(-exp2f(-l2f)) * 1.4426950408889634f, lgb2 = log1pf(-exp2f(-l2b)) * 1.4426950408889634f;
#pragma unroll
        for (int j = 0; j < 4; ++j) { const int pc = C.tid + NTHR * j, r = pc >> 4, c16 = pc & 15;
            *(LAS v4u*)(T0 + r * PP + 8 * c16) = __builtin_nontemporal_load((const v4u*)(KR + (size_t)(t0 + r) * 1024 + 128 * h + 8 * c16)); }
        bf16x8 QA[4];
        { const bf16* qp = QR + (size_t)(t0 + 16 * rs + fr) * 1024 + 128 * h + 8 * fq;
#pragma unroll
          for (int s = 0; s < 4; ++s) QA[s] = __builtin_nontemporal_load((const bf16x8*)(qp + 32 * s)); }
        __syncthreads();
#pragma unroll
        for (int j = 0; j < 8; ++j) {
            f32x4 acc = {0.f, 0.f, 0.f, 0.f};
#pragma unroll
            for (int s = 0; s < 4; ++s) { const bf16x8 B = *(const LAS bf16x8*)(T0 + (16 * j + fr) * PP + 32 * s + 8 * fq); acc = __builtin_amdgcn_mfma_f32_16x16x32_bf16(QA[s], B, acc, 0, 0, 0); }
#pragma unroll
            for (int r = 0; r < 4; ++r) { const int n = 16 * rs + 4 * fq + r, m = 16 * j + fr, df = n - m;
                const float f = df >= 0 ? exp2f(lgf2 * (float)df) : exp2f(lgb2 * (float)(-df));
                Pw[(4 * fq + r) * PP + m] = f2bf1(acc[r] * f); }
        }
        __syncthreads();
#pragma unroll
        for (int j = 0; j < 4; ++j) { const int pc = C.tid + NTHR * j, r = pc >> 4, c16 = pc & 15; const size_t go = (size_t)hc * 16384 + (size_t)r * 128 + 8 * c16;
            *(LAS v4u*)(T0 + r * PP + 8 * c16) = __builtin_nontemporal_load((const v4u*)(VT + go));
            *(LAS v4u*)(T1 + r * PP + 8 * c16) = __builtin_nontemporal_load((const v4u*)(ST + (size_t)(0 * 8) * NCH * 16384 + go));
            *(LAS v4u*)(T2 + r * PP + 8 * c16) = __builtin_nontemporal_load((const v4u*)(ST + (size_t)(1 * 8) * NCH * 16384 + go)); }
        __syncthreads();
        f32x4 aY[8];
        bf16x8 PA[4];
#pragma unroll
        for (int s = 0; s < 4; ++s) PA[s] = *(const LAS bf16x8*)(Pw + fr * PP + 32 * s + 8 * fq);
        const int n = 16 * rs + fr;
        const float xf = exp2f(lgf2 * (float)(n + 1)), xb = exp2f(lgb2 * (float)(128 - n));
        float ss = 0.f;
#pragma unroll
        for (int j = 0; j < 8; ++j) {
            const int dvr = 32 * (j >> 1) + 8 * (fr >> 2) + 4 * (j & 1) + (fr & 3);
            f32x4 y = {0.f, 0.f, 0.f, 0.f}, zf = y, zb = y;
#pragma unroll
            for (int s = 0; s < 4; ++s) {
                const bf16x8 Av = *(const LAS bf16x8*)(T0 + dvr * PP + 32 * s + 8 * fq), Af = *(const LAS bf16x8*)(T1 + dvr * PP + 32 * s + 8 * fq), Ab = *(const LAS bf16x8*)(T2 + dvr * PP + 32 * s + 8 * fq);
                y = __builtin_amdgcn_mfma_f32_16x16x32_bf16(Av, PA[s], y, 0, 0, 0);
                zf = __builtin_amdgcn_mfma_f32_16x16x32_bf16(Af, QA[s], zf, 0, 0, 0);
                zb = __builtin_amdgcn_mfma_f32_16x16x32_bf16(Ab, QA[s], zb, 0, 0, 0);
            }
#pragma unroll
            for (int r = 0; r < 4; ++r) { const float v = y[r] + xf * zf[r] + xb * zb[r]; y[r] = v; ss += v * v; }
            aY[j] = y;
            asm volatile("" : "+v"(aY[j]));
        }
        ss += __shfl_xor(ss, 16); ss += __shfl_xor(ss, 32);
        const float rstd = rsqrtf(ss * (1.0f / 128.0f) + 1e-6f);
        const int t = t0 + n;
#pragma unroll
        for (int m = 0; m < 4; ++m) { const int dv0 = 32 * m + 8 * fq;
            const f32x4 w0 = *(const f32x4*)(a.in[I_GNW] + l * 1024 + 128 * h + dv0), w1 = *(const f32x4*)(a.in[I_GNW] + l * 1024 + 128 * h + dv0 + 4);
            const v4u gq = __builtin_nontemporal_load((const v4u*)(P + (size_t)t * PW + RET_OFF + 3072 + 128 * h + dv0));
            const float g8[8] = {bf_lo(gq.x), bf_hi(gq.x), bf_lo(gq.y), bf_hi(gq.y), bf_lo(gq.z), bf_hi(gq.z), bf_lo(gq.w), bf_hi(gq.w)};
            const float w8[8] = {w0.x, w0.y, w0.z, w0.w, w1.x, w1.y, w1.z, w1.w};
            float o[8];
#pragma unroll
            for (int i = 0; i < 8; ++i) { const float yv = (i < 4) ? aY[2 * m][i] : aY[2 * m + 1][i - 4]; o[i] = yv * rstd * w8[i] * g8[i] * sigmoidf_(g8[i]); }
            *(v4u*)(YALL + (size_t)t * D + 1024 + 128 * h + dv0) = (v4u){pk2(o[0], o[1]), pk2(o[2], o[3]), pk2(o[4], o[5]), pk2(o[6], o[7])}; }
        __syncthreads();
    }
}

constexpr int NCK = T / 32;
__device__ __forceinline__ int scan_row(int s, int dir) { return dir ? (s < TC ? TC - 1 - s : (T + TC - 1) - s) : s; }
__device__ __forceinline__ int pos_c(int c) { return 32 * (c >> 5) + 8 * ((c >> 2) & 3) + 4 * ((c >> 4) & 1) + (c & 3); }
__device__ __forceinline__ int pos_i(int i) { return 8 * ((i >> 2) & 3) + 4 * (i >> 4) + (i & 3); }
__device__ __forceinline__ float wave_sum_all(float v) {
    v = rowsum16(v);
    const float a = __builtin_bit_cast(float, __builtin_amdgcn_readlane(__builtin_bit_cast(int, v), 0)), b = __builtin_bit_cast(float, __builtin_amdgcn_readlane(__builtin_bit_cast(int, v), 16));
    const float c = __builtin_bit_cast(float, __builtin_amdgcn_readlane(__builtin_bit_cast(int, v), 32)), d = __builtin_bit_cast(float, __builtin_amdgcn_readlane(__builtin_bit_cast(int, v), 48));
    return (a + b) + (c + d);
}
__device__ __forceinline__ float ldbf(const bf16* p) { return __uint_as_float((unsigned)(*p) << 16); }

__device__ __forceinline__ void rwkv_mats_unit(const Args& a, const Ctx& C, int cs, LAS float* LA, const LAS unsigned char* bk);
__device__ __forceinline__ void ld8(const bf16* p, float (&o)[8]) { const v4u w = *(const v4u*)p; o[0] = bf_lo(w.x); o[1] = bf_hi(w.x); o[2] = bf_lo(w.y); o[3] = bf_hi(w.y); o[4] = bf_lo(w.z); o[5] = bf_hi(w.z); o[6] = bf_lo(w.w); o[7] = bf_hi(w.w); }
__device__ __forceinline__ float seg_scan32(float x) {
    x += dppf<0x111>(x); x += dppf<0x112>(x); x += dppf<0x114>(x); x += dppf<0x118>(x);
    x += __builtin_bit_cast(float, __builtin_amdgcn_update_dpp(0, __builtin_bit_cast(int, x), 0x142, 0xa, 0xf, false));
    return x;
}
template <int ST> __device__ __forceinline__ void ph_rwkv_prep(const Args& a, const Ctx& C, int l) {
    const bf16* P = (const bf16*)(a.ws + WS_P); const bf16* LO = (const bf16*)(a.ws + WS_LORA); const float* KNRM = (const float*)(a.ws + WS_KNRM);
    bf16* AGP = (bf16*)(a.ws + WS_AGP); bf16* RGP = (bf16*)(a.ws + WS_RGP);
    bf16* KGT = (bf16*)(a.ws + WS_KGT); bf16* BGT = (bf16*)(a.ws + WS_BGT); bf16* VTP = (bf16*)(a.ws + WS_VTP); float* GC = (float*)(a.ws + WS_GC);
    float* BONP = (float*)(a.ws + WS_BON);
    const int gsel = C.lane >> 5, tok = C.lane & 31;
    LAS unsigned short* tl = (LAS unsigned short*)(C.lds + 65536 + C.wave * 9216);
    LAS unsigned char* bkw = C.lds + (((C.wave >> 2) & 1) * 2 + gsel) * 2 * 8192;
    const int nwv = C.NGW & ~63, hq = C.gw & 63, q = hq & 3, h = hq >> 2;
    for (int un = C.gw; (un & ~7) < (NCK / 2) * 64 && C.gw < nwv; un += nwv) {
        const int pp = un >> 6;
        const int g = 2 * pp + gsel, t = 32 * g + tok;
        const int s = q >> 1, fqb = 2 * (q & 1), lcA = 32 * s + 4 * fqb, lcB = lcA + 16;
        const int chA = 64 * h + lcA, chB = 64 * h + lcB;
        int nb[4], nn; shift_rows(t, nb, nn);
        float onf[4], hasf[4]; int nrow[4];
#pragma unroll
        for (int j = 0; j < 4; ++j) { onf[j] = (j < nn) ? 1.0f : 0.0f; hasf[j] = (nb[j] >= 0) ? 1.0f : 0.0f; nrow[j] = nb[j] >= 0 ? nb[j] : t; }
        float r[16], k[16], v[16];
#pragma unroll
        for (int arr = 0; arr < 3; ++arr) {
#pragma unroll
            for (int run = 0; run < 2; ++run) {
                const int cc = 1024 * arr + (run ? chB : chA);
                float pc[8], u[8]; ld8(P + (size_t)t * PW + cc, pc);
#pragma unroll
                for (int i = 0; i < 8; ++i) u[i] = pc[i];
#pragma unroll
                for (int j = 0; j < 4; ++j) { float n8[8]; ld8(P + (size_t)nrow[j] * PW + cc, n8);
                    const CAS float* mu = (const CAS float*)a.in[I_MU] + ((size_t)l * 4 + j) * RWIN + cc;
#pragma unroll
                    for (int i = 0; i < 8; ++i) u[i] += onf[j] * mu[i] * (hasf[j] * n8[i] - pc[i]); }
#pragma unroll
                for (int i = 0; i < 8; ++i) { if (arr == 0) r[8 * run + i] = u[i]; else if (arr == 1) k[8 * run + i] = u[i]; else v[8 * run + i] = u[i]; }
            }
        }
        const float rn = __builtin_amdgcn_rcpf(fmaxf(__builtin_amdgcn_sqrtf(KNRM[(size_t)t * 16 + h]), 1e-12f));
        float kk[16];
#pragma unroll
        for (int i = 0; i < 16; ++i) kk[i] = k[i] * ((const CAS float*)a.in[I_KK])[l * 1024 + (i < 8 ? chA + i : chB + i - 8)] * rn;
#pragma unroll
        for (int d = 0; d < 2; ++d) {
            const int c = d == 0 ? g : (g < 8 ? 7 - g : (NCK + 7) - g);
            const int cs = (d * 16 + h) * NCK + c, ii = d ? 31 - tok : tok, pi = pos_i(ii);
            const bf16* lo = LO + (size_t)t * LNN + d * 1024;
            float bon = 0.f, gcv = 0.f;
            const size_t po = (size_t)cs * 2048 + ((ii >> 4) * 2 + s) * 512 + (ii & 15) * 8;
#pragma unroll
            for (int f = 0; f < 2; ++f) {
                float ag[8], rg[8], bg[8], kg[8], lwv[8], lav[8];
                { const v2u wa = *(const v2u*)(lo + chA + 4 * f), wb = *(const v2u*)(lo + chB + 4 * f), xa = *(const v2u*)(lo + 2048 + chA + 4 * f), xb = *(const v2u*)(lo + 2048 + chB + 4 * f);
                  lwv[0] = bf_lo(wa.x); lwv[1] = bf_hi(wa.x); lwv[2] = bf_lo(wa.y); lwv[3] = bf_hi(wa.y); lwv[4] = bf_lo(wb.x); lwv[5] = bf_hi(wb.x); lwv[6] = bf_lo(wb.y); lwv[7] = bf_hi(wb.y);
                  lav[0] = bf_lo(xa.x); lav[1] = bf_hi(xa.x); lav[2] = bf_lo(xa.y); lav[3] = bf_hi(xa.y); lav[4] = bf_lo(xb.x); lav[5] = bf_hi(xb.x); lav[6] = bf_lo(xb.y); lav[7] = bf_hi(xb.y); }
#pragma unroll
                for (int e = 0; e < 8; ++e) {
                    const int i = (e < 4) ? 4 * f + e : 8 + 4 * f + (e - 4);
                    const int ch = (i < 8 ? chA + i : chB + i - 8), lc = (i < 8 ? lcA + i : lcB + i - 8);
                    const float x = ((const CAS float*)a.in[I_W0])[(size_t)(l * 2 + d) * 1024 + ch] + lwv[e], z = -x;
                    const float sp = fmaxf(z, 0.f) + __logf(1.0f + __expf(-fabsf(z)));
                    const float lw = -__expf(-sp - 0.5f);
                    const float av = __builtin_amdgcn_rcpf(1.0f + __expf(-(((const CAS float*)a.in[I_A0])[(size_t)(l * 2 + d) * 1024 + ch] + lav[e])));
                    const float kd = k[i] * (1.0f + (av - 1.0f) * ((const CAS float*)a.in[I_KA])[l * 1024 + ch]), b = kk[i] * av;
                    float inc = seg_scan32(lw);
                    const float t31 = __builtin_bit_cast(float, __builtin_amdgcn_readlane(__builtin_bit_cast(int, inc), 31)), t63 = __builtin_bit_cast(float, __builtin_amdgcn_readlane(__builtin_bit_cast(int, inc), 63));
                    const float tot = gsel ? t63 : t31;
                    if (d) inc = tot - inc + lw;
                    gcv = (tok == i) ? tot : gcv;
                    const float gp = __expf(inc - lw), gt = __expf(inc), gi = __expf(-inc);
                    ag[e] = kk[i] * gp; rg[e] = r[i] * gt; bg[e] = b * gi; kg[e] = kd * gi;
                    bon += r[i] * kd * ((const CAS float*)a.in[I_RK])[l * 1024 + ch];
                    if (ST & 2) { const int to = i * 64 + 32 * gsel + pi; tl[to] = f2bf1(kg[e]); tl[1024 + to] = f2bf1(-bg[e]); tl[2048 + to] = f2bf1(v[i]); } else asm volatile("" :: "v"(kg[e]), "v"(bg[e]));
                }
                const size_t o = po + (size_t)(fqb + f) * 128;
                if (ST & 1) {
                *(v4u*)(AGP + o) = (v4u){pk2(ag[0], ag[1]), pk2(ag[2], ag[3]), pk2(ag[4], ag[5]), pk2(ag[6], ag[7])};
                *(v4u*)(RGP + o) = (v4u){pk2(rg[0], rg[1]), pk2(rg[2], rg[3]), pk2(rg[4], rg[5]), pk2(rg[6], rg[7])};
                { const int pfe = (int)(o - (size_t)cs * 2048);
                  *(LAS v4u*)(bkw + d * 8192 + pfe * 2) = (v4u){pk2(bg[0], bg[1]), pk2(bg[2], bg[3]), pk2(bg[4], bg[5]), pk2(bg[6], bg[7])};
                  *(LAS v4u*)(bkw + d * 8192 + 4096 + pfe * 2) = (v4u){pk2(kg[0], kg[1]), pk2(kg[2], kg[3]), pk2(kg[4], kg[5]), pk2(kg[6], kg[7])}; }
                } else asm volatile("" :: "v"(ag[0] + ag[1] + ag[2] + ag[3] + ag[4] + ag[5] + ag[6] + ag[7]), "v"(rg[0] + rg[1] + rg[2] + rg[3] + rg[4] + rg[5] + rg[6] + rg[7]));
            }
            if (ST & 2) {
                LDS_WAIT();
                const int kl = C.lane & 15, gs = (C.lane >> 4) & 1, op = C.lane >> 5, lcl = kl < 8 ? lcA + kl : lcB + kl - 8;
                const int gg = 2 * pp + gs, cg = d == 0 ? gg : (gg < 8 ? 7 - gg : (NCK + 7) - gg);
                const size_t ob = (size_t)((d * 16 + h) * NCK + cg) * 2048 + ((lcl >> 4) * 64 + (lcl & 15)) * 8;
#pragma unroll
                for (int oo = 0; oo < 2; ++oo) { const int o = 2 * op + oo; const int la = kl * 64 + 32 * gs + 8 * o;
                    *(v4u*)(KGT + ob + o * 128) = *(const LAS v4u*)(tl + la); *(v4u*)(BGT + ob + o * 128) = *(const LAS v4u*)(tl + 1024 + la); *(v4u*)(VTP + ob + o * 128) = *(const LAS v4u*)(tl + 2048 + la); }
                LDS_WAIT();
            }
            if (ST & 4) BONP[((size_t)(d * 16 + h) * 4 + q) * T + t] = bon; else asm volatile("" :: "v"(bon));
            if ((ST & 4) && tok < 16) GC[(size_t)cs * 64 + (tok < 8 ? lcA + tok : lcB + tok - 8)] = __expf(gcv);
        }
        asm volatile("s_waitcnt vmcnt(0)" ::: "memory");
        __syncthreads();
        { const int hh = (C.wave >> 2) & 1, gs2 = (C.wave >> 1) & 1, d2 = C.wave & 1;
          const int h2 = ((C.gw & ~7) & 63) / 4 + hh, g2 = 2 * pp + gs2, c2 = d2 == 0 ? g2 : (g2 < 8 ? 7 - g2 : (NCK + 7) - g2);
          rwkv_mats_unit(a, C, (d2 * 16 + h2) * NCK + c2, (LAS float*)(C.lds + 65536 + C.wave * 9216), C.lds + ((hh * 2 + gs2) * 2 + d2) * 8192); }
        __syncthreads();
    }
}

__device__ __forceinline__ void rwkv_mats_unit(const Args& a, const Ctx& C, int cs, LAS float* LA, const LAS unsigned char* bk) {
    const bf16* AGP = (const bf16*)(a.ws + WS_AGP); const bf16* RGP = (const bf16*)(a.ws + WS_RGP);
    bf16* TPm = (bf16*)(a.ws + WS_TP); bf16* AAK = (bf16*)(a.ws + WS_AAK); bf16* ARK = (bf16*)(a.ws + WS_ARK); bf16* ARB = (bf16*)(a.ws + WS_ARB);
    LAS float* LT = LA + 32 * 36;
    {
        int ln = C.lane; asm volatile("" : "+v"(ln));
        const int fr = ln & 15, fq = ln >> 4;
        const size_t o = (size_t)cs * 2048 + ln * 8;
        bf16x8 AG[2][2], RG[2][2], BG[2][2], KG[2][2];
#pragma unroll
        for (int tt = 0; tt < 2; ++tt)
#pragma unroll
            for (int s = 0; s < 2; ++s) { const size_t off = o + (tt * 2 + s) * 512;
                AG[tt][s] = *(const bf16x8*)(AGP + off); RG[tt][s] = *(const bf16x8*)(RGP + off);
                BG[tt][s] = *(const LAS bf16x8*)(bk + ((tt * 2 + s) * 512 + ln * 8) * 2); KG[tt][s] = *(const LAS bf16x8*)(bk + 4096 + ((tt * 2 + s) * 512 + ln * 8) * 2); }
#pragma unroll
        for (int tt = 0; tt < 2; ++tt) {
            f32x4 ab[2], ak[2], rk[2], rb[2];
#pragma unroll
            for (int it = 0; it < 2; ++it) {
                ab[it] = (f32x4){0.f, 0.f, 0.f, 0.f}; ak[it] = ab[it]; rk[it] = ab[it]; rb[it] = ab[it];
                if (it <= tt) {
#pragma unroll
                    for (int s = 0; s < 2; ++s) {
                        ab[it] = __builtin_amdgcn_mfma_f32_16x16x32_bf16(BG[it][s], AG[tt][s], ab[it], 0, 0, 0);
                        ak[it] = __builtin_amdgcn_mfma_f32_16x16x32_bf16(KG[it][s], AG[tt][s], ak[it], 0, 0, 0);
                        rk[it] = __builtin_amdgcn_mfma_f32_16x16x32_bf16(KG[it][s], RG[tt][s], rk[it], 0, 0, 0);
                        rb[it] = __builtin_amdgcn_mfma_f32_16x16x32_bf16(BG[it][s], RG[tt][s], rb[it], 0, 0, 0);
                    }
                    const int t = 16 * tt + fr;
#pragma unroll
                    for (int r = 0; r < 4; ++r) { const int i = 16 * it + 4 * fq + r;
                        if (i >= t) { ab[it][r] = 0.f; ak[it][r] = 0.f; }
                        if (i > t) { rk[it][r] = 0.f; rb[it][r] = 0.f; } }
                }
                *(LAS f32x4*)(LA + (16 * tt + fr) * 36 + 16 * it + 4 * fq) = ab[it];
            }
            if (tt == 0) { const size_t so = (size_t)cs * 1024 + ln * 4;
                *(v2u*)(AAK + so) = (v2u){pk2(ak[0][0], ak[0][1]), pk2(ak[0][2], ak[0][3])};
                *(v2u*)(ARK + so) = (v2u){pk2(rk[0][0], rk[0][1]), pk2(rk[0][2], rk[0][3])};
                *(v2u*)(ARB + so) = (v2u){pk2(-rb[0][0], -rb[0][1]), pk2(-rb[0][2], -rb[0][3])}; }
            else { const size_t so = (size_t)cs * 1024 + 256 + ln * 8;
                *(v4u*)(AAK + so) = (v4u){pk2(ak[0][0], ak[0][1]), pk2(ak[0][2], ak[0][3]), pk2(ak[1][0], ak[1][1]), pk2(ak[1][2], ak[1][3])};
                *(v4u*)(ARK + so) = (v4u){pk2(rk[0][0], rk[0][1]), pk2(rk[0][2], rk[0][3]), pk2(rk[1][0], rk[1][1]), pk2(rk[1][2], rk[1][3])};
                *(v4u*)(ARB + so) = (v4u){pk2(-rb[0][0], -rb[0][1]), pk2(-rb[0][2], -rb[0][3]), pk2(-rb[1][0], -rb[1][1]), pk2(-rb[1][2], -rb[1][3])}; }
        }
        LDS_WAIT();
        const int n = ln & 31;
        float x[32];
#pragma unroll
        for (int t = 0; t < 32; ++t) {
            float s = (t == n) ? 1.0f : 0.0f;
#pragma unroll
            for (int m = 0; m < (t + 3) / 4; ++m) { const f32x4 av = *(const LAS f32x4*)(LA + t * 36 + 4 * m);
                if (4 * m + 0 < t) s -= av.x * x[4 * m + 0];
                if (4 * m + 1 < t) s -= av.y * x[4 * m + 1];
                if (4 * m + 2 < t) s -= av.z * x[4 * m + 2];
                if (4 * m + 3 < t) s -= av.w * x[4 * m + 3]; }
            x[t] = s; LT[t * 36 + n] = s;
        }
        LDS_WAIT();
#pragma unroll
        for (int tt = 0; tt < 2; ++tt) { const LAS float* row = LT + (16 * tt + fr) * 36;
            const f32x4 lo = *(const LAS f32x4*)(row + 4 * fq), hi = *(const LAS f32x4*)(row + 16 + 4 * fq);
            if (tt == 0) *(v2u*)(TPm + (size_t)cs * 1024 + ln * 4) = (v2u){pk2(lo.x, lo.y), pk2(lo.z, lo.w)};
            else *(v4u*)(TPm + (size_t)cs * 1024 + 256 + ln * 8) = (v4u){pk2(lo.x, lo.y), pk2(lo.z, lo.w), pk2(hi.x, hi.y), pk2(hi.z, hi.w)}; }
        LDS_WAIT();
    }
}

__device__ __forceinline__ bf16x8 pack_acc2(const f32x4& lo, const f32x4& hi) {
    v4u w = {pk2(lo[0], lo[1]), pk2(lo[2], lo[3]), pk2(hi[0], hi[1]), pk2(hi[2], hi[3])};
    return __builtin_bit_cast(bf16x8, w);
}
struct SeqOpsA { bf16x8 AG[2][2], TPf[2], AK[2], KT[4], BT[4], VB; f32x4 GCv[4]; };
struct SeqOpsB { bf16x8 RG[2][2], RK[2], RB[2]; };
__device__ __forceinline__ void ph_rwkv_seq(const Args& a, const Ctx& C, int hd, int vs) {
    const int fq = C.lane >> 4;
    const bf16* AGP = (const bf16*)(a.ws + WS_AGP); const bf16* KGT = (const bf16*)(a.ws + WS_KGT); const bf16* BGT = (const bf16*)(a.ws + WS_BGT);
    const bf16* VTP = (const bf16*)(a.ws + WS_VTP); const float* GC = (const float*)(a.ws + WS_GC);
    const bf16* TPm = (const bf16*)(a.ws + WS_TP); const bf16* AAK = (const bf16*)(a.ws + WS_AAK);
    const size_t ol = (size_t)C.lane * 8;
#define SEQ_LD64(dst, base, cs_, tt, s) dst = *(const bf16x8*)((base) + (size_t)(cs_) * 2048 + ((tt) * 2 + (s)) * 512 + ol)
#define SEQ_LD32(dst, base, cs_, tt) do { if ((tt) == 0) { const v2u w_ = *(const v2u*)((base) + (size_t)(cs_) * 1024 + C.lane * 4); dst = __builtin_bit_cast(bf16x8, (v4u){w_.x, w_.y, 0u, 0u}); } \
        else dst = *(const bf16x8*)((base) + (size_t)(cs_) * 1024 + 256 + ol); } while (0)
#define SEQ_LDT(dst, base, cs_, mt) dst = *(const bf16x8*)((base) + (size_t)(cs_) * 2048 + (mt) * 512 + ol)
#define SEQA_LOAD1(O, cs_) do { _Pragma("unroll") for (int tt = 0; tt < 2; ++tt) { _Pragma("unroll") for (int s = 0; s < 2; ++s) SEQ_LD64(O.AG[tt][s], AGP, cs_, tt, s); SEQ_LD32(O.AK[tt], AAK, cs_, tt); } } while (0)
#define SEQA_LOAD2(O, cs_) do { _Pragma("unroll") for (int tt = 0; tt < 2; ++tt) SEQ_LD32(O.TPf[tt], TPm, cs_, tt); } while (0)
#define SEQA_LOAD3(O, cs_) do { _Pragma("unroll") for (int mt = 0; mt < 4; ++mt) { SEQ_LDT(O.KT[mt], KGT, cs_, mt); SEQ_LDT(O.BT[mt], BGT, cs_, mt); O.GCv[mt] = *(const f32x4*)(GC + (size_t)(cs_) * 64 + 16 * mt + 4 * fq); } SEQ_LDT(O.VB, VTP, cs_, vs); } while (0)
    const int cs0 = hd * NCK;
    SeqOpsA P0, P1;
    SEQA_LOAD1(P0, cs0); SEQA_LOAD2(P0, cs0); SEQA_LOAD3(P0, cs0);
    SEQA_LOAD1(P1, cs0 + 1); SEQA_LOAD2(P1, cs0 + 1); SEQA_LOAD3(P1, cs0 + 1);
    f32x4 Hc[4];
#pragma unroll
    for (int mt = 0; mt < 4; ++mt) Hc[mt] = (f32x4){0.f, 0.f, 0.f, 0.f};
    bf16x8 Hb[2]; Hb[0] = pack_acc2(Hc[0], Hc[1]); Hb[1] = pack_acc2(Hc[2], Hc[3]);
    volatile LAS int* prog = (volatile LAS int*)(C.lds + MISC_OFF + 64);
    volatile LAS int* fa = (volatile LAS int*)(C.lds + MISC_OFF + 68);
    volatile LAS int* fb = (volatile LAS int*)(C.lds + MISC_OFF + 72);
    LAS unsigned char* ring = C.lds;
#define SEQA_BODY(O, c) do { \
        if (C.lane == 0) *prog = (c); \
        const int cn = cs0 + ((c) + 2 < NCK ? (c) + 2 : NCK - 1); \
        LAS unsigned char* slot = ring + ((c) & 7) * 4096 + C.lane * 16; \
        if ((c) >= 8) { unsigned sp = 0; while (*fb < (c) - 7 && ++sp < (1u << 24)) __builtin_amdgcn_s_sleep(1); } \
        *(LAS bf16x8*)slot = Hb[0]; *(LAS bf16x8*)(slot + 1024) = Hb[1]; *(LAS bf16x8*)(slot + 3072) = O.VB; \
        f32x4 RH[2], U[2]; \
        _Pragma("unroll") for (int tt = 0; tt < 2; ++tt) { RH[tt] = (f32x4){0.f, 0.f, 0.f, 0.f}; \
            _Pragma("unroll") for (int s = 0; s < 2; ++s) RH[tt] = __builtin_amdgcn_mfma_f32_16x16x32_bf16(O.AG[tt][s], Hb[s], RH[tt], 0, 0, 0); \
            RH[tt] = __builtin_amdgcn_mfma_f32_16x16x32_bf16(O.AK[tt], O.VB, RH[tt], 0, 0, 0); } \
        SEQA_LOAD1(O, cn); \
        const bf16x8 RHb = pack_acc2(RH[0], RH[1]); \
        _Pragma("unroll") for (int tt = 0; tt < 2; ++tt) U[tt] = __builtin_amdgcn_mfma_f32_16x16x32_bf16(O.TPf[tt], RHb, (f32x4){0.f, 0.f, 0.f, 0.f}, 0, 0, 0); \
        SEQA_LOAD2(O, cn); \
        const bf16x8 Ub = pack_acc2(U[0], U[1]); \
        *(LAS bf16x8*)(slot + 2048) = Ub; \
        asm volatile("s_waitcnt lgkmcnt(0)" ::: "memory"); \
        if (C.lane == 0) *fa = (c) + 1; \
        _Pragma("unroll") for (int mt = 0; mt < 4; ++mt) { \
            Hc[mt] = __builtin_amdgcn_mfma_f32_16x16x32_bf16(O.KT[mt], O.VB, Hc[mt], 0, 0, 0); \
            Hc[mt] = __builtin_amdgcn_mfma_f32_16x16x32_bf16(O.BT[mt], Ub, Hc[mt], 0, 0, 0); \
            Hc[mt] = Hc[mt] * O.GCv[mt]; } \
        SEQA_LOAD3(O, cn); \
        Hb[0] = pack_acc2(Hc[0], Hc[1]); Hb[1] = pack_acc2(Hc[2], Hc[3]); } while (0)
    for (int c = 0; c < NCK; c += 2) { SEQA_BODY(P0, c); SEQA_BODY(P1, c + 1); }
    if (C.lane == 0) *prog = NCK + 64;
#undef SEQA_BODY
#undef SEQA_LOAD1
#undef SEQA_LOAD2
#undef SEQA_LOAD3
}
__device__ __forceinline__ void ph_rwkv_seq_y(const Args& a, const Ctx& C, int hd, int vs) {
    const int d = hd >> 4, h = hd & 15, fr = C.lane & 15, fq = C.lane >> 4;
    const bf16* RGP = (const bf16*)(a.ws + WS_RGP); const bf16* VTP = (const bf16*)(a.ws + WS_VTP); const bf16* ARK = (const bf16*)(a.ws + WS_ARK); const bf16* ARB = (const bf16*)(a.ws + WS_ARB);
    bf16* YF = (bf16*)(a.ws + WS_SY) + (size_t)d * T * 1024 + 64 * h + 16 * vs + 4 * fq;
    const size_t ol = (size_t)C.lane * 8;
    const int cs0 = hd * NCK;
#define SEQB_LOAD(O, cs_) do { _Pragma("unroll") for (int tt = 0; tt < 2; ++tt) { _Pragma("unroll") for (int s = 0; s < 2; ++s) SEQ_LD64(O.RG[tt][s], RGP, cs_, tt, s); SEQ_LD32(O.RK[tt], ARK, cs_, tt); SEQ_LD32(O.RB[tt], ARB, cs_, tt); } } while (0)
    SeqOpsB P0, P1;
    SEQB_LOAD(P0, cs0); SEQB_LOAD(P1, cs0 + 1);
    volatile LAS int* fa = (volatile LAS int*)(C.lds + MISC_OFF + 68);
    volatile LAS int* fb = (volatile LAS int*)(C.lds + MISC_OFF + 72);
    LAS unsigned char* ring = C.lds;
#define SEQB_BODY(O, c) do { \
        const int cn = cs0 + ((c) + 2 < NCK ? (c) + 2 : NCK - 1); \
        const int ystep = d ? -1 : 1, yrow0 = d ? ((c) < 8 ? TC - 1 : T + TC - 1) : 0; \
        { unsigned sp = 0; while (*fa <= (c) && ++sp < (1u << 24)) __builtin_amdgcn_s_sleep(1); } \
        asm volatile("" ::: "memory"); \
        const LAS unsigned char* slot = ring + ((c) & 7) * 4096 + C.lane * 16; \
        const bf16x8 H0 = *(const LAS bf16x8*)slot, H1 = *(const LAS bf16x8*)(slot + 1024), Ub = *(const LAS bf16x8*)(slot + 2048), VBs = *(const LAS bf16x8*)(slot + 3072); \
        asm volatile("s_waitcnt lgkmcnt(0)" ::: "memory"); \
        if (C.lane == 0) *fb = (c) + 1; \
        f32x4 Y[2];     \
        _Pragma("unroll") for (int tt = 0; tt < 2; ++tt) { Y[tt] = (f32x4){0.f, 0.f, 0.f, 0.f}; \
            Y[tt] = __builtin_amdgcn_mfma_f32_16x16x32_bf16(H0, O.RG[tt][0], Y[tt], 0, 0, 0); \
            Y[tt] = __builtin_amdgcn_mfma_f32_16x16x32_bf16(H1, O.RG[tt][1], Y[tt], 0, 0, 0); \
            Y[tt] = __builtin_amdgcn_mfma_f32_16x16x32_bf16(VBs, O.RK[tt], Y[tt], 0, 0, 0); \
            Y[tt] = __builtin_amdgcn_mfma_f32_16x16x32_bf16(Ub, O.RB[tt], Y[tt], 0, 0, 0); } \
        SEQB_LOAD(O, cn); \
        _Pragma("unroll") for (int tt = 0; tt < 2; ++tt) *(v2u*)(YF + (size_t)(unsigned)((yrow0 + ystep * (32 * (c) + 16 * tt + fr)) * 1024)) = (v2u){pk2(Y[tt][0], Y[tt][1]), pk2(Y[tt][2], Y[tt][3])}; } while (0)
    for (int c = 0; c < NCK; c += 2) { SEQB_BODY(P0, c); SEQB_BODY(P1, c + 1); }
#undef SEQB_BODY
#undef SEQB_LOAD
#undef SEQ_LD64
#undef SEQ_LD32
#undef SEQ_LDT
}
__device__ __forceinline__ void ph_rwkv_pref(const Args& a, const Ctx& C, int hd, int vs) {
    const unsigned char* ws = a.ws;
    volatile LAS int* prog = (volatile LAS int*)(C.lds + MISC_OFF + 64);
    const int cs0 = hd * NCK;
    constexpr int DEPTH = 12, INFL = 6;
    unsigned x[INFL][4];
#pragma unroll
    for (int i = 0; i < INFL; ++i)
#pragma unroll
        for (int k = 0; k < 4; ++k) x[i][k] = 0u;
#define PREF_ADDR(cs_, k) ({ const int L_ = 64 * (k) + C.lane; const size_t c2_ = (size_t)(cs_) * 4096, c1_ = (size_t)(cs_) * 2048; \
        (L_ < 32 ? ws + WS_AGP + c2_ + 128 * L_ : L_ < 64 ? ws + WS_RGP + c2_ + 128 * (L_ - 32)   : L_ < 96 ? ws + WS_KGT + c2_ + 128 * (L_ - 64) : L_ < 128 ? ws + WS_BGT + c2_ + 128 * (L_ - 96) : \
         L_ < 160 ? ws + WS_VTP + c2_ + 128 * (L_ - 128) : L_ < 172 ? ws + WS_TP + c1_ + 128 * (L_ - 160) : L_ < 184 ? ws + WS_AAK + c1_ + 128 * (L_ - 172) : L_ < 196 ? ws + WS_ARK + c1_ + 128 * (L_ - 184) : L_ < 208 ? ws + WS_ARB + c1_ + 128 * (L_ - 196) : \
         L_ >= 210 ? ws + WS_GC + (size_t)(cs_) * 256   : ws + WS_GC + (size_t)(cs_) * 256 + 128 * ((L_ - 224) & 1)); })
    for (int c0 = 2; c0 < NCK; c0 += INFL) {
#pragma unroll
        for (int i = 0; i < INFL; ++i) {
            const int c = c0 + i < NCK ? c0 + i : NCK - 1;
            unsigned spins = 0;
            while (c > *prog + DEPTH && ++spins < (1u << 22)) __builtin_amdgcn_s_sleep(8);
#pragma unroll
            for (int k = 0; k < 4; ++k) { asm volatile("" :: "v"(x[i][k])); x[i][k] = *(const unsigned*)PREF_ADDR(cs0 + c, k); }
        }
    }
#pragma unroll
    for (int i = 0; i < INFL; ++i)
#pragma unroll
        for (int k = 0; k < 4; ++k) asm volatile("" :: "v"(x[i][k]));
#undef PREF_ADDR
}

__device__ __forceinline__ void rwkv_out_rows(const Args& a, const Ctx& C, int l, const bf16* __restrict__ SY, const bf16* __restrict__ P, const float* __restrict__ mu, const float* __restrict__ BON,
                                              const bf16* __restrict__ LO, const float* __restrict__ LNW, const float* __restrict__ LNB, bf16* __restrict__ YALL);
__device__ __forceinline__ void ph_rwkv_out(const Args& a, const Ctx& C, int l) {
    rwkv_out_rows(a, C, l, (const bf16*)(a.ws + WS_SY), (const bf16*)(a.ws + WS_P), a.in[I_MU] + (size_t)l * 4 * RWIN, (const float*)(a.ws + WS_BON), (const bf16*)(a.ws + WS_LORA),
                  a.in[I_LNW] + l * 1024, a.in[I_LNB] + l * 1024, (bf16*)(a.ws + WS_YALL));
}
__device__ __forceinline__ void rwkv_out_rows(const Args& a, const Ctx& C, int l, const bf16* __restrict__ SY, const bf16* __restrict__ P, const float* __restrict__ mu, const float* __restrict__ BON,
                                              const bf16* __restrict__ LO, const float* __restrict__ LNW, const float* __restrict__ LNB, bf16* __restrict__ YALL) {
    const int c0 = 16 * C.lane;
#pragma unroll 2
    FOR_ROWS_FROM(t, l == NL - 1 ? TC : 0) {
        const size_t o = (size_t)t * 1024 + c0;
        float y[16], v[16]; float s = 0.f;
        { const v4u f0 = *(const v4u*)(SY + o), f1 = *(const v4u*)(SY + o + 8), b0 = *(const v4u*)(SY + (size_t)T * 1024 + o), b1 = *(const v4u*)(SY + (size_t)T * 1024 + o + 8);
          const unsigned ff[8] = {f0.x, f0.y, f0.z, f0.w, f1.x, f1.y, f1.z, f1.w}, bb[8] = {b0.x, b0.y, b0.z, b0.w, b1.x, b1.y, b1.z, b1.w};
#pragma unroll
          for (int i = 0; i < 8; ++i) { y[2 * i] = bf_lo(ff[i]) + bf_lo(bb[i]); y[2 * i + 1] = bf_hi(ff[i]) + bf_hi(bb[i]); } }
        { int nb[4], nn; shift_rows(t, nb, nn); float u[8];
          shift8(P, mu, t, 2048 + c0, nb, nn, u);
#pragma unroll
          for (int i = 0; i < 8; ++i) v[i] = u[i];
          shift8(P, mu, t, 2048 + c0 + 8, nb, nn, u);
#pragma unroll
          for (int i = 0; i < 8; ++i) v[8 + i] = u[i]; }
#pragma unroll
        for (int i = 0; i < 16; ++i) s += y[i];
        const float mean = quadsum(s) * (1.0f / 64.0f); float q = 0.f;
#pragma unroll
        for (int i = 0; i < 16; ++i) { y[i] -= mean; q += y[i] * y[i]; }
        const float rstd = rsqrtf(quadsum(q) * (1.0f / 64.0f) + 64e-5f);
        float bon = 0.f;
#pragma unroll
        for (int j = 0; j < 8; ++j) bon += BON[((size_t)((j >> 2) * 16 + (C.lane >> 2)) * 4 + (j & 3)) * T + t];
        const bf16* gp = LO + (size_t)t * LNN + 4096 + c0; const v4u g0 = *(const v4u*)gp, g1 = *(const v4u*)(gp + 8);
        const unsigned gg[8] = {g0.x, g0.y, g0.z, g0.w, g1.x, g1.y, g1.z, g1.w};
        float out[16];
#pragma unroll
        for (int i = 0; i < 16; ++i) { const float g = (i & 1) ? bf_hi(gg[i >> 1]) : bf_lo(gg[i >> 1]);
            out[i] = (y[i] * rstd * LNW[c0 + i] + LNB[c0 + i] + bon * v[i]) * g; }
        bf16* yo = YALL + (size_t)t * D + c0;
        *(v4u*)yo = (v4u){pk2(out[0], out[1]), pk2(out[2], out[3]), pk2(out[4], out[5]), pk2(out[6], out[7])};
        *(v4u*)(yo + 8) = (v4u){pk2(out[8], out[9]), pk2(out[10], out[11]), pk2(out[12], out[13]), pk2(out[14], out[15])};
    }
}

__device__ __forceinline__ void ph_norm2_route(const Args& a, const Ctx& C, int l, int cslot) {
    const bf16* X = (const bf16*)(a.ws + WS_X); bf16* H = (bf16*)(a.ws + WS_H);
    const float* modf = (const float*)(a.ws + WS_MOD);
    constexpr int TPH = 2056;
    LAS unsigned short* TH = (LAS unsigned short*)C.lds; LAS unsigned short* TLo = TH + 16 * TPH;
    LAS float* PART = (LAS float*)(C.lds + 2 * 16 * TPH * 2);
    LAS float* SC = PART + 8 * 16 * 32;
    int* RE = (int*)(a.ws + WS_RE); float* RWT = (float*)(a.ws + WS_RWT); int* RI = (int*)(a.ws + WS_RI); int* SLOT = (int*)(a.ws + WS_XB);
    unsigned* cnt = (unsigned*)(a.ws + WS_CTL) + CW_CNT + 64 * cslot;
    const bf16* RT = (const bf16*)(a.ws + WS_RT);
    const int fr = C.lane & 15, fq = C.lane >> 4;
    f32x4 gg[8]; const float* shp = modf; int vwh = -1;
    for (int tl = (l == NL - 1 ? TC / 16 : 0) + C.bx; tl < T / 16; tl += C.G) {
        { const int wh = tl < TC / 16 ? 1 : 0;
          if (wh != vwh) { vwh = wh; const float* md = modf + (size_t)(l * 2 + wh) * 12288;
#pragma unroll
              for (int j = 0; j < 8; ++j) { const int k = 4 * C.lane + 256 * j; gg[j] = *(const f32x4*)(a.in[I_N2G] + l * D + k) * (1.0f + *(const f32x4*)(md + 4 * D + k)); } shp = md + 3 * D; } }
#pragma nounroll
        for (int rr = 0; rr < 2; ++rr) {
            const int r = 16 * tl + 2 * C.wave + rr;
            const bf16* xr = X + (size_t)r * D;
            if (l == 0 && r < TC) {
#pragma nounroll
                for (int j = 0; j < 8; ++j) { const int k = 4 * C.lane + 256 * j; const float* pp = (const float*)(a.ws + WS_XB + CTXPART_OFF) + (size_t)r * 2048 + k;
                    const f32x4 sm = (*(const f32x4*)pp + *(const f32x4*)(pp + 256 * 2048)) + (*(const f32x4*)(pp + 2 * 256 * 2048) + *(const f32x4*)(pp + 3 * 256 * 2048));
                    const f32x4 o = *(const f32x4*)(a.in[I_CTX] + (size_t)r * D + k) + *(const f32x4*)(modf + (size_t)(l * 2 + 1) * 12288 + 2 * D + k) * sm;
                    *(v2u*)((bf16*)(a.ws + WS_X) + (size_t)r * D + k) = (v2u){pk2(o.x, o.y), pk2(o.z, o.w)}; }
                asm volatile("s_waitcnt vmcnt(0)" ::: "memory"); }
            f32x4 v[8]; float ss = 0.f;
#pragma unroll
            for (int j = 0; j < 8; ++j) { const v2u xw = *(const v2u*)(xr + 4 * C.lane + 256 * j); v[j] = (f32x4){bf_lo(xw.x), bf_hi(xw.x), bf_lo(xw.y), bf_hi(xw.y)}; ss += v[j].x * v[j].x + v[j].y * v[j].y + v[j].z * v[j].z + v[j].w * v[j].w; }
            const float rstd = rsqrtf(wave_sum(ss) * (1.0f / D) + 1e-6f);
#pragma unroll
            for (int j = 0; j < 8; ++j) { const int k = 4 * C.lane + 256 * j;
                const f32x4 h = v[j] * rstd * gg[j] + *(const f32x4*)(shp + k);
                const unsigned p0 = pk2(h.x, h.y), p1 = pk2(h.z, h.w);
                const float l0 = h.x - bf_lo(p0), l1 = h.y - bf_hi(p0), l2 = h.z - bf_lo(p1), l3 = h.w - bf_hi(p1);
                *(LAS v2u*)(TH + (2 * C.wave + rr) * TPH + k) = (v2u){p0, p1};
                *(LAS v2u*)(TLo + (2 * C.wave + rr) * TPH + k) = (v2u){pk2(l0, l1), pk2(l2, l3)};
                *(v2u*)(H + (size_t)r * D + k) = (v2u){p0, p1}; }
        }
        __syncthreads();
        { f32x4 acc[2] = {{0.f, 0.f, 0.f, 0.f}, {0.f, 0.f, 0.f, 0.f}};
#pragma unroll
          for (int s = 0; s < 8; ++s) { const int k = 256 * C.wave + 32 * s + 8 * fq;
              const bf16x8 ah = *(const LAS bf16x8*)(TH + fr * TPH + k), al = *(const LAS bf16x8*)(TLo + fr * TPH + k);
#pragma unroll
              for (int hf = 0; hf < 2; ++hf) { const bf16* rp = RT + (size_t)(16 * hf + fr) * 2048 + k;
                  const bf16x8 bh = *(const bf16x8*)rp, bl = *(const bf16x8*)(rp + 32 * 2048);
                  acc[hf] = __builtin_amdgcn_mfma_f32_16x16x32_bf16(ah, bh, acc[hf], 0, 0, 0);
                  acc[hf] = __builtin_amdgcn_mfma_f32_16x16x32_bf16(ah, bl, acc[hf], 0, 0, 0);
                  acc[hf] = __builtin_amdgcn_mfma_f32_16x16x32_bf16(al, bh, acc[hf], 0, 0, 0); } }
#pragma unroll
          for (int hf = 0; hf < 2; ++hf)
#pragma unroll
              for (int r = 0; r < 4; ++r) PART[(C.wave * 16 + 4 * fq + r) * 32 + 16 * hf + fr] = acc[hf][r]; }
        __syncthreads();
        { const int row = C.tid >> 5, e = C.tid & 31; float lg = 0.f;
#pragma unroll
          for (int w = 0; w < 8; ++w) lg += PART[(w * 16 + row) * 32 + e];
          const float sc = 1.0f / (1.0f + expf(-lg)); SC[row * 32 + e] = sc; SC[512 + row * 32 + e] = sc + a.in[I_RTB][e]; }
        __syncthreads();
        if (C.tid < 16) { const int row = C.tid, t = 16 * tl + row; const LAS float* bi = SC + 512 + row * 32; const LAS float* sc = SC + row * 32;
            int bg = 0; float bgs = -1e30f;
            for (int g = 0; g < 4; ++g) { float m1 = -1e30f, m2 = -1e30f;
                for (int j = 0; j < 8; ++j) { const float x = bi[8 * g + j]; if (x > m1) { m2 = m1; m1 = x; } else if (x > m2) m2 = x; }
                const float gs = m1 + m2; if (gs > bgs) { bgs = gs; bg = g; } }
            int i1 = 0; float v1 = -1e30f;
            for (int j = 0; j < 8; ++j) { const float x = bi[8 * bg + j]; if (x > v1) { v1 = x; i1 = j; } }
            int i2 = 0; float v2 = -1e30f;
            for (int j = 0; j < 8; ++j) { if (j == i1) continue; const float x = bi[8 * bg + j]; if (x > v2) { v2 = x; i2 = j; } }
            const int e1 = 8 * bg + i1, e2 = 8 * bg + i2; const float w1 = sc[e1], w2 = sc[e2], ws = w1 + w2;
            RE[2 * t] = e1; RE[2 * t + 1] = e2; RWT[2 * t] = w1 / ws; RWT[2 * t + 1] = w2 / ws;
            const int x1 = (int)atomicAdd(cnt + e1, 1u), x2 = (int)atomicAdd(cnt + e2, 1u);
            RI[2 * t] = x1; RI[2 * t + 1] = x2; SLOT[(size_t)e1 * T + x1] = t; SLOT[(size_t)e2 * T + x2] = t; }
        __syncthreads();
    }
}

__device__ __forceinline__ void moe_tables(const Args& a, const Ctx& C, int l) {
    LAS int* pst = (LAS int*)(C.lds + EXTRA_OFF);
    unsigned* cnt = (unsigned*)(a.ws + WS_CTL) + CW_CNT + 64 * l;
    if (C.tid < 64) {
        const int c = C.lane < NE ? (int)__hip_atomic_load(cnt + C.lane, __ATOMIC_RELAXED, __HIP_MEMORY_SCOPE_AGENT) : 0;
        const int pad = ((c + 255) >> 8) << 8; int inc = pad;
#pragma unroll
        for (int o = 1; o < 32; o <<= 1) { const int t = __shfl_up(inc, o); if (C.lane >= o) inc += t; }
        const int st = inc - pad;
        if (C.lane < NE) { pst[C.lane] = st; pst[64 + C.lane] = c; if (C.lane == NE - 1) { pst[NE] = inc; pst[127] = inc >> 8; }
            for (int i = 0; i < (pad >> 8); ++i) pst[128 + (st >> 8) + i] = C.lane; }
    }
    __syncthreads();
}

__device__ __forceinline__ void combine_rows(const Args& a, const Ctx& C, int l, const bf16* __restrict__ X, bf16* __restrict__ XN, const bf16* __restrict__ YB, const int* __restrict__ RE, const int* __restrict__ RI,
                                             const float* __restrict__ RWT, const float* __restrict__ modf, bf16* __restrict__ Hq, float* __restrict__ outq);
__device__ __forceinline__ void ph_combine(const Args& a, const Ctx& C, int l) {
    combine_rows(a, C, l, (const bf16*)(a.ws + WS_X), (bf16*)(a.ws + WS_XN), (const bf16*)(a.ws + WS_YB), (const int*)(a.ws + WS_RE), (const int*)(a.ws + WS_RI), (const float*)(a.ws + WS_RWT),
                 (const float*)(a.ws + WS_MOD), (bf16*)(a.ws + WS_H), a.out);
}
__device__ __forceinline__ void combine_rows(const Args& a, const Ctx& C, int l, const bf16* __restrict__ X, bf16* __restrict__ XN, const bf16* __restrict__ YB, const int* __restrict__ RE, const int* __restrict__ RI,
                                             const float* __restrict__ RWT, const float* __restrict__ modf, bf16* __restrict__ Hq, float* __restrict__ outq) {
    moe_tables(a, C, l); LAS const int* pst = (LAS const int*)(C.lds + EXTRA_OFF);
    f32x4 gq[8], ng[8]; const float* nshp;
#define CMB_VECS(wh) do { const float* gt_ = modf + (size_t)(l * 2 + (wh)) * 12288 + 5 * D; const float* mdn_ = modf + (size_t)((l + 1 < NL ? l + 1 : l) * 2 + (wh)) * 12288; \
        _Pragma("unroll") for (int j = 0; j < 8; ++j) { const int k = 4 * C.lane + 256 * j; gq[j] = *(const f32x4*)(gt_ + k); \
            if (l == NL - 1) ng[j] = *(const f32x4*)(a.in[I_FG] + k); \
            else ng[j] = *(const f32x4*)(a.in[I_N1G] + (l + 1) * D + k) * (1.0f + *(const f32x4*)(mdn_ + D + k)); } nshp = mdn_; } while (0)
#define CMB_ROW(r, NGX, NSX) do { \
        const int d0 = pst[RE[2 * (r)]] + RI[2 * (r)], d1 = pst[RE[2 * (r) + 1]] + RI[2 * (r) + 1]; const float w0 = RWT[2 * (r)], w1 = RWT[2 * (r) + 1]; \
        const bf16* xr = X + (size_t)(r) * D; bf16* xo = XN + (size_t)(r) * D; const bf16* y0 = YB + (size_t)d0 * D; const bf16* y1 = YB + (size_t)d1 * D; \
        f32x4 v[8]; float ss = 0.f; \
        _Pragma("unroll") for (int j = 0; j < 8; ++j) { const int k = 4 * C.lane + 256 * j; \
            const v2u xw = *(const v2u*)(xr + k); const f32x4 x = {bf_lo(xw.x), bf_hi(xw.x), bf_lo(xw.y), bf_hi(xw.y)}; const v2u p0 = *(const v2u*)(y0 + k), p1 = *(const v2u*)(y1 + k); \
            f32x4 f; f.x = w0 * bf_lo(p0.x) + w1 * bf_lo(p1.x); f.y = w0 * bf_hi(p0.x) + w1 * bf_hi(p1.x); f.z = w0 * bf_lo(p0.y) + w1 * bf_lo(p1.y); f.w = w0 * bf_hi(p0.y) + w1 * bf_hi(p1.y); \
            v[j] = x + gq[j] * f; ss += v[j].x * v[j].x + v[j].y * v[j].y + v[j].z * v[j].z + v[j].w * v[j].w; } \
        if (l == NL - 1) { \
            if ((r) >= TC) { const float rstd = rsqrtf(wave_sum(ss) * (1.0f / D) + 1e-6f); float* orow = outq + (size_t)((r) - TC) * D; \
                _Pragma("unroll") for (int j = 0; j < 8; ++j) { const int k = 4 * C.lane + 256 * j; *(f32x4*)(orow + k) = v[j] * rstd * NGX(j, k); } } \
        } else {                                                                \
            const float rstd = rsqrtf(wave_sum(ss) * (1.0f / D) + 1e-6f); bf16* H = Hq; \
            _Pragma("unroll") for (int j = 0; j < 8; ++j) { const int k = 4 * C.lane + 256 * j; \
                *(v2u*)(xo + k) = (v2u){pk2(v[j].x, v[j].y), pk2(v[j].z, v[j].w)}; \
                const f32x4 h = v[j] * rstd * NGX(j, k) + NSX(k); \
                *(v2u*)(H + (size_t)(r) * D + k) = (v2u){pk2(h.x, h.y), pk2(h.z, h.w)}; } \
        } } while (0)
#define NG_REG(j, k) ng[j]
#define NS_MEM(k) (*(const f32x4*)(nshp + (k)))
#define NG_LDS(j, k) (*(const LAS f32x4*)(NGL + (k)))
#define NS_LDS(k) (*(const LAS f32x4*)(NSL + (k)))
    if (l < NL - 1 && C.wave == 0 && C.bx < TC) { CMB_VECS(1); for (int r = C.bx; r < TC; r += C.G) CMB_ROW(r, NG_REG, NS_MEM); }
    CMB_VECS(0);
    LAS float* NGL = (LAS float*)C.lds; LAS float* NSL = NGL + D;
    for (int k = C.tid; k < D; k += NTHR) { const float* mdn_ = modf + (size_t)((l + 1 < NL ? l + 1 : l) * 2 + 0) * 12288;
        NGL[k] = (l == NL - 1) ? a.in[I_FG][k] : a.in[I_N1G][(l + 1) * D + k] * (1.0f + mdn_[D + k]); NSL[k] = (l == NL - 1) ? 0.f : mdn_[k]; }
    __syncthreads();
#pragma unroll 2
    for (int r = TC + C.gw; r < T; r += C.NGW) CMB_ROW(r, NG_LDS, NS_LDS);
#undef NG_REG
#undef NS_MEM
#undef NG_LDS
#undef NS_LDS
#undef CMB_VECS
#undef CMB_ROW
}

__device__ __forceinline__ Ctx fresh_ctx(const Ctx& C0) {
    Ctx C = C0; int t = C0.tid; asm volatile("" : "+v"(t)); C.tid = t; C.lane = t & 63; C.wave = __builtin_amdgcn_readfirstlane(t >> 6); C.gw = C.bx * NWAVES + C.wave; return C; }
__device__ __forceinline__ int opaque_two() { int n = 2; asm volatile("" : "+s"(n)); return n; }
constexpr int PH_PER_LAYER = 14, N_PHASES = 1 + NL * PH_PER_LAYER;
#ifndef PH_MASK
#define PH_MASK 0xffffffffu
#endif
#define PHM(j) (((PH_MASK) >> (j)) & 1u)
#ifndef GEMM_SP2
#define GEMM_SP2 true
#endif
#ifndef REP_PHASE
#define REP_PHASE (-1)
#endif
#define REPLOOP(j, l) _Pragma("nounroll") for (int rep_ = 0, nrep_ = ((REP_PHASE) == (j) && (l) == 0) ? opaque_two() : 1; rep_ < nrep_; ++rep_)
#define IN(k) (lo <= (k) && (k) < hi)
#define SEAM(k) do { if (IN(k) && IN((k) + 1)) xcd_barrier(bar); } while (0)


template <int l> __device__ __forceinline__ void layer_body(const Args& args, const Ctx& C, const XcdBarrier& bar, const int lo, const int hi, const bool multi) {
    unsigned char* ws = args.ws;
        const int pb = 1 + l * PH_PER_LAYER;
        if (l == 0) {
            if (PHM(0) && IN(pb + 0)) REPLOOP(0, l) ph_norm1(args, fresh_ctx(C), l);
            SEAM(pb + 0);
        }
        if (PHM(1) && IN(pb + 1)) {
            pg8::Gemm g{(const bf16*)(ws + WS_H), (const bf16*)(ws + WS_WIN) + (size_t)l * PW * D, T, PW, D};
            pg8::StaticOrder S; S.init(T, PW, C.G, C.bx);
            pg8::EpiStoreBf16 E{(bf16*)(ws + WS_P), PW, 0x7fffffff};
            pg8::gemm_phase<pg8::EpiStoreBf16, pg8::StaticOrder, true, GEMM_SP2>(C.lds, g, S, E);
        }
        SEAM(pb + 1);
        if (PHM(2) && IN(pb + 2)) REPLOOP(2, l) ph_prep(args, fresh_ctx(C), l);
        SEAM(pb + 2);
        if (PHM(3) && IN(pb + 3)) {
            pg8::Gemm g{(const bf16*)(ws + WS_LA), (const bf16*)(ws + WS_LB) + (size_t)l * LNN * LK, T, LNN, LK};
            pg8::LoraOrder S; S.S.init(T, LNN, C.G, C.bx);
            pg8::EpiStoreBf16 E{(bf16*)(ws + WS_LORA), LNN, 0x7fffffff};
            pg8::gemm_phase<pg8::EpiStoreBf16, pg8::LoraOrder, true, GEMM_SP2, false, true>(C.lds, g, S, E);
        }
        SEAM(pb + 3);
        if (PHM(4) && IN(pb + 4)) { REPLOOP(4, l) ph_rwkv_prep<7>(args, fresh_ctx(C), l); if ((REP_PHASE) >= 420 && (REP_PHASE) < 428 && l == 0) ph_rwkv_prep<((REP_PHASE) >= 420 && (REP_PHASE) < 428) ? (REP_PHASE) - 420 : 0>(args, fresh_ctx(C), l); REPLOOP(41, l) ph_ret_prefix(args, fresh_ctx(C), l); }
        SEAM(pb + 4);
        if (PHM(6) && IN(pb + 6)) {
            const int nsq = C.G >= 128 ? 128 : 0;
            if (nsq == 0) { for (int b = C.bx; b < 128; b += C.G) { if (C.wave == 0) ph_rwkv_seq(args, fresh_ctx(C), b >> 2, b & 3); else if (C.wave == 2) ph_rwkv_seq_y(args, fresh_ctx(C), b >> 2, b & 3);
                    __syncthreads(); if (C.tid == 0) { volatile LAS int* w = (volatile LAS int*)(C.lds + MISC_OFF + 64); w[0] = 0; w[1] = 0; w[2] = 0; } __syncthreads(); } ph_ret_out(args, fresh_ctx(C), l, C.bx, C.G); ph_convert_moe(args, fresh_ctx(C), l, C.gw, C.NGW, (LAS float*)(C.lds + 79872 + (C.wave & 7) * 8704)); }
            else if (C.bx < nsq && C.wave == 0) { const int xi = C.bx >> 3;
                ph_rwkv_seq(args, fresh_ctx(C), (C.bx & 7) * 4 + (xi >> 2), xi & 3); }
            else if (C.bx < nsq && C.wave == 1) { const int xi = C.bx >> 3; ph_rwkv_pref(args, fresh_ctx(C), (C.bx & 7) * 4 + (xi >> 2), xi & 3); }
            else if (C.bx < nsq && C.wave == 2) { const int xi = C.bx >> 3; ph_rwkv_seq_y(args, fresh_ctx(C), (C.bx & 7) * 4 + (xi >> 2), xi & 3); }
            else if (C.bx >= nsq) { const int wid = (C.bx - nsq) * 8 + C.wave; const int nwk = (C.G - nsq) * 8;     REPLOOP(62, l) ph_ret_out(args, fresh_ctx(C), l, C.bx - nsq, C.G - nsq);
                   REPLOOP(63, l) ph_convert_moe(args, fresh_ctx(C), l, wid, nwk, (LAS float*)(C.lds + 79872 + (C.wave & 7) * 8704)); }
        }
        SEAM(pb + 6);
        if (IN(pb + 6) && C.tid == 0) { volatile LAS int* w = (volatile LAS int*)(C.lds + MISC_OFF + 64); w[0] = 0; w[1] = 0; w[2] = 0; }
        if (PHM(7) && IN(pb + 7)) REPLOOP(7, l) ph_rwkv_out(args, fresh_ctx(C), l);
        SEAM(pb + 7);
        if (PHM(8) && IN(pb + 8)) REPLOOP(8, l) {
            constexpr int roff = (l == NL - 1) ? TC : 0;
            pg8::Gemm g{(const bf16*)(ws + WS_YALL) + (size_t)roff * D, (const bf16*)(ws + WS_WOUT) + (size_t)l * D * D, T - roff, D, D};
            pg8::StaticOrder S; S.init(T - roff, D, C.G, C.bx);
            const float* modf = (const float*)(ws + WS_MOD);
            bf16* X = (bf16*)(ws + WS_X); const bf16* XNp = (const bf16*)(ws + WS_XN);
            if constexpr (l == 0) {
                pg8::OutL0Order S0; S0.S.init(T - TC, D, C.G, C.bx);
                pg8::EpiResidL0 E{{args.in[I_CTX], args.in[I_X], modf + (size_t)(l * 2 + 1) * 12288 + 2 * D, modf + (size_t)(l * 2 + 0) * 12288 + 2 * D, X, D, 0}, (float*)(ws + WS_XB + CTXPART_OFF)};
                pg8::gemm_phase<pg8::EpiResidL0, pg8::OutL0Order, true, GEMM_SP2, false, true>(C.lds, g, S0, E); }
            else { pg8::EpiResid<true> E{XNp, XNp + (size_t)TC * D, modf + (size_t)(l * 2 + 1) * 12288 + 2 * D, modf + (size_t)(l * 2 + 0) * 12288 + 2 * D, X, D, roff / 256};
                pg8::gemm_phase<pg8::EpiResid<true>, pg8::StaticOrder, true, GEMM_SP2>(C.lds, g, S, E); }
        }
        SEAM(pb + 8);
        if (PHM(9) && IN(pb + 9)) REPLOOP(9, l) ph_norm2_route(args, fresh_ctx(C), l, l + 2 * rep_);
        SEAM(pb + 9);
        if (PHM(11) && IN(pb + 11)) REPLOOP(11, l) {
            moe_tables(args, fresh_ctx(C), l); LAS const int* tb = (LAS const int*)(C.lds + EXTRA_OFF);
            pg8::Gemm g{(const bf16*)(ws + WS_H), (const bf16*)(ws + WS_W1) + (size_t)l * NE * 2048 * 2048, MPAD, NE * 2048, D};
            pg8::MoeGatherOrder S{tb[127] * 8, C.G, C.bx, tb, (const int*)(ws + WS_XB), T};
            pg8::EpiSwiGLU E{(bf16*)(ws + WS_ACT), 1024};
            pg8::gemm_phase<pg8::EpiSwiGLU, pg8::MoeGatherOrder, true, GEMM_SP2, true>(C.lds, g, S, E);
        }
        SEAM(pb + 11);
        if (PHM(12) && IN(pb + 12)) REPLOOP(12, l) {
            moe_tables(args, fresh_ctx(C), l); LAS const int* tb = (LAS const int*)(C.lds + EXTRA_OFF);
            pg8::Gemm g{(const bf16*)(ws + WS_ACT), (const bf16*)(ws + WS_W2) + (size_t)l * NE * 2048 * 1024, MPAD, NE * 2048, 1024};
            pg8::MoeOrder S{tb[127] * 8, C.G, C.bx, tb};
            pg8::EpiStoreBf16 E{(bf16*)(ws + WS_YB), D, 7};
            pg8::gemm_phase<pg8::EpiStoreBf16, pg8::MoeOrder, true, GEMM_SP2>(C.lds, g, S, E);
        }
        SEAM(pb + 12);
        if (PHM(13) && IN(pb + 13)) REPLOOP(13, l) ph_combine(args, fresh_ctx(C), l);
        SEAM(pb + 13);
        if ((REP_PHASE) == 77 && l == 0 && multi) { _Pragma("nounroll") for (int i_ = 0, n_ = 5 * opaque_two(); i_ < n_; ++i_) xcd_barrier(bar); }
    }
__global__ void __launch_bounds__(NTHR, 2) fwd_kernel(Args args) {
    extern __shared__ __attribute__((aligned(16))) unsigned char lds_raw[];
    Ctx C; C.lds = (LAS unsigned char*)lds_raw;
    C.tid = threadIdx.x; C.lane = C.tid & 63; C.wave = __builtin_amdgcn_readfirstlane(C.tid >> 6);
    C.G = gridDim.x; C.bx = blockIdx.x; C.gw = C.bx * NWAVES + C.wave; C.NGW = C.G * NWAVES;
    volatile LAS unsigned* MISC = (volatile LAS unsigned*)(C.lds + MISC_OFF);
    if (C.tid < 64) MISC[C.tid] = 0u;
    __syncthreads();
    unsigned char* ws = args.ws;
    XcdBarrier bar; bar.bar = (unsigned*)(ws + WS_CTL) + CW_BAR; bar.x = 0; bar.st = nullptr;
    const bool multi = (args.ph_hi - args.ph_lo) > 1;
    if (multi) bar = xcd_barrier_post((unsigned*)(ws + WS_CTL) + CW_BAR, MISC + 8);
    const int lo = args.ph_lo, hi = args.ph_hi;
    if (PHM(15) && IN(0)) { REPLOOP(15, 0) ph_prologue(args, fresh_ctx(C)); }
    SEAM(0);
    layer_body<0>(args, C, bar, lo, hi, multi);
    layer_body<1>(args, C, bar, lo, hi, multi);
#undef IN
#undef SEAM
}

extern "C" void kernel_launch(void* const* d_in, const int* in_sizes, int n_in, void* d_out, int out_size, void* d_ws, size_t ws_size, hipStream_t stream) {
    static int grid = 0;
    if (grid == 0) {
        if (n_in != 28 || out_size != TL * D || ws_size < WS_END) { fprintf(stderr, "kernel_launch: unexpected shapes (n_in %d out %d ws %zu need %zu)\n", n_in, out_size, ws_size, (size_t)WS_END); grid = -1; return; }
        int dev = 0, cus = 0, per_cu = 0;
        if (hipGetDevice(&dev) != hipSuccess || hipDeviceGetAttribute(&cus, hipDeviceAttributeMultiprocessorCount, dev) != hipSuccess) { grid = -1; return; }
        if (hipFuncSetAttribute((const void*)fwd_kernel, hipFuncAttributeMaxDynamicSharedMemorySize, LDS_BYTES) != hipSuccess) { fprintf(stderr, "kernel_launch: hipFuncSetAttribute failed\n"); grid = -1; return; }
        if (hipOccupancyMaxActiveBlocksPerMultiprocessor(&per_cu, (const void*)fwd_kernel, NTHR, LDS_BYTES) != hipSuccess || per_cu < 1) { fprintf(stderr, "kernel_launch: occupancy query says %d\n", per_cu); }
        (void)hipGetLastError();
        grid = cus;
    }
    if (grid < 0) return;
    if (hipMemsetAsync((char*)d_ws + WS_CTL, 0, CTL_BYTES, stream) != hipSuccess) return;
    Args a{};
    for (int i = 0; i < 28; ++i) a.in[i] = (const float*)d_in[i];
    a.out = (float*)d_out; a.ws = (unsigned char*)d_ws;
#if MK_N_LAUNCHES == 1
    a.ph_lo = 0; a.ph_hi = N_PHASES;
    hipLaunchKernelGGL(fwd_kernel, dim3(grid), dim3(NTHR), LDS_BYTES, stream, a);
#else
    for (int p = 0; p < N_PHASES; ++p) { a.ph_lo = p; a.ph_hi = p + 1; hipLaunchKernelGGL(fwd_kernel, dim3(grid), dim3(NTHR), LDS_BYTES, stream, a); }
#endif
}
```
